# Optimizing an MI355X kernel written in HIP

```python
import math
import jax, jax.numpy as jnp
from jax import lax
import numpy as np

D_MODEL = 1024
BATCH = 8
SEQ = 4096
DEPTH = 4

N_MIXERS = 3
N_CONV_LAYERS = (DEPTH + 2) // 3
N_LRU_LAYERS = (DEPTH + 1) // 3
N_MLA_LAYERS = DEPTH // 3

CONV_WIDTH = 3

LRU_WIDTH = 1280
LRU_BLOCKS = 10
LRU_BLOCK_W = LRU_WIDTH // LRU_BLOCKS
LRU_CONV_WIDTH = 4
LRU_C = 8.0

MLA_HEADS = 8
Q_LORA_RANK = 384
KV_LORA_RANK = 256
QK_NOPE_DIM = 128
QK_ROPE_DIM = 64
V_HEAD_DIM = 128
ROPE_THETA = 10000.0
Q_BLOCK = 128

D_FF = ((8 * D_MODEL // 3 + 255) // 256) * 256

NORM_EPS = 1e-6

kernel_name = 'hybrid_conv_rglru_mla_interleaved'


def rms_norm(x, g):
    xf = x.astype(jnp.float32)
    y = xf * lax.rsqrt(jnp.mean(xf * xf, axis=-1, keepdims=True) + NORM_EPS)
    return (y * g.astype(jnp.float32)).astype(x.dtype)


def causal_depthwise_conv(x, w):
    width, ch = w.shape
    return lax.conv_general_dilated(
        x, w[:, None, :].astype(x.dtype), window_strides=(1,),
        padding=[(width - 1, 0)], dimension_numbers=('NWC', 'WIO', 'NWC'),
        feature_group_count=ch)


def short_conv_mixer(xn, w_in, w_conv, w_out):
    b_gate, c_gate, h = jnp.split(xn @ w_in, 3, axis=-1)
    y = b_gate * causal_depthwise_conv(c_gate * h, w_conv)
    return y @ w_out


def rg_lru(xs, wa, ba, wx, bx, lam):
    bsz, seq, width = xs.shape
    xb = xs.reshape(bsz, seq, LRU_BLOCKS, LRU_BLOCK_W)
    r = jax.nn.sigmoid(jnp.einsum('bsnd,nde->bsne', xb, wa) + ba).reshape(bsz, seq, width)
    i = jax.nn.sigmoid(jnp.einsum('bsnd,nde->bsne', xb, wx) + bx).reshape(bsz, seq, width)
    log_a = LRU_C * r.astype(jnp.float32) * jax.nn.log_sigmoid(lam.astype(jnp.float32))
    a = jnp.exp(log_a)
    mult = jnp.sqrt(-jnp.expm1(2.0 * log_a))
    b = mult * (i * xs).astype(jnp.float32)

    def combine(left, right):
        a_l, b_l = left
        a_r, b_r = right
        return a_l * a_r, a_r * b_l + b_r

    _, h = lax.associative_scan(combine, (a, b), axis=1)
    return h.astype(xs.dtype)


def recurrent_mixer(xn, w_in, conv_w, conv_b, gate_a_w, gate_a_b, gate_x_w, gate_x_b, lam, w_out):
    gate_branch, rec_branch = jnp.split(xn @ w_in, 2, axis=-1)
    gate = jax.nn.gelu(gate_branch, approximate=True)
    rec = causal_depthwise_conv(rec_branch, conv_w) + conv_b
    h = rg_lru(rec, gate_a_w, gate_a_b, gate_x_w, gate_x_b, lam)
    return (gate * h) @ w_out


def apply_rope(t, cos, sin):
    half = t.shape[-1] // 2
    tf = t.astype(jnp.float32)
    t1, t2 = tf[..., :half], tf[..., half:]
    return jnp.concatenate([t1 * cos - t2 * sin, t2 * cos + t1 * sin], axis=-1).astype(t.dtype)


def mla_mixer(xn, cos, sin, w_down, q_norm, kv_norm, w_uq, w_ukv,
              qn_norm, qr_norm, kn_norm, kr_norm, w_o):
    bsz, seq, _ = xn.shape
    c = xn @ w_down
    c_q = c[..., :Q_LORA_RANK]
    c_kv = c[..., Q_LORA_RANK:Q_LORA_RANK + KV_LORA_RANK]
    k_rope = c[..., Q_LORA_RANK + KV_LORA_RANK:]

    q = (rms_norm(c_q, q_norm) @ w_uq).reshape(bsz, seq, MLA_HEADS, QK_NOPE_DIM + QK_ROPE_DIM)
    kv = (rms_norm(c_kv, kv_norm) @ w_ukv).reshape(bsz, seq, MLA_HEADS, QK_NOPE_DIM + V_HEAD_DIM)
    q_nope = rms_norm(q[..., :QK_NOPE_DIM], qn_norm)
    q_rope = apply_rope(rms_norm(q[..., QK_NOPE_DIM:], qr_norm), cos[:, :, None, :], sin[:, :, None, :])
    k_nope = rms_norm(kv[..., :QK_NOPE_DIM], kn_norm)
    v = kv[..., QK_NOPE_DIM:]
    k_rope = apply_rope(rms_norm(k_rope, kr_norm), cos, sin)

    scale = 1.0 / math.sqrt(QK_NOPE_DIM + QK_ROPE_DIM)
    n_blk = seq // Q_BLOCK

    def to_blocks(t):
        return t.reshape(bsz, n_blk, Q_BLOCK, *t.shape[2:]).transpose(1, 0, 2, 3, 4)

    k_idx = jnp.arange(seq)

    def attend(args):
        qn_b, qr_b, start = args
        s = (jnp.einsum('bqhd,bkhd->bhqk', qn_b, k_nope)
             + jnp.einsum('bqhr,bkr->bhqk', qr_b, k_rope)).astype(jnp.float32) * scale
        q_idx = start + jnp.arange(Q_BLOCK)
        mask = k_idx[None, :] <= q_idx[:, None]
        s = jnp.where(mask, s, jnp.finfo(jnp.float32).min)
        p = jax.nn.softmax(s, axis=-1).astype(v.dtype)
        return jnp.einsum('bhqk,bkhd->bqhd', p, v)

    starts = jnp.arange(n_blk, dtype=jnp.int32) * Q_BLOCK
    o = lax.map(attend, (to_blocks(q_nope), to_blocks(q_rope), starts))
    o = o.transpose(1, 0, 2, 3, 4).reshape(bsz, seq, MLA_HEADS * V_HEAD_DIM)
    return o @ w_o


def swiglu_ffn(xn, w_gu, w_down):
    gate, up = jnp.split(xn @ w_gu, 2, axis=-1)
    return (jax.nn.silu(gate) * up) @ w_down


def setup_inputs(seed: int = 0) -> dict:
    key = jax.random.key(seed)
    ks = iter(jax.random.split(key, 40))
    f32 = jnp.float32
    res = (2 * DEPTH) ** -0.5

    def nrm(shape, scale):
        return jax.random.normal(next(ks), shape, f32) * scale

    def gain(shape):
        return 1.0 + 0.05 * jax.random.normal(next(ks), shape, f32)

    x = jax.random.normal(next(ks), (BATCH, SEQ, D_MODEL), f32)
    offset = jax.random.randint(next(ks), (BATCH, 1), 0, 1024, dtype=jnp.int32)
    positions = offset + jnp.arange(SEQ, dtype=jnp.int32)[None, :]

    mix_norm = gain((DEPTH, D_MODEL))

    nA = N_CONV_LAYERS
    conv_w_in = nrm((nA, D_MODEL, 3 * D_MODEL), D_MODEL ** -0.5)
    conv_w = nrm((nA, CONV_WIDTH, D_MODEL), CONV_WIDTH ** -0.5)
    conv_w_out = nrm((nA, D_MODEL, D_MODEL), D_MODEL ** -0.5 * res)

    nB = N_LRU_LAYERS
    lru_w_in = nrm((nB, D_MODEL, 2 * LRU_WIDTH), D_MODEL ** -0.5)
    lru_conv_w = nrm((nB, LRU_CONV_WIDTH, LRU_WIDTH), LRU_CONV_WIDTH ** -0.5)
    lru_conv_b = nrm((nB, LRU_WIDTH), 0.01)
    lru_gate_a_w = nrm((nB, LRU_BLOCKS, LRU_BLOCK_W, LRU_BLOCK_W), LRU_BLOCK_W ** -0.5)
    lru_gate_a_b = nrm((nB, LRU_BLOCKS, LRU_BLOCK_W), 0.01)
    lru_gate_x_w = nrm((nB, LRU_BLOCKS, LRU_BLOCK_W, LRU_BLOCK_W), LRU_BLOCK_W ** -0.5)
    lru_gate_x_b = nrm((nB, LRU_BLOCKS, LRU_BLOCK_W), 0.01)
    a0 = jax.random.uniform(next(ks), (nB, LRU_WIDTH), f32, 0.9, 0.999)
    lru_lambda = jnp.log(a0) - jnp.log1p(-a0)
    lru_w_out = nrm((nB, LRU_WIDTH, D_MODEL), LRU_WIDTH ** -0.5 * res)

    nC = N_MLA_LAYERS
    mla_w_down = nrm((nC, D_MODEL, Q_LORA_RANK + KV_LORA_RANK + QK_ROPE_DIM), D_MODEL ** -0.5)
    mla_q_norm = gain((nC, Q_LORA_RANK))
    mla_kv_norm = gain((nC, KV_LORA_RANK))
    mla_w_uq = nrm((nC, Q_LORA_RANK, MLA_HEADS * (QK_NOPE_DIM + QK_ROPE_DIM)), Q_LORA_RANK ** -0.5)
    mla_w_ukv = nrm((nC, KV_LORA_RANK, MLA_HEADS * (QK_NOPE_DIM + V_HEAD_DIM)), KV_LORA_RANK ** -0.5)
    mla_qn_norm = gain((nC, QK_NOPE_DIM))
    mla_qr_norm = gain((nC, QK_ROPE_DIM))
    mla_kn_norm = gain((nC, QK_NOPE_DIM))
    mla_kr_norm = gain((nC, QK_ROPE_DIM))
    mla_w_o = nrm((nC, MLA_HEADS * V_HEAD_DIM, D_MODEL), (MLA_HEADS * V_HEAD_DIM) ** -0.5 * res)

    ffn_norm = gain((DEPTH, D_MODEL))
    ffn_w_gu = nrm((DEPTH, D_MODEL, 2 * D_FF), D_MODEL ** -0.5)
    ffn_w_down = nrm((DEPTH, D_FF, D_MODEL), D_FF ** -0.5 * res)

    return {'x': x, 'positions': positions, 'mix_norm': mix_norm,
            'conv_w_in': conv_w_in, 'conv_w': conv_w, 'conv_w_out': conv_w_out,
            'lru_w_in': lru_w_in, 'lru_conv_w': lru_conv_w, 'lru_conv_b': lru_conv_b,
            'lru_gate_a_w': lru_gate_a_w, 'lru_gate_a_b': lru_gate_a_b,
            'lru_gate_x_w': lru_gate_x_w, 'lru_gate_x_b': lru_gate_x_b,
            'lru_lambda': lru_lambda, 'lru_w_out': lru_w_out,
            'mla_w_down': mla_w_down, 'mla_q_norm': mla_q_norm, 'mla_kv_norm': mla_kv_norm,
            'mla_w_uq': mla_w_uq, 'mla_w_ukv': mla_w_ukv,
            'mla_qn_norm': mla_qn_norm, 'mla_qr_norm': mla_qr_norm,
            'mla_kn_norm': mla_kn_norm, 'mla_kr_norm': mla_kr_norm, 'mla_w_o': mla_w_o,
            'ffn_norm': ffn_norm, 'ffn_w_gu': ffn_w_gu, 'ffn_w_down': ffn_w_down}


def reference(x, positions, mix_norm, conv_w_in, conv_w, conv_w_out,
              lru_w_in, lru_conv_w, lru_conv_b, lru_gate_a_w, lru_gate_a_b,
              lru_gate_x_w, lru_gate_x_b, lru_lambda, lru_w_out,
              mla_w_down, mla_q_norm, mla_kv_norm, mla_w_uq, mla_w_ukv,
              mla_qn_norm, mla_qr_norm, mla_kn_norm, mla_kr_norm, mla_w_o,
              ffn_norm, ffn_w_gu, ffn_w_down):
    inv_freq = ROPE_THETA ** (-jnp.arange(0, QK_ROPE_DIM, 2, dtype=jnp.float32) / QK_ROPE_DIM)
    angle = positions.astype(jnp.float32)[..., None] * inv_freq
    cos, sin = jnp.cos(angle), jnp.sin(angle)

    h = x
    for i in range(DEPTH):
        kind, j = i % N_MIXERS, i // N_MIXERS
        xn = rms_norm(h, mix_norm[i])
        if kind == 0:
            y = short_conv_mixer(xn, conv_w_in[j], conv_w[j], conv_w_out[j])
        elif kind == 1:
            y = recurrent_mixer(xn, lru_w_in[j], lru_conv_w[j], lru_conv_b[j],
                                lru_gate_a_w[j], lru_gate_a_b[j], lru_gate_x_w[j],
                                lru_gate_x_b[j], lru_lambda[j], lru_w_out[j])
        else:
            y = mla_mixer(xn, cos, sin, mla_w_down[j], mla_q_norm[j], mla_kv_norm[j],
                          mla_w_uq[j], mla_w_ukv[j], mla_qn_norm[j], mla_qr_norm[j],
                          mla_kn_norm[j], mla_kr_norm[j], mla_w_o[j])
        h = h + y
        h = h + swiglu_ffn(rms_norm(h, ffn_norm[i]), ffn_w_gu[i], ffn_w_down[i])
    return h
```

```cpp
#include <hip/hip_runtime.h>
#include <hip/hip_cooperative_groups.h>
#include <cstdio>
namespace cg = cooperative_groups;

#define LAS __attribute__((address_space(3)))
typedef unsigned short bf16_t;
typedef short bf16x8 __attribute__((ext_vector_type(8)));
typedef short s16x4 __attribute__((ext_vector_type(4)));
typedef float f32x2 __attribute__((ext_vector_type(2)));
typedef float f32x4 __attribute__((ext_vector_type(4)));
typedef float f32x16 __attribute__((ext_vector_type(16)));
typedef unsigned u32x2 __attribute__((ext_vector_type(2)));
typedef unsigned u32x4 __attribute__((ext_vector_type(4)));
typedef __bf16 bf2_t __attribute__((ext_vector_type(2)));

constexpr int T = 32768, DM = 1024, SEQ = 4096, NBATCH = 8, DFF = 2816, LW = 1280;
constexpr int NTHREADS = 512;
constexpr float EPS = 1e-6f;
constexpr size_t MiB = 1ull << 20;
constexpr size_t OFF_WCIN = 0;
constexpr size_t OFF_WCOUT = 12 * MiB;
constexpr size_t OFF_WLIN = 16 * MiB;
constexpr size_t OFF_WLG = 21 * MiB;
constexpr size_t OFF_WLOUT = 22 * MiB + MiB / 4;
constexpr size_t OFF_WMD = 24 * MiB + 3 * MiB / 4;
constexpr size_t OFF_WUQ = 26 * MiB + MiB / 4;
constexpr size_t OFF_WUKV = 27 * MiB + 3 * MiB / 8;
constexpr size_t OFF_WO = 28 * MiB + 3 * MiB / 8;
constexpr size_t OFF_WGU = 31 * MiB;
constexpr size_t OFF_WDN = 75 * MiB;
constexpr size_t OFF_HB = 97 * MiB;
constexpr size_t OFF_SSQ = 161 * MiB;
constexpr size_t OFF_CL = OFF_SSQ + 11ull * T * 4;
constexpr size_t OFF_R = 163 * MiB;
constexpr size_t OFF_ACT = OFF_R;
constexpr size_t OFF_U = OFF_R, OFF_BG = OFF_R + 64 * MiB, OFF_Y = OFF_R + 128 * MiB;
constexpr size_t OFF_GATE = OFF_R, OFF_RECB = OFF_R + 80 * MiB, OFF_XS = OFF_R + 160 * MiB, OFF_LA = OFF_R + 240 * MiB, OFF_CARRY = OFF_R + 320 * MiB;
constexpr size_t OFF_CBUF = OFF_R, OFF_OBUF = OFF_R, OFF_QB = OFF_R + 64 * MiB, OFF_KVB = OFF_R + 160 * MiB, OFF_KR = OFF_R + 288 * MiB;
constexpr size_t WS_NEED = OFF_R + 326 * MiB;

struct Params { const void* in[28]; float* out; unsigned char* ws; };
typedef const void* kptr_t;
typedef const __attribute__((address_space(4))) kptr_t* KA;
#define P_IN(i) (ka[(i)])
#define P_OUT ((float*)ka[28])
#define P_WS ((unsigned char*)ka[29])

__device__ __forceinline__ unsigned pk_bf16(float lo, float hi) { bf2_t v = __builtin_convertvector((f32x2){lo, hi}, bf2_t); return __builtin_bit_cast(unsigned, v); }
__device__ __forceinline__ float bf_lo(unsigned w) { return __uint_as_float(w << 16); }
__device__ __forceinline__ float bf_hi(unsigned w) { return __uint_as_float(w & 0xffff0000u); }
__device__ __forceinline__ float bf1(bf16_t b) { return __uint_as_float(((unsigned)b) << 16); }
__device__ __forceinline__ float wave_sum(float v) {
#pragma unroll
    for (int o = 32; o >= 1; o >>= 1) v += __shfl_xor(v, o);
    return v;
}
__device__ __forceinline__ int otid() { int t = threadIdx.x; asm volatile("" : "+v"(t)); return t; }
__device__ __forceinline__ int obid() { int t = blockIdx.x; asm volatile("" : "+s"(t)); return t; }
__device__ __forceinline__ int ogrid() { int t = gridDim.x; asm volatile("" : "+s"(t)); return t; }
__device__ __forceinline__ float fast_sigmoid(float x) { return __builtin_amdgcn_rcpf(1.0f + __expf(-x)); }

namespace pg8 {
constexpr int BM = 256, BK = 64, HALF = 128, HTB = HALF * BK * 2, STAGE_BYTES = 8 * HTB, NXCD = 8, WGM = 8;
__device__ __forceinline__ int lds_byte(int r, int c) { const int st = (r >> 4) * 2 + (c >> 5), rr = r & 15, cc = c & 31, ob = rr * 64 + cc * 2; return st * 1024 + (ob ^ (((ob >> 9) & 1) << 5)); }
__device__ __forceinline__ void stage_rc(int b, int& R, int& C) { const int st = b / 1024, sb = b % 1024, swz = sb ^ (((sb >> 9) & 1) << 5); R = (st >> 1) * 16 + swz / 64; C = (st & 1) * 32 + (swz % 64) / 2; }
__device__ __forceinline__ int perm32(int rho) { const int n = rho >> 4, i = rho & 15; return 8 * (i >> 2) + 4 * n + (i & 3); }
struct Unit { int pm, pn; };
struct Gemm { const bf16_t* A; const bf16_t* Bt; int M, N, K, lda, akoff; };
struct StaticOrder {
    int nM, nN, nwg, G, c;
    __device__ void init(int M, int N, int G_, int c_) { nM = M / BM; nN = N / BM; nwg = nM * nN; G = G_; c = c_; }
    __device__ bool next(int i, Unit& u) const {
        const long L = (long)i * G + c; if (L >= nwg) return false;
        int wgid = (int)L; { const int q = nwg / NXCD, r = nwg % NXCD, xcd = wgid % NXCD, off = wgid / NXCD; wgid = (xcd < r ? xcd * (q + 1) : r * (q + 1) + (xcd - r) * q) + off; }
        const int nig = WGM * nN, gid = wgid / nig, fm = gid * WGM, gsz = (nM - fm) < WGM ? (nM - fm) : WGM;
        u.pm = fm + ((wgid % nig) % gsz); u.pn = (wgid % nig) / gsz; return true;
    }
};

template <class Epi>
__device__ __forceinline__ void gemm_phase(LAS unsigned char* lds, const Gemm g, const StaticOrder& S, const Epi& E) {
    const int tid = otid(), wid = __builtin_amdgcn_readfirstlane(tid >> 6), lane = tid & 63, wr = wid >> 2, wc = wid & 3, fr = lane & 15, fq = lane >> 4;
    const int K = g.K, nt = K / BK, lda = g.lda;
    unsigned voffA[2], voffB[2];
#pragma unroll
    for (int i = 0; i < 2; ++i) { int R, C; stage_rc(tid * 16 + i * 8192, R, C); const int Rb = Epi::PERM ? ((R & ~31) + perm32(R & 31)) : R;
        voffA[i] = (unsigned)(R * lda + C) * 2u; voffB[i] = (unsigned)(Rb * K + C) * 2u; }
    const size_t kstep = (size_t)(BK * 2);
    const size_t hstepA = (size_t)HALF * lda * 2, hstepB = (size_t)HALF * K * 2;
    const size_t tstepA = 2 * hstepA, tstepB = 2 * hstepB;
    const size_t akoffb = (size_t)g.akoff * 2;
    const unsigned ldsw = (unsigned)wid * 1024u;
    const int aoff = lds_byte(wr * 64 + fr, fq * 8), boff = lds_byte(wc * 32 + fr, fq * 8);
#define PG8_SA(b, h) (((b) * 2 + (h)) * HTB)
#define PG8_SB(b, h) ((4 + (b) * 2 + (h)) * HTB)
#define PG8_STAGE(bufoff, gbase, voff) do { _Pragma("unroll") for (int _i = 0; _i < 2; ++_i) \
        __builtin_amdgcn_global_load_lds((const unsigned*)((const char*)(gbase) + (voff)[_i]), (LAS unsigned*)(lds + (bufoff) + ldsw + _i * 8192), 16, 0, 0); } while (0)
#define PG8_LDA(dst, b, h) do { _Pragma("unroll") for (int m = 0; m < 4; ++m) _Pragma("unroll") for (int k = 0; k < 2; ++k) dst[m][k] = *(const LAS bf16x8*)(lds + PG8_SA(b, h) + aoff + m * 2048 + k * 1024); } while (0)
#define PG8_LDB(dst, b, h) do { _Pragma("unroll") for (int n = 0; n < 2; ++n) _Pragma("unroll") for (int k = 0; k < 2; ++k) dst[n][k] = *(const LAS bf16x8*)(lds + PG8_SB(b, h) + boff + n * 2048 + k * 1024); } while (0)
#define PG8_MMA(ai, bj, At, Bt) do { __builtin_amdgcn_s_setprio(1); _Pragma("unroll") for (int m = 0; m < 4; ++m) _Pragma("unroll") for (int n = 0; n < 2; ++n) _Pragma("unroll") for (int k = 0; k < 2; ++k) \
        acc[ai][bj][m][n] = __builtin_amdgcn_mfma_f32_16x16x32_bf16(Bt[n][k], At[m][k], acc[ai][bj][m][n], 0, 0, 0); __builtin_amdgcn_s_setprio(0); } while (0)
#define PG8_WAIT_V(n) asm volatile("s_waitcnt vmcnt(" #n ")" ::: "memory")
#define PG8_WAIT_L(n) asm volatile("s_waitcnt lgkmcnt(" #n ")" ::: "memory")
#define PG8_BAR __builtin_amdgcn_s_barrier()
#define PG8_SCHED __builtin_amdgcn_sched_barrier(0)
    Unit cur, nxt; int ui = 0;
    if (!S.next(0, cur)) return;
    f32x4 acc[2][2][4][2];
#pragma unroll
    for (int a = 0; a < 2; ++a)
#pragma unroll
        for (int b = 0; b < 2; ++b)
#pragma unroll
            for (int m = 0; m < 4; ++m)
#pragma unroll
                for (int n = 0; n < 2; ++n) acc[a][b][m][n] = (f32x4){0.f, 0.f, 0.f, 0.f};
    bf16x8 At[4][2], B0[2][2], B1[2][2];
    const char* cA = (const char*)g.A + (size_t)cur.pm * tstepA + (size_t)(cur.pn >> 1) * akoffb; const char* cB = (const char*)g.Bt + (size_t)cur.pn * tstepB;
    PG8_STAGE(PG8_SB(0, 0), cB, voffB); PG8_STAGE(PG8_SA(0, 0), cA, voffA); PG8_STAGE(PG8_SB(0, 1), cB + hstepB, voffB); PG8_STAGE(PG8_SA(0, 1), cA + hstepA, voffA);
    if (wr == 1) PG8_BAR;
    PG8_WAIT_V(4); PG8_BAR;
    PG8_STAGE(PG8_SB(1, 0), cB + kstep, voffB); PG8_STAGE(PG8_SA(1, 0), cA + kstep, voffA); PG8_STAGE(PG8_SB(1, 1), cB + hstepB + kstep, voffB);
    PG8_WAIT_V(6); PG8_BAR;
    for (;;) {
        const bool has_next = S.next(ui + 1, nxt);
        const char* nA = has_next ? (const char*)g.A + (size_t)nxt.pm * tstepA + (size_t)(nxt.pn >> 1) * akoffb : cA; const char* nB = has_next ? (const char*)g.Bt + (size_t)nxt.pn * tstepB : cB;
        for (int t = 0; t < nt; t += 2) {
            const bool last = (t == nt - 2);
            const char* a1 = cA + (size_t)(t + 1) * kstep;
            const char* a2 = last ? nA : cA + (size_t)(t + 2) * kstep; const char* b2 = last ? nB : cB + (size_t)(t + 2) * kstep;
            const char* a3 = a2 + kstep; const char* b3 = b2 + kstep;
            PG8_LDB(B0, 0, 0); PG8_SCHED; PG8_LDA(At, 0, 0); PG8_STAGE(PG8_SA(1, 1), a1 + hstepA, voffA);
            PG8_WAIT_L(8); PG8_BAR; PG8_WAIT_L(0); PG8_MMA(0, 0, At, B0); PG8_BAR; PG8_SCHED;
            PG8_LDB(B1, 0, 1); PG8_STAGE(PG8_SB(0, 0), b2, voffB);
            PG8_BAR; PG8_WAIT_L(0); PG8_MMA(0, 1, At, B1); PG8_BAR;
            PG8_LDA(At, 0, 1); PG8_STAGE(PG8_SA(0, 0), a2, voffA);
            PG8_BAR; PG8_WAIT_L(0); PG8_MMA(1, 0, At, B0); PG8_BAR; PG8_SCHED;
            PG8_STAGE(PG8_SB(0, 1), b2 + hstepB, voffB);
            PG8_WAIT_V(6); PG8_BAR; PG8_MMA(1, 1, At, B1); PG8_BAR;
            PG8_LDB(B0, 1, 0); PG8_SCHED; PG8_LDA(At, 1, 0); PG8_STAGE(PG8_SA(0, 1), a2 + hstepA, voffA);
            PG8_WAIT_L(8); PG8_BAR; PG8_WAIT_L(0); PG8_MMA(0, 0, At, B0); PG8_BAR; PG8_SCHED;
            PG8_LDB(B1, 1, 1); PG8_STAGE(PG8_SB(1, 0), b3, voffB);
            PG8_BAR; PG8_WAIT_L(0); PG8_MMA(0, 1, At, B1); PG8_BAR;
            PG8_LDA(At, 1, 1); PG8_STAGE(PG8_SA(1, 0), a3, voffA);
            PG8_BAR; PG8_WAIT_L(0); PG8_MMA(1, 0, At, B0); PG8_BAR; PG8_SCHED;
            PG8_STAGE(PG8_SB(1, 1), b3 + hstepB, voffB);
            PG8_WAIT_V(6); PG8_BAR; PG8_MMA(1, 1, At, B1); PG8_BAR;
        }
        E(acc, cur, wr, wc, fr, fq);
        if (!has_next) break;
#pragma unroll
        for (int a = 0; a < 2; ++a)
#pragma unroll
            for (int b = 0; b < 2; ++b)
#pragma unroll
                for (int m = 0; m < 4; ++m)
#pragma unroll
                    for (int n = 0; n < 2; ++n) acc[a][b][m][n] = (f32x4){0.f, 0.f, 0.f, 0.f};
        cur = nxt; cA = nA; cB = nB; ++ui;
    }
    PG8_WAIT_V(0);
    if (wr == 0) PG8_BAR;
    PG8_BAR;
#undef PG8_SA
#undef PG8_SB
#undef PG8_STAGE
#undef PG8_LDA
#undef PG8_LDB
#undef PG8_MMA
#undef PG8_WAIT_V
#undef PG8_WAIT_L
#undef PG8_BAR
#undef PG8_SCHED
}
}

struct EP {
    bf16_t* o0; bf16_t* o1; int ld0, ld1, split, mode, type;
    const float* rs; float inv_dim;
    float* ssq0; float* ssq1;
    const float* resid; float* fout;
    const bf16_t* xs; const float* ba; const float* bx; const float* cl;
};
__device__ __forceinline__ void load_rstd(const EP& p, int row0, float (&rstd)[2][4]) {
#pragma unroll
    for (int ai = 0; ai < 2; ++ai)
#pragma unroll
        for (int m = 0; m < 4; ++m) rstd[ai][m] = p.rs ? rsqrtf(p.rs[row0 + ai * 128 + m * 16] * p.inv_dim + EPS) : 1.0f;
}
__device__ __forceinline__ u32x4 pack8(const f32x4 a, const f32x4 b) { u32x4 w; w.x = pk_bf16(a[0], a[1]); w.y = pk_bf16(a[2], a[3]); w.z = pk_bf16(b[0], b[1]); w.w = pk_bf16(b[2], b[3]); return w; }

struct EpiAll {
    static constexpr bool PERM = true;
    EP p;
    __device__ __forceinline__ void operator()(const f32x4 (&acc)[2][2][4][2], const pg8::Unit& u, int wr, int wc, int fr, int fq) const {
        const int row0 = u.pm * 256 + wr * 64 + fr;
        if (p.type == 0) {
            float rstd[2][4]; load_rstd(p, row0, rstd);
            if (u.pn < p.split) {
                const int col = u.pn * 128 + wc * 32 + fq * 8;
#pragma unroll
                for (int ai = 0; ai < 2; ++ai)
#pragma unroll
                    for (int m = 0; m < 4; ++m) {
                        const float r = rstd[ai][m];
                        f32x4 v[2];
#pragma unroll
                        for (int n = 0; n < 2; ++n) {
                            const f32x4 g = acc[ai][0][m][n] * r, uu = acc[ai][1][m][n] * r;
                            if (p.mode == 0) {
#pragma unroll
                                for (int j = 0; j < 4; ++j) v[n][j] = g[j] * fast_sigmoid(g[j]) * uu[j];
                            } else v[n] = g * uu;
                        }
                        *(u32x4*)(p.o0 + (size_t)(row0 + ai * 128 + m * 16) * p.ld0 + col) = pack8(v[0], v[1]);
                    }
            } else {
                const int col = (u.pn - p.split) * 256 + wc * 32 + fq * 8;
#pragma unroll
                for (int ai = 0; ai < 2; ++ai)
#pragma unroll
                    for (int m = 0; m < 4; ++m) {
                        const float r = rstd[ai][m];
#pragma unroll
                        for (int bj = 0; bj < 2; ++bj)
                            *(u32x4*)(p.o1 + (size_t)(row0 + ai * 128 + m * 16) * p.ld1 + col + bj * 128) = pack8(acc[ai][bj][m][0] * r, acc[ai][bj][m][1] * r);
                    }
            }
        } else if (p.type == 1) {
            float rstd[2][4]; load_rstd(p, row0, rstd);
            const bool second = u.pn >= p.split;
            bf16_t* ob = second ? p.o1 : p.o0; const int ld = second ? p.ld1 : p.ld0;
            const int col = (second ? u.pn - p.split : u.pn) * 256 + wc * 32 + fq * 8;
            const bool gelu = (p.mode == 1) && !second;
#pragma unroll
            for (int ai = 0; ai < 2; ++ai)
#pragma unroll
                for (int m = 0; m < 4; ++m) {
                    const float r = rstd[ai][m]; const int row = row0 + ai * 128 + m * 16;
                    float sq[2];
#pragma unroll
                    for (int bj = 0; bj < 2; ++bj) {
                        f32x4 v0 = acc[ai][bj][m][0] * r, v1 = acc[ai][bj][m][1] * r;
                        if (gelu) {
#pragma unroll
                            for (int j = 0; j < 4; ++j) {
                                const float a = v0[j], b = v1[j];
                                v0[j] = a * fast_sigmoid(1.5957691216f * (a + 0.044715f * a * a * a));
                                v1[j] = b * fast_sigmoid(1.5957691216f * (b + 0.044715f * b * b * b));
                            }
                        }
                        sq[bj] = (v0[0] * v0[0] + v0[1] * v0[1]) + (v0[2] * v0[2] + v0[3] * v0[3]) + (v1[0] * v1[0] + v1[1] * v1[1]) + (v1[2] * v1[2] + v1[3] * v1[3]);
                        *(u32x4*)(ob + (size_t)row * ld + col + bj * 128) = pack8(v0, v1);
                    }
                    if (p.mode == 2) {
                        float s = (u.pn == 2) ? sq[0] : sq[0] + sq[1];
                        s += __shfl_xor(s, 16); s += __shfl_xor(s, 32);
                        if (fq == 0) atomicAdd((u.pn == 0 ? p.ssq0 : p.ssq1) + row, s);
                    }
                }
        } else if (p.type == 2) {
            const int col0 = u.pn * 256 + wc * 32 + 8 * fq;
#pragma unroll
            for (int ai = 0; ai < 2; ++ai)
#pragma unroll
                for (int m = 0; m < 4; ++m) {
                    const int row = row0 + ai * 128 + m * 16; const size_t off = (size_t)row * DM + col0;
                    float s = 0.f;
#pragma unroll
                    for (int bj = 0; bj < 2; ++bj) {
                        const f32x4 b0 = *(const f32x4*)(p.resid + off + bj * 128), b1 = *(const f32x4*)(p.resid + off + bj * 128 + 4);
                        const f32x4 o0 = b0 + acc[ai][bj][m][0], o1 = b1 + acc[ai][bj][m][1];
                        *(f32x4*)(p.fout + off + bj * 128) = o0; *(f32x4*)(p.fout + off + bj * 128 + 4) = o1;
                        *(u32x4*)(p.o0 + off + bj * 128) = pack8(o0, o1);
                        s += (o0[0] * o0[0] + o0[1] * o0[1]) + (o0[2] * o0[2] + o0[3] * o0[3]) + (o1[0] * o1[0] + o1[1] * o1[1]) + (o1[2] * o1[2] + o1[3] * o1[3]);
                    }
                    s += __shfl_xor(s, 16); s += __shfl_xor(s, 32);
                    if (fq == 0) atomicAdd(p.ssq0 + row, s);
                    asm volatile("" ::: "memory");
                }
        } else {
            const int col = u.pn * 128 + wc * 32 + fq * 8;
#pragma unroll
            for (int n = 0; n < 2; ++n) {
                const f32x4 ba = *(const f32x4*)(p.ba + col + 4 * n), bx = *(const f32x4*)(p.bx + col + 4 * n), cl = *(const f32x4*)(p.cl + col + 4 * n);
#pragma unroll
                for (int ai = 0; ai < 2; ++ai)
#pragma unroll
                    for (int m = 0; m < 4; ++m) {
                        const size_t off = (size_t)(row0 + ai * 128 + m * 16) * LW + col + 4 * n;
                        const u32x2 xw = *(const u32x2*)(p.xs + off);
                        const float xv[4] = {bf_lo(xw.x), bf_hi(xw.x), bf_lo(xw.y), bf_hi(xw.y)};
                        f32x4 la, bb;
#pragma unroll
                        for (int j = 0; j < 4; ++j) {
                            const float r = fast_sigmoid(acc[ai][0][m][n][j] + ba[j]), ig = fast_sigmoid(acc[ai][1][m][n][j] + bx[j]);
                            const float l = r * cl[j];
                            const float a2 = __builtin_amdgcn_exp2f(2.0f * l);
                            la[j] = l; bb[j] = sqrtf(fmaxf(1.0f - a2, 0.f)) * ig * xv[j];
                        }
                        u32x2 w0, w1; w0.x = pk_bf16(la[0], la[1]); w0.y = pk_bf16(la[2], la[3]); w1.x = pk_bf16(bb[0], bb[1]); w1.y = pk_bf16(bb[2], bb[3]);
                        *(u32x2*)(p.o0 + off) = w0;
                        *(u32x2*)(p.o1 + off) = w1;
                    }
            }
        }
    }
};

struct Job { const float* src; int K, ldsrc; bf16_t* dst; int ndst; const float* gain; int perm; };
__device__ __forceinline__ int src_col(int perm, int n0, int nsrc) {
    const int tile = n0 >> 8, r = n0 & 255;
    if (perm == 1) return r < 128 ? 128 * tile + r : DFF + 128 * tile + (r - 128);
    if (perm == 2) return tile < 8 ? (r < 128 ? 1024 + 128 * tile + r : 2048 + 128 * tile + (r - 128)) : (tile - 8) * 256 + r;
    if (perm == 3) return n0 < 256 ? 384 + n0 : (n0 < 640 ? n0 - 256 : (n0 == 640 ? 640 : -1));
    return n0 < nsrc ? n0 : -1;
}
__device__ __forceinline__ void get_job(KA ka, int j, Job& jb) {
    unsigned char* const ws = P_WS;
    const float* mixn = (const float*)P_IN(2); const float* ffnn = (const float*)P_IN(25);
        if (j < 2) { jb = Job{(const float*)P_IN(3) + (size_t)j * DM * 3072, DM, 3072, (bf16_t*)(ws + OFF_WCIN) + (size_t)j * 3072 * DM, 3072, mixn + (j == 0 ? 0 : 3) * DM, 2}; }
    else if (j < 4) { const int i = j - 2; jb = Job{(const float*)P_IN(5) + (size_t)i * DM * DM, DM, DM, (bf16_t*)(ws + OFF_WCOUT) + (size_t)i * DM * DM, DM, nullptr, 0}; }
    else if (j == 4) jb = Job{(const float*)P_IN(6), DM, 2 * LW, (bf16_t*)(ws + OFF_WLIN), 2 * LW, mixn + 1 * DM, 0};
    else if (j == 5) jb = Job{(const float*)P_IN(14), LW, DM, (bf16_t*)(ws + OFF_WLOUT), DM, nullptr, 0};
    else if (j == 6) jb = Job{(const float*)P_IN(15), DM, 704, (bf16_t*)(ws + OFF_WMD), 768, mixn + 2 * DM, 3};
    else if (j == 7) jb = Job{(const float*)P_IN(18), 384, 1536, (bf16_t*)(ws + OFF_WUQ), 1536, (const float*)P_IN(16), 0};
    else if (j == 8) jb = Job{(const float*)P_IN(19), 256, 2048, (bf16_t*)(ws + OFF_WUKV), 2048, (const float*)P_IN(17), 0};
    else if (j == 9) jb = Job{(const float*)P_IN(24), DM, DM, (bf16_t*)(ws + OFF_WO), DM, nullptr, 0};
    else if (j < 14) { const int i = j - 10; jb = Job{(const float*)P_IN(26) + (size_t)i * DM * 2 * DFF, DM, 2 * DFF, (bf16_t*)(ws + OFF_WGU) + (size_t)i * 2 * DFF * DM, 2 * DFF, ffnn + i * DM, 1}; }
    else { const int i = j - 14; jb = Job{(const float*)P_IN(27) + (size_t)i * DFF * DM, DFF, DM, (bf16_t*)(ws + OFF_WDN) + (size_t)i * DM * DFF, DM, nullptr, 0}; }
}
__device__ void phase0(KA ka, LAS unsigned char* lds) {
    unsigned char* const ws = P_WS;
    const int tid = otid(), G = ogrid(), bx = obid(), lane = tid & 63, wid = tid >> 6;
    { float* z = (float*)(ws + OFF_SSQ) + T; const int n = 10 * T; for (int i = bx * NTHREADS + tid; i < n; i += G * NTHREADS) z[i] = 0.f; }
    if (bx == 0) { const float* lam = (const float*)P_IN(13); float* cl = (float*)(ws + OFF_CL); for (int c = tid; c < LW; c += NTHREADS) cl[c] = -8.0f * 1.4426950408889634f * log1pf(expf(-lam[c])); }
    { bf16_t* wlg = (bf16_t*)(ws + OFF_WLG); const float* wa = (const float*)P_IN(9); const float* wx = (const float*)P_IN(11);
      for (int i = bx * NTHREADS + tid; i < 2560 * 256; i += G * NTHREADS) { const int k = i & 255, row = i >> 8, n = row >> 8, gsel = (row >> 7) & 1, e = row & 127;
          float v = 0.f; if ((k >> 7) == (n & 1)) v = (gsel ? wx : wa)[((size_t)n * 128 + (k & 127)) * 128 + e];
          wlg[i] = (bf16_t)(pk_bf16(v, 0.f) & 0xffffu); } }
    { const float* x = (const float*)P_IN(0); bf16_t* hb = (bf16_t*)(ws + OFF_HB); float* ssq = (float*)(ws + OFF_SSQ);
      for (int row = bx * 8 + wid; row < T; row += G * 8) { float s = 0.f;
#pragma unroll
          for (int i = 0; i < 4; ++i) { const f32x4 v = *(const f32x4*)(x + (size_t)row * DM + i * 256 + lane * 4); s += (v[0] * v[0] + v[1] * v[1]) + (v[2] * v[2] + v[3] * v[3]);
              u32x2 w; w.x = pk_bf16(v[0], v[1]); w.y = pk_bf16(v[2], v[3]); *(u32x2*)(hb + (size_t)row * DM + i * 256 + lane * 4) = w; }
          s = wave_sum(s); if (lane == 0) ssq[row] = s; } }
    LAS float* tile = (LAS float*)lds;
    for (int j = 0; j < 18; ++j) {
        Job jb; get_job(ka, j, jb);
        const int tk = jb.K / 64, tn = jb.ndst / 64, ntile = tk * tn;
        for (int t = bx; t < ntile; t += G) {
            const int k0 = (t % tk) * 64, n0 = (t / tk) * 64; const int sc = src_col(jb.perm, n0, jb.ldsrc);
            __syncthreads();
#pragma unroll
            for (int i = 0; i < 8; ++i) { const int k = i * 8 + (tid >> 6), n = tid & 63; tile[k * 65 + n] = sc >= 0 ? jb.src[(size_t)(k0 + k) * jb.ldsrc + sc + n] : 0.f; }
            __syncthreads();
            const int n = tid >> 3, kc = (tid & 7) * 8; float v[8];
#pragma unroll
            for (int i = 0; i < 8; ++i) v[i] = tile[(kc + i) * 65 + n] * (jb.gain ? jb.gain[k0 + kc + i] : 1.0f);
            u32x4 w; w.x = pk_bf16(v[0], v[1]); w.y = pk_bf16(v[2], v[3]); w.z = pk_bf16(v[4], v[5]); w.w = pk_bf16(v[6], v[7]);
            *(u32x4*)(jb.dst + (size_t)(n0 + n) * jb.K + k0 + kc) = w;
        }
    }
    __syncthreads();
}

__device__ void conv3_phase(KA ka, const float* cw) {
    unsigned char* const ws = P_WS;
    const bf16_t* U = (const bf16_t*)(ws + OFF_U); const bf16_t* BG = (const bf16_t*)(ws + OFF_BG); bf16_t* Y = (bf16_t*)(ws + OFF_Y);
    const int nitem = (T / 16) * 128;
    const int gstride = ogrid() * NTHREADS;
    for (int id = obid() * NTHREADS + otid(); id < nitem; id += gstride) {
        const int cgp = id & 127, rc = id >> 7, c0 = cgp * 8, t0 = rc * 16;
        float w0[8], w1[8], w2[8], um2[8], um1[8];
#pragma unroll
        for (int j = 0; j < 8; ++j) { w0[j] = cw[c0 + j]; w1[j] = cw[DM + c0 + j]; w2[j] = cw[2 * DM + c0 + j]; um2[j] = 0.f; um1[j] = 0.f; }
        if ((t0 & (SEQ - 1)) != 0) {
            const u32x4 a = *(const u32x4*)(U + (size_t)(t0 - 2) * DM + c0), b = *(const u32x4*)(U + (size_t)(t0 - 1) * DM + c0);
            um2[0] = bf_lo(a.x); um2[1] = bf_hi(a.x); um2[2] = bf_lo(a.y); um2[3] = bf_hi(a.y); um2[4] = bf_lo(a.z); um2[5] = bf_hi(a.z); um2[6] = bf_lo(a.w); um2[7] = bf_hi(a.w);
            um1[0] = bf_lo(b.x); um1[1] = bf_hi(b.x); um1[2] = bf_lo(b.y); um1[3] = bf_hi(b.y); um1[4] = bf_lo(b.z); um1[5] = bf_hi(b.z); um1[6] = bf_lo(b.w); um1[7] = bf_hi(b.w);
        }
#pragma unroll 4
        for (int r = 0; r < 16; ++r) {
            const size_t off = (size_t)(t0 + r) * DM + c0;
            const u32x4 a = *(const u32x4*)(U + off), g = *(const u32x4*)(BG + off);
            const float uc[8] = {bf_lo(a.x), bf_hi(a.x), bf_lo(a.y), bf_hi(a.y), bf_lo(a.z), bf_hi(a.z), bf_lo(a.w), bf_hi(a.w)};
            const float gv[8] = {bf_lo(g.x), bf_hi(g.x), bf_lo(g.y), bf_hi(g.y), bf_lo(g.z), bf_hi(g.z), bf_lo(g.w), bf_hi(g.w)};
            float y[8];
#pragma unroll
            for (int j = 0; j < 8; ++j) { y[j] = gv[j] * (w0[j] * um2[j] + w1[j] * um1[j] + w2[j] * uc[j]); um2[j] = um1[j]; um1[j] = uc[j]; }
            u32x4 w; w.x = pk_bf16(y[0], y[1]); w.y = pk_bf16(y[2], y[3]); w.z = pk_bf16(y[4], y[5]); w.w = pk_bf16(y[6], y[7]);
            *(u32x4*)(Y + off) = w;
        }
    }
}
__device__ void conv4_phase(KA ka) {
    unsigned char* const ws = P_WS;
    const bf16_t* R = (const bf16_t*)(ws + OFF_RECB); bf16_t* XS = (bf16_t*)(ws + OFF_XS);
    const float* cw = (const float*)P_IN(7); const float* cb = (const float*)P_IN(8);
    const int nitem = (T / 16) * 160;
    const int gstride = ogrid() * NTHREADS;
    for (int id = obid() * NTHREADS + otid(); id < nitem; id += gstride) {
        const int cgp = id % 160, rc = id / 160, c0 = cgp * 8, t0 = rc * 16;
        float w0[8], w1[8], w2[8], w3[8], bs[8], x3[8], x2[8], x1[8];
#pragma unroll
        for (int j = 0; j < 8; ++j) { w0[j] = cw[c0 + j]; w1[j] = cw[LW + c0 + j]; w2[j] = cw[2 * LW + c0 + j]; w3[j] = cw[3 * LW + c0 + j]; bs[j] = cb[c0 + j]; x3[j] = 0.f; x2[j] = 0.f; x1[j] = 0.f; }
        if ((t0 & (SEQ - 1)) != 0) {
            const u32x4 a = *(const u32x4*)(R + (size_t)(t0 - 3) * LW + c0), b = *(const u32x4*)(R + (size_t)(t0 - 2) * LW + c0), c = *(const u32x4*)(R + (size_t)(t0 - 1) * LW + c0);
            x3[0] = bf_lo(a.x); x3[1] = bf_hi(a.x); x3[2] = bf_lo(a.y); x3[3] = bf_hi(a.y); x3[4] = bf_lo(a.z); x3[5] = bf_hi(a.z); x3[6] = bf_lo(a.w); x3[7] = bf_hi(a.w);
            x2[0] = bf_lo(b.x); x2[1] = bf_hi(b.x); x2[2] = bf_lo(b.y); x2[3] = bf_hi(b.y); x2[4] = bf_lo(b.z); x2[5] = bf_hi(b.z); x2[6] = bf_lo(b.w); x2[7] = bf_hi(b.w);
            x1[0] = bf_lo(c.x); x1[1] = bf_hi(c.x); x1[2] = bf_lo(c.y); x1[3] = bf_hi(c.y); x1[4] = bf_lo(c.z); x1[5] = bf_hi(c.z); x1[6] = bf_lo(c.w); x1[7] = bf_hi(c.w);
        }
#pragma unroll 4
        for (int r = 0; r < 16; ++r) {
            const size_t off = (size_t)(t0 + r) * LW + c0;
            const u32x4 a = *(const u32x4*)(R + off);
            const float xc[8] = {bf_lo(a.x), bf_hi(a.x), bf_lo(a.y), bf_hi(a.y), bf_lo(a.z), bf_hi(a.z), bf_lo(a.w), bf_hi(a.w)};
            float y[8];
#pragma unroll
            for (int j = 0; j < 8; ++j) { y[j] = bs[j] + w0[j] * x3[j] + w1[j] * x2[j] + w2[j] * x1[j] + w3[j] * xc[j]; x3[j] = x2[j]; x2[j] = x1[j]; x1[j] = xc[j]; }
            u32x4 w; w.x = pk_bf16(y[0], y[1]); w.y = pk_bf16(y[2], y[3]); w.z = pk_bf16(y[4], y[5]); w.w = pk_bf16(y[6], y[7]);
            *(u32x4*)(XS + off) = w;
        }
    }
}
__device__ void scan1_phase(KA ka) {
    unsigned char* const ws = P_WS;
    const unsigned* LA = (const unsigned*)(ws + OFF_LA); const unsigned* BB = (const unsigned*)(ws + OFF_RECB);
    f32x2* CA = (f32x2*)(ws + OFF_CARRY); f32x2* CH = CA + NBATCH * 64 * 640;
    const int nitem = NBATCH * 64 * 640;
    const int gstride = ogrid() * NTHREADS;
    for (int id = obid() * NTHREADS + otid(); id < nitem; id += gstride) {
        const int cp = id % 640, bj = id / 640;
        const size_t base = (size_t)bj * 64 * 640 + cp;
        float s0 = 0.f, s1 = 0.f, h0 = 0.f, h1 = 0.f;
#pragma unroll 8
        for (int t = 0; t < 64; ++t) {
            const unsigned l = LA[base + (size_t)t * 640], b = BB[base + (size_t)t * 640];
            const float l0 = bf_lo(l), l1 = bf_hi(l);
            s0 += l0; s1 += l1;
            h0 = __builtin_amdgcn_exp2f(l0) * h0 + bf_lo(b); h1 = __builtin_amdgcn_exp2f(l1) * h1 + bf_hi(b);
        }
        CA[id] = (f32x2){s0, s1}; CH[id] = (f32x2){h0, h1};
    }
}
__device__ void scan2_phase(KA ka) {
    unsigned char* const ws = P_WS;
    const unsigned* LA = (const unsigned*)(ws + OFF_LA); const unsigned* BB = (const unsigned*)(ws + OFF_RECB); unsigned* GT = (unsigned*)(ws + OFF_GATE);
    const f32x2* CA = (const f32x2*)(ws + OFF_CARRY); const f32x2* CH = CA + NBATCH * 64 * 640;
    const int nitem = NBATCH * 64 * 640;
    const int gstride = ogrid() * NTHREADS;
    for (int id = obid() * NTHREADS + otid(); id < nitem; id += gstride) {
        const int cp = id % 640, bj = id / 640, j = bj & 63, b0 = bj - j;
        float h0 = 0.f, h1 = 0.f;
        for (int jj = 0; jj < j; ++jj) { const f32x2 a = CA[(size_t)(b0 + jj) * 640 + cp], hh = CH[(size_t)(b0 + jj) * 640 + cp];
            h0 = __builtin_amdgcn_exp2f(a.x) * h0 + hh.x; h1 = __builtin_amdgcn_exp2f(a.y) * h1 + hh.y; }
        const size_t base = (size_t)bj * 64 * 640 + cp;
#pragma unroll 8
        for (int t = 0; t < 64; ++t) {
            const size_t o = base + (size_t)t * 640;
            const unsigned l = LA[o], b = BB[o], g = GT[o];
            h0 = __builtin_amdgcn_exp2f(bf_lo(l)) * h0 + bf_lo(b); h1 = __builtin_amdgcn_exp2f(bf_hi(l)) * h1 + bf_hi(b);
            GT[o] = pk_bf16(bf_lo(g) * h0, bf_hi(g) * h1);
        }
    }
}
__device__ void prep_phase(KA ka) {
    unsigned char* const ws = P_WS;
    const int tid = otid(), lane = tid & 63, wid = tid >> 6, G = ogrid(), bx = obid();
    bf16_t* QB = (bf16_t*)(ws + OFF_QB); bf16_t* KVB = (bf16_t*)(ws + OFF_KVB); bf16_t* KR = (bf16_t*)(ws + OFF_KR); const bf16_t* CB = (const bf16_t*)(ws + OFF_CBUF);
    const int* pos = (const int*)P_IN(1);
    const float* qn = (const float*)P_IN(20); const float* qr = (const float*)P_IN(21); const float* kn = (const float*)P_IN(22); const float* kr = (const float*)P_IN(23);
    const float QS = 0.07216878364870322f * 1.4426950408889634f;
    const float qn0 = qn[2 * lane], qn1 = qn[2 * lane + 1], kn0 = kn[2 * lane], kn1 = kn[2 * lane + 1], qrg = qr[lane], krg = kr[lane];
    const float inv_freq = exp2f(-(float)(lane & 31) * (13.287712379549449f / 32.0f));
    for (int t = bx * 8 + wid; t < T; t += G * 8) {
        const float ang = (float)pos[t] * inv_freq;
        const float nrev = rintf(ang * 0.15915494309189535f);
        float rr = fmaf(-nrev, 6.2831854820251465f, ang); rr = fmaf(-nrev, -1.7484556000744883e-07f, rr);
        const float sn = __sinf(rr), cs = __cosf(rr);
        {
            const float x = bf1(CB[(size_t)t * 768 + 640 + lane]);
            const float rstd = rsqrtf(wave_sum(x * x) * (1.0f / 64.0f) + EPS);
            const float xr = x * rstd * krg, pr = __shfl_xor(xr, 32);
            const float o = lane < 32 ? xr * cs - pr * sn : xr * cs + pr * sn;
            KR[(size_t)t * 64 + lane] = (bf16_t)(pk_bf16(o, 0.f) & 0xffffu);
        }
#pragma unroll 2
        for (int h = 0; h < 8; ++h) {
            unsigned* qp = (unsigned*)(QB + (size_t)t * 1536 + h * 192) + lane;
            const unsigned qw = *qp; const float q0 = bf_lo(qw), q1 = bf_hi(qw);
            bf16_t* qrp = QB + (size_t)t * 1536 + h * 192 + 128 + lane; const float xq = bf1(*qrp);
            unsigned* kp = (unsigned*)(KVB + (size_t)t * 2048 + h * 256) + lane;
            const unsigned kw = *kp; const float k0 = bf_lo(kw), k1 = bf_hi(kw);
            const float rq = rsqrtf(wave_sum(q0 * q0 + q1 * q1) * (1.0f / 128.0f) + EPS) * QS;
            const float rk = rsqrtf(wave_sum(k0 * k0 + k1 * k1) * (1.0f / 128.0f) + EPS);
            const float rqr = rsqrtf(wave_sum(xq * xq) * (1.0f / 64.0f) + EPS);
            *qp = pk_bf16(q0 * rq * qn0, q1 * rq * qn1);
            *kp = pk_bf16(k0 * rk * kn0, k1 * rk * kn1);
            const float xr = xq * rqr * qrg, pr = __shfl_xor(xr, 32);
            const float o = (lane < 32 ? xr * cs - pr * sn : xr * cs + pr * sn) * QS;
            *qrp = (bf16_t)(pk_bf16(o, 0.f) & 0xffffu);
        }
    }
}

constexpr int KP = 400, VP = 320, KBUF = 64 * KP, VBUF = 64 * VP;
__device__ __forceinline__ int crow(int r, int hi) { return (r & 3) + 8 * (r >> 2) + 4 * hi; }
__device__ void attn_phase(KA ka, LAS unsigned char* lds) {
    unsigned char* const ws = P_WS;
    const int tid = otid(), lane = tid & 63, w = __builtin_amdgcn_readfirstlane(tid >> 6), G = ogrid(), bx = obid();
    const bf16_t* QB = (const bf16_t*)(ws + OFF_QB); const bf16_t* KVB = (const bf16_t*)(ws + OFF_KVB); const bf16_t* KR = (const bf16_t*)(ws + OFF_KR); bf16_t* OB = (bf16_t*)(ws + OFF_OBUF);
    const int c = lane & 31, hi = lane >> 5;
    const int kn_key0 = tid >> 4, kn_ch = tid & 15;
    const int kr_key = tid >> 3, kr_ch = tid & 7;
    const unsigned kvoff = (unsigned)(kn_key0 * 4096 + kn_ch * 16), kroff = (unsigned)(kr_key * 128 + kr_ch * 16);
    const unsigned k_rd = (unsigned)(c * KP + hi * 16);
    const int g4 = lane >> 4, i16 = lane & 15, qq = i16 >> 2, pp = i16 & 3;
    const unsigned v_rd = (unsigned)((4 * hi + qq) * VP + (g4 & 1) * 32 + pp * 8);
    const int vcu = (G % 8 == 0) ? (bx % 8) * (G / 8) + bx / 8 : bx;
    for (int vw = vcu; vw < 256; vw += G) {
        const int bh = vw >> 2, sub = vw & 3, b = bh >> 3, h = bh & 7;
        for (int ui = 0; ui < 4; ++ui) {
            const int qb = ui == 0 ? 15 - sub : (ui == 1 ? 8 + sub : (ui == 2 ? 7 - sub : sub));
            const int q0 = qb * 256 + w * 32;
            const char* qbase = (const char*)(QB + ((size_t)b * SEQ + q0) * 1536 + h * 192);
            asm volatile("" : "+s"(qbase));
            const unsigned qoff = (unsigned)(c * 3072 + hi * 16);
            bf16x8 qf[12];
#pragma unroll
            for (int ks = 0; ks < 12; ++ks) qf[ks] = *(const bf16x8*)(qbase + qoff + ks * 32);
            f32x16 oacc[4];
#pragma unroll
            for (int i = 0; i < 4; ++i)
#pragma unroll
                for (int j = 0; j < 16; ++j) oacc[i][j] = 0.f;
            float mrun = -1e30f, lrun = 0.f;
            const int ntile = 4 * qb + 4, wlast = 4 * qb + (w >> 1);
            const char* kvbase = (const char*)(KVB + (size_t)b * SEQ * 2048 + h * 256);
            const char* krbase = (const char*)(KR + (size_t)b * SEQ * 64);
            asm volatile("" : "+s"(kvbase), "+s"(krbase));
            u32x4 sk0, sk1, skr, sv0, sv1;
#define ATT_LOADK(kt) do { const char* tb_ = kvbase + (size_t)(kt) * (64 * 4096); const char* tr_ = krbase + (size_t)(kt) * (64 * 128); \
                sk0 = *(const u32x4*)(tb_ + kvoff); sk1 = *(const u32x4*)(tb_ + 32 * 4096 + kvoff); skr = *(const u32x4*)(tr_ + kroff); } while (0)
#define ATT_LOADV(kt) do { const char* tb_ = kvbase + (size_t)(kt) * (64 * 4096) + 256; \
                sv0 = *(const u32x4*)(tb_ + kvoff); sv1 = *(const u32x4*)(tb_ + 32 * 4096 + kvoff); } while (0)
#define ATT_WRITEK(buf) do { LAS unsigned char* kb_ = lds + (buf) * KBUF; \
                *(LAS u32x4*)(kb_ + kn_key0 * KP + kn_ch * 16) = sk0; *(LAS u32x4*)(kb_ + (kn_key0 + 32) * KP + kn_ch * 16) = sk1; \
                *(LAS u32x4*)(kb_ + kr_key * KP + 256 + kr_ch * 16) = skr; } while (0)
#define ATT_WRITEV(buf) do { LAS unsigned char* vb_ = lds + 2 * KBUF + (buf) * VBUF; \
                *(LAS u32x4*)(vb_ + kn_key0 * VP + kn_ch * 16) = sv0; *(LAS u32x4*)(vb_ + (kn_key0 + 32) * VP + kn_ch * 16) = sv1; } while (0)
            __syncthreads();
            ATT_LOADK(0); ATT_LOADV(0); ATT_WRITEK(0); ATT_WRITEV(0);
            __syncthreads();
            for (int kt = 0; kt < ntile; ++kt) {
                const int buf = kt & 1;
                const bool more = kt + 1 < ntile, active = kt <= wlast;
                if (more) ATT_LOADK(kt + 1);
                f32x16 sacc[2];
                if (active) {
                    const LAS unsigned char* kb = lds + buf * KBUF + k_rd;
#pragma unroll
                    for (int kb2 = 0; kb2 < 2; ++kb2)
#pragma unroll
                        for (int j = 0; j < 16; ++j) sacc[kb2][j] = 0.f;
                    bf16x8 kf[2][4];
#define ATT_LDK(dst, g) do { _Pragma("unroll") for (int q_ = 0; q_ < 4; ++q_) dst[q_] = *(const LAS bf16x8*)(kb + ((g) / 3) * 32 * KP + (((g) % 3) * 4 + q_) * 32); } while (0)
                    ATT_LDK(kf[0], 0);
#pragma unroll
                    for (int g = 0; g < 6; ++g) {
                        if (g < 5) ATT_LDK(kf[(g + 1) & 1], g + 1);
                        __builtin_amdgcn_sched_barrier(0);
#pragma unroll
                        for (int q_ = 0; q_ < 4; ++q_) sacc[g / 3] = __builtin_amdgcn_mfma_f32_32x32x16_bf16(kf[g & 1][q_], qf[(g % 3) * 4 + q_], sacc[g / 3], 0, 0, 0);
                        __builtin_amdgcn_sched_barrier(0);
                    }
#undef ATT_LDK
                }
                if (more) { ATT_WRITEK(buf ^ 1); ATT_LOADV(kt + 1); }
                if (active) {
                    const LAS unsigned char* vb = lds + 2 * KBUF + buf * VBUF + v_rd;
                    bf16x8 vf[2][4];
#define ATT_LDV(dst, gg) do { _Pragma("unroll") for (int i_ = 0; i_ < 4; ++i_) { \
                        const s16x4 lo_ = __builtin_amdgcn_ds_read_tr16_b64_v4i16((LAS s16x4*)(vb + ((gg) * 16) * VP + i_ * 64)); \
                        const s16x4 hv_ = __builtin_amdgcn_ds_read_tr16_b64_v4i16((LAS s16x4*)(vb + ((gg) * 16 + 8) * VP + i_ * 64)); \
                        dst[i_] = __builtin_shufflevector(lo_, hv_, 0, 1, 2, 3, 4, 5, 6, 7); } } while (0)
                    ATT_LDV(vf[0], 0);
                    if (kt == wlast) {
                        const int qi = q0 + c - kt * 64;
#pragma unroll
                        for (int kb2 = 0; kb2 < 2; ++kb2)
#pragma unroll
                            for (int j = 0; j < 16; ++j) if (kb2 * 32 + crow(j, hi) > qi) sacc[kb2][j] = -INFINITY;
                    }
                    float mx = sacc[0][0];
#pragma unroll
                    for (int kb2 = 0; kb2 < 2; ++kb2)
#pragma unroll
                        for (int j = 0; j < 16; ++j) mx = fmaxf(mx, sacc[kb2][j]);
                    mx = fmaxf(mx, __shfl_xor(mx, 32));
                    const float mnew = fmaxf(mrun, mx), alpha = __builtin_amdgcn_exp2f(mrun - mnew);
                    mrun = mnew;
                    float ps = 0.f;
#pragma unroll
                    for (int kb2 = 0; kb2 < 2; ++kb2)
#pragma unroll
                        for (int j = 0; j < 16; ++j) { const float e = __builtin_amdgcn_exp2f(sacc[kb2][j] - mnew); sacc[kb2][j] = e; ps += e; }
                    lrun = lrun * alpha + ps;
#pragma unroll
                    for (int i = 0; i < 4; ++i)
#pragma unroll
                        for (int j = 0; j < 16; ++j) oacc[i][j] *= alpha;
                    bf16x8 pb[2][2];
#pragma unroll
                    for (int kb2 = 0; kb2 < 2; ++kb2)
#pragma unroll
                        for (int s2 = 0; s2 < 2; ++s2) {
                            u32x4 pw;
                            pw.x = pk_bf16(sacc[kb2][8 * s2 + 0], sacc[kb2][8 * s2 + 1]); pw.y = pk_bf16(sacc[kb2][8 * s2 + 2], sacc[kb2][8 * s2 + 3]);
                            pw.z = pk_bf16(sacc[kb2][8 * s2 + 4], sacc[kb2][8 * s2 + 5]); pw.w = pk_bf16(sacc[kb2][8 * s2 + 6], sacc[kb2][8 * s2 + 7]);
                            pb[kb2][s2] = __builtin_bit_cast(bf16x8, pw);
                        }
#pragma unroll
                    for (int gg = 0; gg < 4; ++gg) {
                        if (gg < 3) ATT_LDV(vf[(gg + 1) & 1], gg + 1);
                        __builtin_amdgcn_sched_barrier(0);
#pragma unroll
                        for (int i = 0; i < 4; ++i) oacc[i] = __builtin_amdgcn_mfma_f32_32x32x16_bf16(vf[gg & 1][i], pb[gg >> 1][gg & 1], oacc[i], 0, 0, 0);
                        __builtin_amdgcn_sched_barrier(0);
                    }
#undef ATT_LDV
                }
                if (more) ATT_WRITEV(buf ^ 1);
                __syncthreads();
            }
#undef ATT_LOADK
#undef ATT_LOADV
#undef ATT_WRITEK
#undef ATT_WRITEV
            const float ltot = lrun + __shfl_xor(lrun, 32), inv = 1.0f / ltot;
            char* obase = (char*)(OB + ((size_t)b * SEQ + q0) * DM + h * 128);
            asm volatile("" : "+s"(obase));
            const unsigned ooff = (unsigned)(c * 2048 + hi * 8);
#pragma unroll
            for (int i = 0; i < 4; ++i)
#pragma unroll
                for (int g = 0; g < 4; ++g) {
                    u32x2 wv; wv.x = pk_bf16(oacc[i][4 * g] * inv, oacc[i][4 * g + 1] * inv); wv.y = pk_bf16(oacc[i][4 * g + 2] * inv, oacc[i][4 * g + 3] * inv);
                    *(u32x2*)(obase + ooff + 64 * i + 16 * g) = wv;
                }
        }
    }
    __syncthreads();
}

enum { OP_CIN, OP_CONV3, OP_COUT, OP_GU, OP_DOWN, OP_LIN, OP_CONV4, OP_GATE, OP_SCAN1, OP_SCAN2, OP_LOUT, OP_MDOWN, OP_UQ, OP_UKV, OP_PREP, OP_ATTN, OP_WO };
enum { GT_NONE, GT_PAIR, GT_STORE, GT_RESID, GT_GATE };
__device__ const unsigned char g_prog[26][3] = {
    {OP_CIN, 0, 1}, {OP_CONV3, 0, 1}, {OP_COUT, 0, 1}, {OP_GU, 0, 1}, {OP_DOWN, 0, 1},
    {OP_LIN, 1, 1}, {OP_CONV4, 1, 1}, {OP_GATE, 1, 1}, {OP_SCAN1, 1, 1}, {OP_SCAN2, 1, 1}, {OP_LOUT, 1, 1}, {OP_GU, 1, 1}, {OP_DOWN, 1, 1},
    {OP_MDOWN, 2, 1}, {OP_UQ, 2, 0}, {OP_UKV, 2, 1}, {OP_PREP, 2, 1}, {OP_ATTN, 2, 1}, {OP_WO, 2, 1}, {OP_GU, 2, 1}, {OP_DOWN, 2, 1},
    {OP_CIN, 3, 1}, {OP_CONV3, 3, 1}, {OP_COUT, 3, 1}, {OP_GU, 3, 1}, {OP_DOWN, 3, 1}};

__global__ void __launch_bounds__(NTHREADS) mega_fwd(Params p) {
    extern __shared__ __attribute__((aligned(16))) unsigned char lds_raw[];
    LAS unsigned char* lds = (LAS unsigned char*)lds_raw;
    cg::grid_group grid = cg::this_grid();
    KA ka = (KA)__builtin_amdgcn_kernarg_segment_ptr();
    (void)p;
    phase0(ka, lds);
    grid.sync();
    for (int st = 0; st < 26; ++st) {
        asm volatile("" : "+s"(ka));
        unsigned char* const ws = P_WS;
        float* const ssq = (float*)(ws + OFF_SSQ);
        bf16_t* const hb = (bf16_t*)(ws + OFF_HB);
        const int op = g_prog[st][0], L = g_prog[st][1], sync_after = g_prog[st][2];
        const int j = L / 3;
        int gt = GT_NONE; pg8::Gemm g{}; EP e{};
        const float* resid_in = (L == 0) ? (const float*)P_IN(0) : (const float*)P_OUT;
        switch (op) {
        case OP_CIN:
            gt = GT_PAIR; g = pg8::Gemm{hb, (const bf16_t*)(ws + OFF_WCIN) + (size_t)j * 3072 * DM, T, 3072, DM, DM, 0};
            e.o0 = (bf16_t*)(ws + OFF_U); e.ld0 = DM; e.o1 = (bf16_t*)(ws + OFF_BG); e.ld1 = DM; e.split = 8; e.mode = 1; e.rs = ssq + (size_t)(2 * L) * T; e.inv_dim = 1.0f / DM; break;
        case OP_CONV3: conv3_phase(ka, (const float*)P_IN(4) + (size_t)j * 3 * DM); break;
        case OP_COUT:
            gt = GT_RESID; g = pg8::Gemm{(const bf16_t*)(ws + OFF_Y), (const bf16_t*)(ws + OFF_WCOUT) + (size_t)j * DM * DM, T, DM, DM, DM, 0};
            e.resid = resid_in; e.fout = P_OUT; e.o0 = hb; e.ssq0 = ssq + (size_t)(2 * L + 1) * T; break;
        case OP_GU:
            gt = GT_PAIR; g = pg8::Gemm{hb, (const bf16_t*)(ws + OFF_WGU) + (size_t)L * 2 * DFF * DM, T, 2 * DFF, DM, DM, 0};
            e.o0 = (bf16_t*)(ws + OFF_ACT); e.ld0 = DFF; e.split = 1 << 20; e.mode = 0; e.rs = ssq + (size_t)(2 * L + 1) * T; e.inv_dim = 1.0f / DM; break;
        case OP_DOWN:
            gt = GT_RESID; g = pg8::Gemm{(const bf16_t*)(ws + OFF_ACT), (const bf16_t*)(ws + OFF_WDN) + (size_t)L * DM * DFF, T, DM, DFF, DFF, 0};
            e.resid = P_OUT; e.fout = P_OUT; e.o0 = hb; e.ssq0 = ssq + (size_t)(L < 3 ? 2 * L + 2 : 10) * T; break;
        case OP_LIN:
            gt = GT_STORE; g = pg8::Gemm{hb, (const bf16_t*)(ws + OFF_WLIN), T, 2 * LW, DM, DM, 0};
            e.o0 = (bf16_t*)(ws + OFF_GATE); e.ld0 = LW; e.o1 = (bf16_t*)(ws + OFF_RECB); e.ld1 = LW; e.split = 5; e.mode = 1; e.rs = ssq + (size_t)(2 * L) * T; e.inv_dim = 1.0f / DM; break;
        case OP_CONV4: conv4_phase(ka); break;
        case OP_GATE:
            gt = GT_GATE; g = pg8::Gemm{(const bf16_t*)(ws + OFF_XS), (const bf16_t*)(ws + OFF_WLG), T, 2 * LW, 256, LW, 256};
            e.o0 = (bf16_t*)(ws + OFF_LA); e.o1 = (bf16_t*)(ws + OFF_RECB); e.xs = (const bf16_t*)(ws + OFF_XS);
            e.ba = (const float*)P_IN(10); e.bx = (const float*)P_IN(12); e.cl = (const float*)(ws + OFF_CL); break;
        case OP_SCAN1: scan1_phase(ka); break;
        case OP_SCAN2: scan2_phase(ka); break;
        case OP_LOUT:
            gt = GT_RESID; g = pg8::Gemm{(const bf16_t*)(ws + OFF_GATE), (const bf16_t*)(ws + OFF_WLOUT), T, DM, LW, LW, 0};
            e.resid = resid_in; e.fout = P_OUT; e.o0 = hb; e.ssq0 = ssq + (size_t)(2 * L + 1) * T; break;
        case OP_MDOWN:
            gt = GT_STORE; g = pg8::Gemm{hb, (const bf16_t*)(ws + OFF_WMD), T, 768, DM, DM, 0};
            e.o0 = (bf16_t*)(ws + OFF_CBUF); e.ld0 = 768; e.split = 1 << 20; e.mode = 2; e.rs = ssq + (size_t)(2 * L) * T; e.inv_dim = 1.0f / DM;
            e.ssq0 = ssq + (size_t)8 * T; e.ssq1 = ssq + (size_t)9 * T; break;
        case OP_UQ:
            gt = GT_STORE; g = pg8::Gemm{(const bf16_t*)(ws + OFF_CBUF) + 256, (const bf16_t*)(ws + OFF_WUQ), T, 1536, 384, 768, 0};
            e.o0 = (bf16_t*)(ws + OFF_QB); e.ld0 = 1536; e.split = 1 << 20; e.mode = 0; e.rs = ssq + (size_t)9 * T; e.inv_dim = 1.0f / 384.0f; break;
        case OP_UKV:
            gt = GT_STORE; g = pg8::Gemm{(const bf16_t*)(ws + OFF_CBUF), (const bf16_t*)(ws + OFF_WUKV), T, 2048, 256, 768, 0};
            e.o0 = (bf16_t*)(ws + OFF_KVB); e.ld0 = 2048; e.split = 1 << 20; e.mode = 0; e.rs = ssq + (size_t)8 * T; e.inv_dim = 1.0f / 256.0f; break;
        case OP_PREP: prep_phase(ka); break;
        case OP_ATTN: attn_phase(ka, lds); break;
        case OP_WO:
            gt = GT_RESID; g = pg8::Gemm{(const bf16_t*)(ws + OFF_OBUF), (const bf16_t*)(ws + OFF_WO), T, DM, DM, DM, 0};
            e.resid = resid_in; e.fout = P_OUT; e.o0 = hb; e.ssq0 = ssq + (size_t)(2 * L + 1) * T; break;
        default: break;
        }
        if (gt != GT_NONE) {
            pg8::StaticOrder S; S.init(g.M, g.N, ogrid(), obid());
            e.type = gt - 1;
            EpiAll E{e}; pg8::gemm_phase<EpiAll>(lds, g, S, E);
        }
        if (sync_after) grid.sync();
    }
}

constexpr int LDS_BYTES = pg8::STAGE_BYTES;

extern "C" void kernel_launch(void* const* d_in, const int* in_sizes, int n_in, void* d_out, int out_size, void* d_ws, size_t ws_size, hipStream_t stream) {
    static int grid_blocks = 0;
    if (grid_blocks == 0) {
        if (n_in != 28 || ws_size < WS_NEED) { fprintf(stderr, "kernel_launch: unexpected inputs (n_in %d, ws %zu, need %zu)\n", n_in, ws_size, (size_t)WS_NEED); grid_blocks = -1; return; }
        int dev = 0, cus = 0, per_cu = 0;
        hipGetDevice(&dev);
        hipDeviceGetAttribute(&cus, hipDeviceAttributeMultiprocessorCount, dev);
        hipFuncSetAttribute((const void*)mega_fwd, hipFuncAttributeMaxDynamicSharedMemorySize, LDS_BYTES);
        hipOccupancyMaxActiveBlocksPerMultiprocessor(&per_cu, (const void*)mega_fwd, NTHREADS, LDS_BYTES);
        if (per_cu < 1) { fprintf(stderr, "kernel_launch: occupancy query returned %d\n", per_cu); per_cu = 1; }
        grid_blocks = cus;
        (void)hipGetLastError();
    }
    if (grid_blocks < 0) return;
    Params p{};
    for (int i = 0; i < 28; ++i) p.in[i] = d_in[i];
    p.out = (float*)d_out; p.ws = (unsigned char*)d_ws;
    void* args[] = {&p};
    hipError_t e = hipLaunchCooperativeKernel((const void*)mega_fwd, dim3(grid_blocks), dim3(NTHREADS), args, LDS_BYTES, stream);
    if (e != hipSuccess) fprintf(stderr, "cooperative launch failed: %s (grid %d)\n", hipGetErrorString(e), grid_blocks);
}
```

```cpp
#include <hip/hip_runtime.h>
#include <hip/hip_cooperative_groups.h>
#include <cstdio>
namespace cg = cooperative_groups;

#define LAS __attribute__((address_space(3)))
typedef unsigned short bf16_t;
typedef short bf16x8 __attribute__((ext_vector_type(8)));
typedef short s16x4 __attribute__((ext_vector_type(4)));
typedef float f32x2 __attribute__((ext_vector_type(2)));
typedef float f32x4 __attribute__((ext_vector_type(4)));
typedef float f32x16 __attribute__((ext_vector_type(16)));
typedef unsigned u32x2 __attribute__((ext_vector_type(2)));
typedef unsigned u32x4 __attribute__((ext_vector_type(4)));
typedef __bf16 bf2_t __attribute__((ext_vector_type(2)));

#define PROBE_OP (-1)
#define PROBE_SYNCS 0
#define PROBE_P0 0
constexpr int T = 32768, DM = 1024, SEQ = 4096, NBATCH = 8, DFF = 2816, LW = 1280;
constexpr int NTHREADS = 512;
constexpr float EPS = 1e-6f;
constexpr size_t MiB = 1ull << 20;
constexpr size_t OFF_WCIN = 0;
constexpr size_t OFF_WCOUT = 12 * MiB;
constexpr size_t OFF_WLIN = 16 * MiB;
constexpr size_t OFF_WLG = 21 * MiB;
constexpr size_t OFF_WLOUT = 22 * MiB + MiB / 4;
constexpr size_t OFF_WMD = 24 * MiB + 3 * MiB / 4;
constexpr size_t OFF_WUQ = 26 * MiB + MiB / 4;
constexpr size_t OFF_WUKV = 27 * MiB + 3 * MiB / 8;
constexpr size_t OFF_WO = 28 * MiB + 3 * MiB / 8;
constexpr size_t OFF_WGU = 31 * MiB;
constexpr size_t OFF_WDN = 75 * MiB;
constexpr size_t OFF_HB = 97 * MiB;
constexpr size_t OFF_SSQ = 161 * MiB;
constexpr size_t OFF_CL = OFF_SSQ + 11ull * T * 4;
constexpr size_t OFF_BAR = OFF_CL + 8192;
constexpr size_t OFF_R = 163 * MiB;
constexpr size_t OFF_ACT = OFF_R;
constexpr size_t OFF_U = OFF_R, OFF_BG = OFF_R + 64 * MiB, OFF_Y = OFF_R + 128 * MiB;
constexpr size_t OFF_GATE = OFF_R, OFF_RECB = OFF_R + 80 * MiB, OFF_XS = OFF_R + 160 * MiB, OFF_LA = OFF_R + 240 * MiB, OFF_CARRY = OFF_R + 320 * MiB;
constexpr size_t OFF_CBUF = OFF_R, OFF_OBUF = OFF_R, OFF_QB = OFF_R + 64 * MiB, OFF_KVB = OFF_R + 160 * MiB, OFF_KR = OFF_R + 288 * MiB;
constexpr size_t WS_NEED = OFF_R + 326 * MiB;

struct Params { const void* in[28]; float* out; unsigned char* ws; };
typedef const void* kptr_t;
typedef const __attribute__((address_space(4))) kptr_t* KA;
#define P_IN(i) (ka[(i)])
#define P_OUT ((float*)ka[28])
#define P_WS ((unsigned char*)ka[29])

__device__ __forceinline__ unsigned pk_bf16(float lo, float hi) { bf2_t v = __builtin_convertvector((f32x2){lo, hi}, bf2_t); return __builtin_bit_cast(unsigned, v); }
__device__ __forceinline__ float bf_lo(unsigned w) { return __uint_as_float(w << 16); }
__device__ __forceinline__ float bf_hi(unsigned w) { return __uint_as_float(w & 0xffff0000u); }
__device__ __forceinline__ float bf1(bf16_t b) { return __uint_as_float(((unsigned)b) << 16); }
__device__ __forceinline__ float wave_sum(float v) {
#pragma unroll
    for (int o = 32; o >= 1; o >>= 1) v += __shfl_xor(v, o);
    return v;
}
__device__ __forceinline__ int otid() { int t = threadIdx.x; asm volatile("" : "+v"(t)); return t; }
__device__ __forceinline__ int obid() { int t = blockIdx.x; asm volatile("" : "+s"(t)); return t; }
__device__ __forceinline__ int ogrid() { int t = gridDim.x; asm volatile("" : "+s"(t)); return t; }
__device__ __forceinline__ float fast_sigmoid(float x) { return __builtin_amdgcn_rcpf(1.0f + __expf(-x)); }

namespace pg8 {
constexpr int BM = 256, BK = 64, HALF = 128, HTB = HALF * BK * 2, STAGE_BYTES = 8 * HTB, NXCD = 8, WGM = 8;
__device__ __forceinline__ int lds_byte(int r, int c) { const int st = (r >> 4) * 2 + (c >> 5), rr = r & 15, cc = c & 31, ob = rr * 64 + cc * 2; return st * 1024 + (ob ^ (((ob >> 9) & 1) << 5)); }
__device__ __forceinline__ void stage_rc(int b, int& R, int& C) { const int st = b / 1024, sb = b % 1024, swz = sb ^ (((sb >> 9) & 1) << 5); R = (st >> 1) * 16 + swz / 64; C = (st & 1) * 32 + (swz % 64) / 2; }
__device__ __forceinline__ int perm32(int rho) { const int n = rho >> 4, i = rho & 15; return 8 * (i >> 2) + 4 * n + (i & 3); }
struct Unit { int pm, pn; };
struct Gemm { const bf16_t* A; const bf16_t* Bt; int M, N, K, lda, akoff; };
struct StaticOrder {
    int nM, nN, nwg, G, c;
    __device__ void init(int M, int N, int G_, int c_) { nM = M / BM; nN = N / BM; nwg = nM * nN; G = G_; c = c_; }
    __device__ bool next(int i, Unit& u) const {
        const long L = (long)i * G + c; if (L >= nwg) return false;
        int wgid = (int)L; { const int q = nwg / NXCD, r = nwg % NXCD, xcd = wgid % NXCD, off = wgid / NXCD; wgid = (xcd < r ? xcd * (q + 1) : r * (q + 1) + (xcd - r) * q) + off; }
        const int nig = WGM * nN, gid = wgid / nig, fm = gid * WGM, gsz = (nM - fm) < WGM ? (nM - fm) : WGM;
        u.pm = fm + ((wgid % nig) % gsz); u.pn = (wgid % nig) / gsz; return true;
    }
};

template <class Epi>
__device__ __forceinline__ void gemm_phase(LAS unsigned char* lds, const Gemm g, const StaticOrder& S, const Epi& E) {
    const int tid = otid(), wid = __builtin_amdgcn_readfirstlane(tid >> 6), lane = tid & 63, wr = wid >> 2, wc = wid & 3, fr = lane & 15, fq = lane >> 4;
    const int K = g.K, nt = K / BK, lda = g.lda;
    unsigned voffA[2], voffB[2];
#pragma unroll
    for (int i = 0; i < 2; ++i) { int R, C; stage_rc(tid * 16 + i * 8192, R, C); const int Rb = Epi::PERM ? ((R & ~31) + perm32(R & 31)) : R;
        voffA[i] = (unsigned)(R * lda + C) * 2u; voffB[i] = (unsigned)(Rb * K + C) * 2u; }
    const size_t kstep = (size_t)(BK * 2);
    const size_t hstepA = (size_t)HALF * lda * 2, hstepB = (size_t)HALF * K * 2;
    const size_t tstepA = 2 * hstepA, tstepB = 2 * hstepB;
    const size_t akoffb = (size_t)g.akoff * 2;
    const unsigned ldsw = (unsigned)wid * 1024u;
    const int aoff = lds_byte(wr * 64 + fr, fq * 8), boff = lds_byte(wc * 32 + fr, fq * 8);
#define PG8_SA(b, h) (((b) * 2 + (h)) * HTB)
#define PG8_SB(b, h) ((4 + (b) * 2 + (h)) * HTB)
#define PG8_STAGE(bufoff, gbase, voff) do { _Pragma("unroll") for (int _i = 0; _i < 2; ++_i) \
        __builtin_amdgcn_global_load_lds((const unsigned*)((const char*)(gbase) + (voff)[_i]), (LAS unsigned*)(lds + (bufoff) + ldsw + _i * 8192), 16, 0, 0); } while (0)
#define PG8_LDA(dst, b, h) do { _Pragma("unroll") for (int m = 0; m < 4; ++m) _Pragma("unroll") for (int k = 0; k < 2; ++k) dst[m][k] = *(const LAS bf16x8*)(lds + PG8_SA(b, h) + aoff + m * 2048 + k * 1024); } while (0)
#define PG8_LDB(dst, b, h) do { _Pragma("unroll") for (int n = 0; n < 2; ++n) _Pragma("unroll") for (int k = 0; k < 2; ++k) dst[n][k] = *(const LAS bf16x8*)(lds + PG8_SB(b, h) + boff + n * 2048 + k * 1024); } while (0)
#define PG8_MMA(ai, bj, At, Bt) do { __builtin_amdgcn_s_setprio(1); _Pragma("unroll") for (int m = 0; m < 4; ++m) _Pragma("unroll") for (int n = 0; n < 2; ++n) _Pragma("unroll") for (int k = 0; k < 2; ++k) \
        acc[ai][bj][m][n] = __builtin_amdgcn_mfma_f32_16x16x32_bf16(Bt[n][k], At[m][k], acc[ai][bj][m][n], 0, 0, 0); __builtin_amdgcn_s_setprio(0); } while (0)
#define PG8_WAIT_V(n) asm volatile("s_waitcnt vmcnt(" #n ")" ::: "memory")
#define PG8_WAIT_L(n) asm volatile("s_waitcnt lgkmcnt(" #n ")" ::: "memory")
#define PG8_BAR __builtin_amdgcn_s_barrier()
#define PG8_SCHED __builtin_amdgcn_sched_barrier(0)
    Unit cur, nxt; int ui = 0;
    if (!S.next(0, cur)) return;
    f32x4 acc[2][2][4][2];
#pragma unroll
    for (int a = 0; a < 2; ++a)
#pragma unroll
        for (int b = 0; b < 2; ++b)
#pragma unroll
            for (int m = 0; m < 4; ++m)
#pragma unroll
                for (int n = 0; n < 2; ++n) acc[a][b][m][n] = (f32x4){0.f, 0.f, 0.f, 0.f};
    bf16x8 At[4][2], B0[2][2], B1[2][2];
    const char* cA = (const char*)g.A + (size_t)cur.pm * tstepA + (size_t)(cur.pn >> 1) * akoffb; const char* cB = (const char*)g.Bt + (size_t)cur.pn * tstepB;
    PG8_STAGE(PG8_SB(0, 0), cB, voffB); PG8_STAGE(PG8_SA(0, 0), cA, voffA); PG8_STAGE(PG8_SB(0, 1), cB + hstepB, voffB); PG8_STAGE(PG8_SA(0, 1), cA + hstepA, voffA);
    if (wr == 1) PG8_BAR;
    PG8_WAIT_V(4); PG8_BAR;
    PG8_STAGE(PG8_SB(1, 0), cB + kstep, voffB); PG8_STAGE(PG8_SA(1, 0), cA + kstep, voffA); PG8_STAGE(PG8_SB(1, 1), cB + hstepB + kstep, voffB);
    PG8_WAIT_V(6); PG8_BAR;
    for (;;) {
        const bool has_next = S.next(ui + 1, nxt);
        const char* nA = has_next ? (const char*)g.A + (size_t)nxt.pm * tstepA + (size_t)(nxt.pn >> 1) * akoffb : cA; const char* nB = has_next ? (const char*)g.Bt + (size_t)nxt.pn * tstepB : cB;
        for (int t = 0; t < nt; t += 2) {
            const bool last = (t == nt - 2);
            const char* a1 = cA + (size_t)(t + 1) * kstep;
            const char* a2 = last ? nA : cA + (size_t)(t + 2) * kstep; const char* b2 = last ? nB : cB + (size_t)(t + 2) * kstep;
            const char* a3 = a2 + kstep; const char* b3 = b2 + kstep;
            PG8_LDB(B0, 0, 0); PG8_SCHED; PG8_LDA(At, 0, 0); PG8_STAGE(PG8_SA(1, 1), a1 + hstepA, voffA);
            PG8_WAIT_L(8); PG8_BAR; PG8_WAIT_L(0); PG8_MMA(0, 0, At, B0); PG8_BAR; PG8_SCHED;
            PG8_LDB(B1, 0, 1); PG8_STAGE(PG8_SB(0, 0), b2, voffB);
            PG8_BAR; PG8_WAIT_L(0); PG8_MMA(0, 1, At, B1); PG8_BAR;
            PG8_LDA(At, 0, 1); PG8_STAGE(PG8_SA(0, 0), a2, voffA);
            PG8_BAR; PG8_WAIT_L(0); PG8_MMA(1, 0, At, B0); PG8_BAR; PG8_SCHED;
            PG8_STAGE(PG8_SB(0, 1), b2 + hstepB, voffB);
            PG8_WAIT_V(6); PG8_BAR; PG8_MMA(1, 1, At, B1); PG8_BAR;
            PG8_LDB(B0, 1, 0); PG8_SCHED; PG8_LDA(At, 1, 0); PG8_STAGE(PG8_SA(0, 1), a2 + hstepA, voffA);
            PG8_WAIT_L(8); PG8_BAR; PG8_WAIT_L(0); PG8_MMA(0, 0, At, B0); PG8_BAR; PG8_SCHED;
            PG8_LDB(B1, 1, 1); PG8_STAGE(PG8_SB(1, 0), b3, voffB);
            PG8_BAR; PG8_WAIT_L(0); PG8_MMA(0, 1, At, B1); PG8_BAR;
            PG8_LDA(At, 1, 1); PG8_STAGE(PG8_SA(1, 0), a3, voffA);
            PG8_BAR; PG8_WAIT_L(0); PG8_MMA(1, 0, At, B0); PG8_BAR; PG8_SCHED;
            PG8_STAGE(PG8_SB(1, 1), b3 + hstepB, voffB);
            PG8_WAIT_V(6); PG8_BAR; PG8_MMA(1, 1, At, B1); PG8_BAR;
        }
        E(acc, cur, wr, wc, fr, fq);
        if (!has_next) break;
#pragma unroll
        for (int a = 0; a < 2; ++a)
#pragma unroll
            for (int b = 0; b < 2; ++b)
#pragma unroll
                for (int m = 0; m < 4; ++m)
#pragma unroll
                    for (int n = 0; n < 2; ++n) acc[a][b][m][n] = (f32x4){0.f, 0.f, 0.f, 0.f};
        cur = nxt; cA = nA; cB = nB; ++ui;
    }
    PG8_WAIT_V(0);
    if (wr == 0) PG8_BAR;
    PG8_BAR;
#undef PG8_SA
#undef PG8_SB
#undef PG8_STAGE
#undef PG8_LDA
#undef PG8_LDB
#undef PG8_MMA
#undef PG8_WAIT_V
#undef PG8_WAIT_L
#undef PG8_BAR
#undef PG8_SCHED
}
}

struct EP {
    bf16_t* o0; bf16_t* o1; const void* q2; void* q3; void* q4; const void* q5;
    int ld0, ld1, split, mode, type; float inv_dim;
};
#define EP_RS(p) ((const float*)(p).q2)
#define EP_SSQ0(p) ((float*)(p).q3)
#define EP_SSQ1(p) ((float*)(p).q4)
#define EP_RESID(p) ((const float*)(p).q2)
#define EP_FOUT(p) ((float*)(p).q4)
#define EP_XS(p) ((const bf16_t*)(p).q2)
#define EP_BA(p) ((const float*)(p).q3)
#define EP_BX(p) ((const float*)(p).q4)
#define EP_CL(p) ((const float*)(p).q5)
__device__ __forceinline__ void load_rstd(const EP& p, int row0, float (&rstd)[2][4]) {
#pragma unroll
    for (int ai = 0; ai < 2; ++ai)
#pragma unroll
        for (int m = 0; m < 4; ++m) rstd[ai][m] = rsqrtf(EP_RS(p)[row0 + ai * 128 + m * 16] * p.inv_dim + EPS);
}
__device__ __forceinline__ u32x4 pack8(const f32x4 a, const f32x4 b) { u32x4 w; w.x = pk_bf16(a[0], a[1]); w.y = pk_bf16(a[2], a[3]); w.z = pk_bf16(b[0], b[1]); w.w = pk_bf16(b[2], b[3]); return w; }

struct EpiAll {
    static constexpr bool PERM = true;
    EP p;
    __device__ __forceinline__ void operator()(const f32x4 (&acc)[2][2][4][2], const pg8::Unit& u, int wr, int wc, int fr, int fq) const {
        const int row0 = u.pm * 256 + wr * 64 + fr;
        if (p.type == 0) {
            float rstd[2][4]; load_rstd(p, row0, rstd);
            if (u.pn < p.split) {
                const int col = u.pn * 128 + wc * 32 + fq * 8;
#pragma unroll
                for (int ai = 0; ai < 2; ++ai)
#pragma unroll
                    for (int m = 0; m < 4; ++m) {
                        const float r = rstd[ai][m];
                        f32x4 v[2];
#pragma unroll
                        for (int n = 0; n < 2; ++n) {
                            const f32x4 g = acc[ai][0][m][n] * r, uu = acc[ai][1][m][n] * r;
                            if (p.mode == 0) {
#pragma unroll
                                for (int j = 0; j < 4; ++j) v[n][j] = g[j] * fast_sigmoid(g[j]) * uu[j];
                            } else v[n] = g * uu;
                        }
                        *(u32x4*)(p.o0 + (size_t)(row0 + ai * 128 + m * 16) * p.ld0 + col) = pack8(v[0], v[1]);
                    }
            } else {
                const int col = (u.pn - p.split) * 256 + wc * 32 + fq * 8;
#pragma unroll
                for (int ai = 0; ai < 2; ++ai)
#pragma unroll
                    for (int m = 0; m < 4; ++m) {
                        const float r = rstd[ai][m];
#pragma unroll
                        for (int bj = 0; bj < 2; ++bj)
                            *(u32x4*)(p.o1 + (size_t)(row0 + ai * 128 + m * 16) * p.ld1 + col + bj * 128) = pack8(acc[ai][bj][m][0] * r, acc[ai][bj][m][1] * r);
                    }
            }
        } else if (p.type == 1) {
            float rstd[2][4]; load_rstd(p, row0, rstd);
            const bool second = u.pn >= p.split;
            bf16_t* ob = second ? p.o1 : p.o0; const int ld = second ? p.ld1 : p.ld0;
            const int col = (second ? u.pn - p.split : u.pn) * 256 + wc * 32 + fq * 8;
            const bool gelu = (p.mode == 1) && !second;
#pragma unroll
            for (int ai = 0; ai < 2; ++ai)
#pragma unroll
                for (int m = 0; m < 4; ++m) {
                    const float r = rstd[ai][m]; const int row = row0 + ai * 128 + m * 16;
                    float sq[2];
#pragma unroll
                    for (int bj = 0; bj < 2; ++bj) {
                        f32x4 v0 = acc[ai][bj][m][0] * r, v1 = acc[ai][bj][m][1] * r;
                        if (gelu) {
#pragma unroll
                            for (int j = 0; j < 4; ++j) {
                                const float a = v0[j], b = v1[j];
                                v0[j] = a * fast_sigmoid(1.5957691216f * (a + 0.044715f * a * a * a));
                                v1[j] = b * fast_sigmoid(1.5957691216f * (b + 0.044715f * b * b * b));
                            }
                        }
                        sq[bj] = (v0[0] * v0[0] + v0[1] * v0[1]) + (v0[2] * v0[2] + v0[3] * v0[3]) + (v1[0] * v1[0] + v1[1] * v1[1]) + (v1[2] * v1[2] + v1[3] * v1[3]);
                        *(u32x4*)(ob + (size_t)row * ld + col + bj * 128) = pack8(v0, v1);
                    }
                    if (p.mode == 2) {
                        float s = (u.pn == 2) ? sq[0] : sq[0] + sq[1];
                        s += __shfl_xor(s, 16); s += __shfl_xor(s, 32);
                        if (fq == 0) atomicAdd((u.pn == 0 ? EP_SSQ0(p) : EP_SSQ1(p)) + row, s);
                    }
                }
        } else if (p.type == 2) {
            const int col0 = u.pn * 256 + wc * 32 + 8 * fq;
#pragma unroll
            for (int ai = 0; ai < 2; ++ai)
#pragma unroll
                for (int m = 0; m < 4; ++m) {
                    const int row = row0 + ai * 128 + m * 16; const size_t off = (size_t)row * DM + col0;
                    float s = 0.f;
#pragma unroll
                    for (int bj = 0; bj < 2; ++bj) {
                        const f32x4 b0 = *(const f32x4*)(EP_RESID(p) + off + bj * 128), b1 = *(const f32x4*)(EP_RESID(p) + off + bj * 128 + 4);
                        const f32x4 o0 = b0 + acc[ai][bj][m][0], o1 = b1 + acc[ai][bj][m][1];
                        *(f32x4*)(EP_FOUT(p) + off + bj * 128) = o0; *(f32x4*)(EP_FOUT(p) + off + bj * 128 + 4) = o1;
                        *(u32x4*)(p.o0 + off + bj * 128) = pack8(o0, o1);
                        s += (o0[0] * o0[0] + o0[1] * o0[1]) + (o0[2] * o0[2] + o0[3] * o0[3]) + (o1[0] * o1[0] + o1[1] * o1[1]) + (o1[2] * o1[2] + o1[3] * o1[3]);
                    }
                    s += __shfl_xor(s, 16); s += __shfl_xor(s, 32);
                    if (fq == 0) atomicAdd(EP_SSQ0(p) + row, s);
                    asm volatile("" ::: "memory");
                }
        } else {
            const int col = u.pn * 128 + wc * 32 + fq * 8;
#pragma unroll
            for (int n = 0; n < 2; ++n) {
                const f32x4 ba = *(const f32x4*)(EP_BA(p) + col + 4 * n), bx = *(const f32x4*)(EP_BX(p) + col + 4 * n), cl = *(const f32x4*)(EP_CL(p) + col + 4 * n);
#pragma unroll
                for (int ai = 0; ai < 2; ++ai)
#pragma unroll
                    for (int m = 0; m < 4; ++m) {
                        const size_t off = (size_t)(row0 + ai * 128 + m * 16) * LW + col + 4 * n;
                        const u32x2 xw = *(const u32x2*)(EP_XS(p) + off);
                        const float xv[4] = {bf_lo(xw.x), bf_hi(xw.x), bf_lo(xw.y), bf_hi(xw.y)};
                        f32x4 la, bb;
#pragma unroll
                        for (int j = 0; j < 4; ++j) {
                            const float r = fast_sigmoid(acc[ai][0][m][n][j] + ba[j]), ig = fast_sigmoid(acc[ai][1][m][n][j] + bx[j]);
                            const float l = r * cl[j];
                            const float a2 = __builtin_amdgcn_exp2f(2.0f * l);
                            la[j] = l; bb[j] = sqrtf(fmaxf(1.0f - a2, 0.f)) * ig * xv[j];
                        }
                        u32x2 w0, w1; w0.x = pk_bf16(la[0], la[1]); w0.y = pk_bf16(la[2], la[3]); w1.x = pk_bf16(bb[0], bb[1]); w1.y = pk_bf16(bb[2], bb[3]);
                        *(u32x2*)(p.o0 + off) = w0;
                        *(u32x2*)(p.o1 + off) = w1;
                    }
            }
        }
    }
};

struct Job { const float* src; int K, ldsrc; bf16_t* dst; int ndst; const float* gain; int perm; };
__device__ __forceinline__ int src_col(int perm, int n0, int nsrc) {
    const int tile = n0 >> 8, r = n0 & 255;
    if (perm == 1) return r < 128 ? 128 * tile + r : DFF + 128 * tile + (r - 128);
    if (perm == 2) return tile < 8 ? (r < 128 ? 1024 + 128 * tile + r : 2048 + 128 * tile + (r - 128)) : (tile - 8) * 256 + r;
    if (perm == 3) return n0 < 256 ? 384 + n0 : (n0 < 640 ? n0 - 256 : (n0 == 640 ? 640 : -1));
    return n0 < nsrc ? n0 : -1;
}
__device__ __forceinline__ void get_job(KA ka, int j, Job& jb) {
    unsigned char* const ws = P_WS;
    const float* mixn = (const float*)P_IN(2); const float* ffnn = (const float*)P_IN(25);
        if (j < 2) { jb = Job{(const float*)P_IN(3) + (size_t)j * DM * 3072, DM, 3072, (bf16_t*)(ws + OFF_WCIN) + (size_t)j * 3072 * DM, 3072, mixn + (j == 0 ? 0 : 3) * DM, 2}; }
    else if (j < 4) { const int i = j - 2; jb = Job{(const float*)P_IN(5) + (size_t)i * DM * DM, DM, DM, (bf16_t*)(ws + OFF_WCOUT) + (size_t)i * DM * DM, DM, nullptr, 0}; }
    else if (j == 4) jb = Job{(const float*)P_IN(6), DM, 2 * LW, (bf16_t*)(ws + OFF_WLIN), 2 * LW, mixn + 1 * DM, 0};
    else if (j == 5) jb = Job{(const float*)P_IN(14), LW, DM, (bf16_t*)(ws + OFF_WLOUT), DM, nullptr, 0};
    else if (j == 6) jb = Job{(const float*)P_IN(15), DM, 704, (bf16_t*)(ws + OFF_WMD), 768, mixn + 2 * DM, 3};
    else if (j == 7) jb = Job{(const float*)P_IN(18), 384, 1536, (bf16_t*)(ws + OFF_WUQ), 1536, (const float*)P_IN(16), 0};
    else if (j == 8) jb = Job{(const float*)P_IN(19), 256, 2048, (bf16_t*)(ws + OFF_WUKV), 2048, (const float*)P_IN(17), 0};
    else if (j == 9) jb = Job{(const float*)P_IN(24), DM, DM, (bf16_t*)(ws + OFF_WO), DM, nullptr, 0};
    else if (j < 14) { const int i = j - 10; jb = Job{(const float*)P_IN(26) + (size_t)i * DM * 2 * DFF, DM, 2 * DFF, (bf16_t*)(ws + OFF_WGU) + (size_t)i * 2 * DFF * DM, 2 * DFF, ffnn + i * DM, 1}; }
    else { const int i = j - 14; jb = Job{(const float*)P_IN(27) + (size_t)i * DFF * DM, DFF, DM, (bf16_t*)(ws + OFF_WDN) + (size_t)i * DM * DFF, DM, nullptr, 0}; }
}
__device__ void phase0(KA ka, LAS unsigned char* lds) {
    unsigned char* const ws = P_WS;
    const int tid = otid(), G = ogrid(), bx = obid(), lane = tid & 63, wid = tid >> 6;
    { float* z = (float*)(ws + OFF_SSQ) + T; const int n = 10 * T; for (int i = bx * NTHREADS + tid; i < n; i += G * NTHREADS) z[i] = 0.f; }
    if (bx == 0) { unsigned* bw = (unsigned*)(ws + OFF_BAR); for (int i = tid; i < 3456; i += NTHREADS) bw[i] = 0u; }
    if (bx == 0) { const float* lam = (const float*)P_IN(13); float* cl = (float*)(ws + OFF_CL); for (int c = tid; c < LW; c += NTHREADS) cl[c] = -8.0f * 1.4426950408889634f * log1pf(expf(-lam[c])); }
    { bf16_t* wlg = (bf16_t*)(ws + OFF_WLG); const float* wa = (const float*)P_IN(9); const float* wx = (const float*)P_IN(11);
      for (int i = bx * NTHREADS + tid; i < 2560 * 256; i += G * NTHREADS) { const int k = i & 255, row = i >> 8, n = row >> 8, gsel = (row >> 7) & 1, e = row & 127;
          float v = 0.f; if ((k >> 7) == (n & 1)) v = (gsel ? wx : wa)[((size_t)n * 128 + (k & 127)) * 128 + e];
          wlg[i] = (bf16_t)(pk_bf16(v, 0.f) & 0xffffu); } }
    { const float* x = (const float*)P_IN(0); bf16_t* hb = (bf16_t*)(ws + OFF_HB); float* ssq = (float*)(ws + OFF_SSQ);
      for (int row = bx * 8 + wid; row < T; row += G * 8) { float s = 0.f;
#pragma unroll
          for (int i = 0; i < 4; ++i) { const f32x4 v = *(const f32x4*)(x + (size_t)row * DM + i * 256 + lane * 4); s += (v[0] * v[0] + v[1] * v[1]) + (v[2] * v[2] + v[3] * v[3]);
              u32x2 w; w.x = pk_bf16(v[0], v[1]); w.y = pk_bf16(v[2], v[3]); *(u32x2*)(hb + (size_t)row * DM + i * 256 + lane * 4) = w; }
          s = wave_sum(s); if (lane == 0) ssq[row] = s; } }
    LAS float* tile = (LAS float*)lds;
    for (int j = 0; j < 18; ++j) {
        Job jb; get_job(ka, j, jb);
        const int tk = jb.K / 64, tn = jb.ndst / 64, ntile = tk * tn;
        for (int t = bx; t < ntile; t += G) {
            const int k0 = (t % tk) * 64, n0 = (t / tk) * 64; const int sc = src_col(jb.perm, n0, jb.ldsrc);
            __syncthreads();
#pragma unroll
            for (int i = 0; i < 8; ++i) { const int k = i * 8 + (tid >> 6), n = tid & 63; tile[k * 65 + n] = sc >= 0 ? jb.src[(size_t)(k0 + k) * jb.ldsrc + sc + n] : 0.f; }
            __syncthreads();
            const int n = tid >> 3, kc = (tid & 7) * 8; float v[8];
#pragma unroll
            for (int i = 0; i < 8; ++i) v[i] = tile[(kc + i) * 65 + n] * (jb.gain ? jb.gain[k0 + kc + i] : 1.0f);
            u32x4 w; w.x = pk_bf16(v[0], v[1]); w.y = pk_bf16(v[2], v[3]); w.z = pk_bf16(v[4], v[5]); w.w = pk_bf16(v[6], v[7]);
            *(u32x4*)(jb.dst + (size_t)(n0 + n) * jb.K + k0 + kc) = w;
        }
    }
    __syncthreads();
}

__device__ void conv3_phase(KA ka, const float* cw) {
    unsigned char* const ws = P_WS;
    const bf16_t* U = (const bf16_t*)(ws + OFF_U); const bf16_t* BG = (const bf16_t*)(ws + OFF_BG); bf16_t* Y = (bf16_t*)(ws + OFF_Y);
    const int nitem = (T / 16) * 128;
    const int gstride = ogrid() * NTHREADS;
    for (int id = obid() * NTHREADS + otid(); id < nitem; id += gstride) {
        const int cgp = id & 127, rc = id >> 7, c0 = cgp * 8, t0 = rc * 16;
        float w0[8], w1[8], w2[8], um2[8], um1[8];
#pragma unroll
        for (int j = 0; j < 8; ++j) { w0[j] = cw[c0 + j]; w1[j] = cw[DM + c0 + j]; w2[j] = cw[2 * DM + c0 + j]; um2[j] = 0.f; um1[j] = 0.f; }
        if ((t0 & (SEQ - 1)) != 0) {
            const u32x4 a = *(const u32x4*)(U + (size_t)(t0 - 2) * DM + c0), b = *(const u32x4*)(U + (size_t)(t0 - 1) * DM + c0);
            um2[0] = bf_lo(a.x); um2[1] = bf_hi(a.x); um2[2] = bf_lo(a.y); um2[3] = bf_hi(a.y); um2[4] = bf_lo(a.z); um2[5] = bf_hi(a.z); um2[6] = bf_lo(a.w); um2[7] = bf_hi(a.w);
            um1[0] = bf_lo(b.x); um1[1] = bf_hi(b.x); um1[2] = bf_lo(b.y); um1[3] = bf_hi(b.y); um1[4] = bf_lo(b.z); um1[5] = bf_hi(b.z); um1[6] = bf_lo(b.w); um1[7] = bf_hi(b.w);
        }
#pragma unroll 4
        for (int r = 0; r < 16; ++r) {
            const size_t off = (size_t)(t0 + r) * DM + c0;
            const u32x4 a = *(const u32x4*)(U + off), g = *(const u32x4*)(BG + off);
            const float uc[8] = {bf_lo(a.x), bf_hi(a.x), bf_lo(a.y), bf_hi(a.y), bf_lo(a.z), bf_hi(a.z), bf_lo(a.w), bf_hi(a.w)};
            const float gv[8] = {bf_lo(g.x), bf_hi(g.x), bf_lo(g.y), bf_hi(g.y), bf_lo(g.z), bf_hi(g.z), bf_lo(g.w), bf_hi(g.w)};
            float y[8];
#pragma unroll
            for (int j = 0; j < 8; ++j) { y[j] = gv[j] * (w0[j] * um2[j] + w1[j] * um1[j] + w2[j] * uc[j]); um2[j] = um1[j]; um1[j] = uc[j]; }
            u32x4 w; w.x = pk_bf16(y[0], y[1]); w.y = pk_bf16(y[2], y[3]); w.z = pk_bf16(y[4], y[5]); w.w = pk_bf16(y[6], y[7]);
            *(u32x4*)(Y + off) = w;
        }
    }
}
__device__ void conv4_phase(KA ka) {
    unsigned char* const ws = P_WS;
    const bf16_t* R = (const bf16_t*)(ws + OFF_RECB); bf16_t* XS = (bf16_t*)(ws + OFF_XS);
    const float* cw = (const float*)P_IN(7); const float* cb = (const float*)P_IN(8);
    const int nitem = (T / 16) * 160;
    const int gstride = ogrid() * NTHREADS;
    for (int id = obid() * NTHREADS + otid(); id < nitem; id += gstride) {
        const int cgp = id % 160, rc = id / 160, c0 = cgp * 8, t0 = rc * 16;
        float w0[8], w1[8], w2[8], w3[8], bs[8], x3[8], x2[8], x1[8];
#pragma unroll
        for (int j = 0; j < 8; ++j) { w0[j] = cw[c0 + j]; w1[j] = cw[LW + c0 + j]; w2[j] = cw[2 * LW + c0 + j]; w3[j] = cw[3 * LW + c0 + j]; bs[j] = cb[c0 + j]; x3[j] = 0.f; x2[j] = 0.f; x1[j] = 0.f; }
        if ((t0 & (SEQ - 1)) != 0) {
            const u32x4 a = *(const u32x4*)(R + (size_t)(t0 - 3) * LW + c0), b = *(const u32x4*)(R + (size_t)(t0 - 2) * LW + c0), c = *(const u32x4*)(R + (size_t)(t0 - 1) * LW + c0);
            x3[0] = bf_lo(a.x); x3[1] = bf_hi(a.x); x3[2] = bf_lo(a.y); x3[3] = bf_hi(a.y); x3[4] = bf_lo(a.z); x3[5] = bf_hi(a.z); x3[6] = bf_lo(a.w); x3[7] = bf_hi(a.w);
            x2[0] = bf_lo(b.x); x2[1] = bf_hi(b.x); x2[2] = bf_lo(b.y); x2[3] = bf_hi(b.y); x2[4] = bf_lo(b.z); x2[5] = bf_hi(b.z); x2[6] = bf_lo(b.w); x2[7] = bf_hi(b.w);
            x1[0] = bf_lo(c.x); x1[1] = bf_hi(c.x); x1[2] = bf_lo(c.y); x1[3] = bf_hi(c.y); x1[4] = bf_lo(c.z); x1[5] = bf_hi(c.z); x1[6] = bf_lo(c.w); x1[7] = bf_hi(c.w);
        }
#pragma unroll 4
        for (int r = 0; r < 16; ++r) {
            const size_t off = (size_t)(t0 + r) * LW + c0;
            const u32x4 a = *(const u32x4*)(R + off);
            const float xc[8] = {bf_lo(a.x), bf_hi(a.x), bf_lo(a.y), bf_hi(a.y), bf_lo(a.z), bf_hi(a.z), bf_lo(a.w), bf_hi(a.w)};
            float y[8];
#pragma unroll
            for (int j = 0; j < 8; ++j) { y[j] = bs[j] + w0[j] * x3[j] + w1[j] * x2[j] + w2[j] * x1[j] + w3[j] * xc[j]; x3[j] = x2[j]; x2[j] = x1[j]; x1[j] = xc[j]; }
            u32x4 w; w.x = pk_bf16(y[0], y[1]); w.y = pk_bf16(y[2], y[3]); w.z = pk_bf16(y[4], y[5]); w.w = pk_bf16(y[6], y[7]);
            *(u32x4*)(XS + off) = w;
        }
    }
}
__device__ void scan1_phase(KA ka) {
    unsigned char* const ws = P_WS;
    const unsigned* LA = (const unsigned*)(ws + OFF_LA); const unsigned* BB = (const unsigned*)(ws + OFF_RECB);
    f32x2* CA = (f32x2*)(ws + OFF_CARRY); f32x2* CH = CA + NBATCH * 64 * 640;
    const int nitem = NBATCH * 64 * 640;
    const int gstride = ogrid() * NTHREADS;
    for (int id = obid() * NTHREADS + otid(); id < nitem; id += gstride) {
        const int cp = id % 640, bj = id / 640;
        const size_t base = (size_t)bj * 64 * 640 + cp;
        float s0 = 0.f, s1 = 0.f, h0 = 0.f, h1 = 0.f;
#pragma unroll 8
        for (int t = 0; t < 64; ++t) {
            const unsigned l = LA[base + (size_t)t * 640], b = BB[base + (size_t)t * 640];
            const float l0 = bf_lo(l), l1 = bf_hi(l);
            s0 += l0; s1 += l1;
            h0 = __builtin_amdgcn_exp2f(l0) * h0 + bf_lo(b); h1 = __builtin_amdgcn_exp2f(l1) * h1 + bf_hi(b);
        }
        CA[id] = (f32x2){s0, s1}; CH[id] = (f32x2){h0, h1};
    }
}
__device__ void scan2_phase(KA ka) {
    unsigned char* const ws = P_WS;
    const unsigned* LA = (const unsigned*)(ws + OFF_LA); const unsigned* BB = (const unsigned*)(ws + OFF_RECB); unsigned* GT = (unsigned*)(ws + OFF_GATE);
    const f32x2* CA = (const f32x2*)(ws + OFF_CARRY); const f32x2* CH = CA + NBATCH * 64 * 640;
    const int nitem = NBATCH * 64 * 640;
    const int gstride = ogrid() * NTHREADS;
    for (int id = obid() * NTHREADS + otid(); id < nitem; id += gstride) {
        const int cp = id % 640, bj = id / 640, j = bj & 63, b0 = bj - j;
        float h0 = 0.f, h1 = 0.f;
        for (int jj = 0; jj < j; ++jj) { const f32x2 a = CA[(size_t)(b0 + jj) * 640 + cp], hh = CH[(size_t)(b0 + jj) * 640 + cp];
            h0 = __builtin_amdgcn_exp2f(a.x) * h0 + hh.x; h1 = __builtin_amdgcn_exp2f(a.y) * h1 + hh.y; }
        const size_t base = (size_t)bj * 64 * 640 + cp;
#pragma unroll 8
        for (int t = 0; t < 64; ++t) {
            const size_t o = base + (size_t)t * 640;
            const unsigned l = LA[o], b = BB[o], g = GT[o];
            h0 = __builtin_amdgcn_exp2f(bf_lo(l)) * h0 + bf_lo(b); h1 = __builtin_amdgcn_exp2f(bf_hi(l)) * h1 + bf_hi(b);
            GT[o] = pk_bf16(bf_lo(g) * h0, bf_hi(g) * h1);
        }
    }
}
__device__ void prep_phase(KA ka) {
    unsigned char* const ws = P_WS;
    const int tid = otid(), lane = tid & 63, wid = tid >> 6, G = ogrid(), bx = obid();
    bf16_t* QB = (bf16_t*)(ws + OFF_QB); bf16_t* KVB = (bf16_t*)(ws + OFF_KVB); bf16_t* KR = (bf16_t*)(ws + OFF_KR); const bf16_t* CB = (const bf16_t*)(ws + OFF_CBUF);
    const int* pos = (const int*)P_IN(1);
    const float* qn = (const float*)P_IN(20); const float* qr = (const float*)P_IN(21); const float* kn = (const float*)P_IN(22); const float* kr = (const float*)P_IN(23);
    const float QS = 0.07216878364870322f * 1.4426950408889634f;
    const float qn0 = qn[2 * lane], qn1 = qn[2 * lane + 1], kn0 = kn[2 * lane], kn1 = kn[2 * lane + 1], qrg = qr[lane], krg = kr[lane];
    const float inv_freq = exp2f(-(float)(lane & 31) * (13.287712379549449f / 32.0f));
    for (int t = bx * 8 + wid; t < T; t += G * 8) {
        const float ang = (float)pos[t] * inv_freq;
        const float nrev = rintf(ang * 0.15915494309189535f);
        float rr = fmaf(-nrev, 6.2831854820251465f, ang); rr = fmaf(-nrev, -1.7484556000744883e-07f, rr);
        const float sn = __sinf(rr), cs = __cosf(rr);
        {
            const float x = bf1(CB[(size_t)t * 768 + 640 + lane]);
            const float rstd = rsqrtf(wave_sum(x * x) * (1.0f / 64.0f) + EPS);
            const float xr = x * rstd * krg, pr = __shfl_xor(xr, 32);
            const float o = lane < 32 ? xr * cs - pr * sn : xr * cs + pr * sn;
            KR[(size_t)t * 64 + lane] = (bf16_t)(pk_bf16(o, 0.f) & 0xffffu);
        }
#pragma unroll 2
        for (int h = 0; h < 8; ++h) {
            unsigned* qp = (unsigned*)(QB + (size_t)t * 1536 + h * 192) + lane;
            const unsigned qw = *qp; const float q0 = bf_lo(qw), q1 = bf_hi(qw);
            bf16_t* qrp = QB + (size_t)t * 1536 + h * 192 + 128 + lane; const float xq = bf1(*qrp);
            unsigned* kp = (unsigned*)(KVB + (size_t)t * 2048 + h * 256) + lane;
            const unsigned kw = *kp; const float k0 = bf_lo(kw), k1 = bf_hi(kw);
            const float rq = rsqrtf(wave_sum(q0 * q0 + q1 * q1) * (1.0f / 128.0f) + EPS) * QS;
            const float rk = rsqrtf(wave_sum(k0 * k0 + k1 * k1) * (1.0f / 128.0f) + EPS);
            const float rqr = rsqrtf(wave_sum(xq * xq) * (1.0f / 64.0f) + EPS);
            *qp = pk_bf16(q0 * rq * qn0, q1 * rq * qn1);
            *kp = pk_bf16(k0 * rk * kn0, k1 * rk * kn1);
            const float xr = xq * rqr * qrg, pr = __shfl_xor(xr, 32);
            const float o = (lane < 32 ? xr * cs - pr * sn : xr * cs + pr * sn) * QS;
            *qrp = (bf16_t)(pk_bf16(o, 0.f) & 0xffffu);
        }
    }
}

constexpr int KP = 400, VP = 320, KBUF = 64 * KP, VBUF = 64 * VP;
__device__ __forceinline__ int crow(int r, int hi) { return (r & 3) + 8 * (r >> 2) + 4 * hi; }
__device__ void attn_phase(KA ka, LAS unsigned char* lds) {
    unsigned char* const ws = P_WS;
    const int tid = otid(), lane = tid & 63, w = __builtin_amdgcn_readfirstlane(tid >> 6), G = ogrid(), bx = obid();
    const bf16_t* QB = (const bf16_t*)(ws + OFF_QB); const bf16_t* KVB = (const bf16_t*)(ws + OFF_KVB); const bf16_t* KR = (const bf16_t*)(ws + OFF_KR); bf16_t* OB = (bf16_t*)(ws + OFF_OBUF);
    const int c = lane & 31, hi = lane >> 5;
    const int kn_key0 = tid >> 4, kn_ch = tid & 15;
    const int kr_key = tid >> 3, kr_ch = tid & 7;
    const unsigned kvoff = (unsigned)(kn_key0 * 4096 + kn_ch * 16), kroff = (unsigned)(kr_key * 128 + kr_ch * 16);
    const unsigned k_rd = (unsigned)(c * KP + hi * 16);
    const int g4 = lane >> 4, i16 = lane & 15, qq = i16 >> 2, pp = i16 & 3;
    const unsigned v_rd = (unsigned)((4 * hi + qq) * VP + (g4 & 1) * 32 + pp * 8);
    const int vcu = (G % 8 == 0) ? (bx % 8) * (G / 8) + bx / 8 : bx;
    for (int vw = vcu; vw < 256; vw += G) {
        const int bh = vw >> 2, sub = vw & 3, b = bh >> 3, h = bh & 7;
        for (int ui = 0; ui < 4; ++ui) {
            const int qb = ui == 0 ? 15 - sub : (ui == 1 ? 8 + sub : (ui == 2 ? 7 - sub : sub));
            const int q0 = qb * 256 + w * 32;
            const char* qbase = (const char*)(QB + ((size_t)b * SEQ + q0) * 1536 + h * 192);
            asm volatile("" : "+s"(qbase));
            const unsigned qoff = (unsigned)(c * 3072 + hi * 16);
            bf16x8 qf[12];
#pragma unroll
            for (int ks = 0; ks < 12; ++ks) qf[ks] = *(const bf16x8*)(qbase + qoff + ks * 32);
            f32x16 oacc[4];
#pragma unroll
            for (int i = 0; i < 4; ++i)
#pragma unroll
                for (int j = 0; j < 16; ++j) oacc[i][j] = 0.f;
            float mrun = -1e30f, lrun = 0.f;
            const int ntile = 4 * qb + 4, wlast = 4 * qb + (w >> 1);
            const char* kvbase = (const char*)(KVB + (size_t)b * SEQ * 2048 + h * 256);
            const char* krbase = (const char*)(KR + (size_t)b * SEQ * 64);
            asm volatile("" : "+s"(kvbase), "+s"(krbase));
            u32x4 sk0, sk1, skr, sv0, sv1;
#define ATT_LOADK(kt) do { const char* tb_ = kvbase + (size_t)(kt) * (64 * 4096); const char* tr_ = krbase + (size_t)(kt) * (64 * 128); \
                sk0 = *(const u32x4*)(tb_ + kvoff); sk1 = *(const u32x4*)(tb_ + 32 * 4096 + kvoff); skr = *(const u32x4*)(tr_ + kroff); } while (0)
#define ATT_LOADV(kt) do { const char* tb_ = kvbase + (size_t)(kt) * (64 * 4096) + 256; \
                sv0 = *(const u32x4*)(tb_ + kvoff); sv1 = *(const u32x4*)(tb_ + 32 * 4096 + kvoff); } while (0)
#define ATT_WRITEK(buf) do { LAS unsigned char* kb_ = lds + (buf) * KBUF; \
                *(LAS u32x4*)(kb_ + kn_key0 * KP + kn_ch * 16) = sk0; *(LAS u32x4*)(kb_ + (kn_key0 + 32) * KP + kn_ch * 16) = sk1; \
                *(LAS u32x4*)(kb_ + kr_key * KP + 256 + kr_ch * 16) = skr; } while (0)
#define ATT_WRITEV(buf) do { LAS unsigned char* vb_ = lds + 2 * KBUF + (buf) * VBUF; \
                *(LAS u32x4*)(vb_ + kn_key0 * VP + kn_ch * 16) = sv0; *(LAS u32x4*)(vb_ + (kn_key0 + 32) * VP + kn_ch * 16) = sv1; } while (0)
            __syncthreads();
            ATT_LOADK(0); ATT_LOADV(0); ATT_WRITEK(0); ATT_WRITEV(0);
            __syncthreads();
            for (int kt = 0; kt < ntile; ++kt) {
                const int buf = kt & 1;
                const bool more = kt + 1 < ntile, active = kt <= wlast;
                if (more) ATT_LOADK(kt + 1);
                f32x16 sacc[2];
                if (active) {
                    const LAS unsigned char* kb = lds + buf * KBUF + k_rd;
#pragma unroll
                    for (int kb2 = 0; kb2 < 2; ++kb2)
#pragma unroll
                        for (int j = 0; j < 16; ++j) sacc[kb2][j] = 0.f;
                    bf16x8 kf[2][4];
#define ATT_LDK(dst, g) do { _Pragma("unroll") for (int q_ = 0; q_ < 4; ++q_) dst[q_] = *(const LAS bf16x8*)(kb + ((g) / 3) * 32 * KP + (((g) % 3) * 4 + q_) * 32); } while (0)
                    ATT_LDK(kf[0], 0);
#pragma unroll
                    for (int g = 0; g < 6; ++g) {
                        if (g < 5) ATT_LDK(kf[(g + 1) & 1], g + 1);
                        __builtin_amdgcn_sched_barrier(0);
#pragma unroll
                        for (int q_ = 0; q_ < 4; ++q_) sacc[g / 3] = __builtin_amdgcn_mfma_f32_32x32x16_bf16(kf[g & 1][q_], qf[(g % 3) * 4 + q_], sacc[g / 3], 0, 0, 0);
                        __builtin_amdgcn_sched_barrier(0);
                    }
#undef ATT_LDK
                }
                if (more) { ATT_WRITEK(buf ^ 1); ATT_LOADV(kt + 1); }
                if (active) {
                    const LAS unsigned char* vb = lds + 2 * KBUF + buf * VBUF + v_rd;
                    bf16x8 vf[2][4];
#define ATT_LDV(dst, gg) do { _Pragma("unroll") for (int i_ = 0; i_ < 4; ++i_) { \
                        const s16x4 lo_ = __builtin_amdgcn_ds_read_tr16_b64_v4i16((LAS s16x4*)(vb + ((gg) * 16) * VP + i_ * 64)); \
                        const s16x4 hv_ = __builtin_amdgcn_ds_read_tr16_b64_v4i16((LAS s16x4*)(vb + ((gg) * 16 + 8) * VP + i_ * 64)); \
                        dst[i_] = __builtin_shufflevector(lo_, hv_, 0, 1, 2, 3, 4, 5, 6, 7); } } while (0)
                    ATT_LDV(vf[0], 0);
                    if (kt == wlast) {
                        const int qi = q0 + c - kt * 64;
#pragma unroll
                        for (int kb2 = 0; kb2 < 2; ++kb2)
#pragma unroll
                            for (int j = 0; j < 16; ++j) if (kb2 * 32 + crow(j, hi) > qi) sacc[kb2][j] = -INFINITY;
                    }
                    float mx = sacc[0][0];
#pragma unroll
                    for (int kb2 = 0; kb2 < 2; ++kb2)
#pragma unroll
                        for (int j = 0; j < 16; ++j) mx = fmaxf(mx, sacc[kb2][j]);
                    mx = fmaxf(mx, __shfl_xor(mx, 32));
                    const float mnew = fmaxf(mrun, mx), alpha = __builtin_amdgcn_exp2f(mrun - mnew);
                    mrun = mnew;
                    float ps = 0.f;
#pragma unroll
                    for (int kb2 = 0; kb2 < 2; ++kb2)
#pragma unroll
                        for (int j = 0; j < 16; ++j) { const float e = __builtin_amdgcn_exp2f(sacc[kb2][j] - mnew); sacc[kb2][j] = e; ps += e; }
                    lrun = lrun * alpha + ps;
#pragma unroll
                    for (int i = 0; i < 4; ++i)
#pragma unroll
                        for (int j = 0; j < 16; ++j) oacc[i][j] *= alpha;
                    bf16x8 pb[2][2];
#pragma unroll
                    for (int kb2 = 0; kb2 < 2; ++kb2)
#pragma unroll
                        for (int s2 = 0; s2 < 2; ++s2) {
                            u32x4 pw;
                            pw.x = pk_bf16(sacc[kb2][8 * s2 + 0], sacc[kb2][8 * s2 + 1]); pw.y = pk_bf16(sacc[kb2][8 * s2 + 2], sacc[kb2][8 * s2 + 3]);
                            pw.z = pk_bf16(sacc[kb2][8 * s2 + 4], sacc[kb2][8 * s2 + 5]); pw.w = pk_bf16(sacc[kb2][8 * s2 + 6], sacc[kb2][8 * s2 + 7]);
                            pb[kb2][s2] = __builtin_bit_cast(bf16x8, pw);
                        }
#pragma unroll
                    for (int gg = 0; gg < 4; ++gg) {
                        if (gg < 3) ATT_LDV(vf[(gg + 1) & 1], gg + 1);
                        __builtin_amdgcn_sched_barrier(0);
#pragma unroll
                        for (int i = 0; i < 4; ++i) oacc[i] = __builtin_amdgcn_mfma_f32_32x32x16_bf16(vf[gg & 1][i], pb[gg >> 1][gg & 1], oacc[i], 0, 0, 0);
                        __builtin_amdgcn_sched_barrier(0);
                    }
#undef ATT_LDV
                }
                if (more) ATT_WRITEV(buf ^ 1);
                __syncthreads();
            }
#undef ATT_LOADK
#undef ATT_LOADV
#undef ATT_WRITEK
#undef ATT_WRITEV
            const float ltot = lrun + __shfl_xor(lrun, 32), inv = 1.0f / ltot;
            char* obase = (char*)(OB + ((size_t)b * SEQ + q0) * DM + h * 128);
            asm volatile("" : "+s"(obase));
            const unsigned ooff = (unsigned)(c * 2048 + hi * 8);
#pragma unroll
            for (int i = 0; i < 4; ++i)
#pragma unroll
                for (int g = 0; g < 4; ++g) {
                    u32x2 wv; wv.x = pk_bf16(oacc[i][4 * g] * inv, oacc[i][4 * g + 1] * inv); wv.y = pk_bf16(oacc[i][4 * g + 2] * inv, oacc[i][4 * g + 3] * inv);
                    *(u32x2*)(obase + ooff + 64 * i + 16 * g) = wv;
                }
        }
    }
    __syncthreads();
}

#define XB_TMO      128
#define XB_XCNT(j)  (256  + 64 * (j))
#define XB_XSUB(j)  (1280 + 64 * (j))
#define XB_XGEN(j)  (2304 + 64 * (j))
#define XB_TOP      3328
#define XB_TOPGEN   3392
#define XCD_BAR_WORDS 3456
#define XB_SPIN_CAP (1u << 20)
__device__ __forceinline__ unsigned xb_ld(unsigned* p)              { return __hip_atomic_load(p, __ATOMIC_RELAXED, __HIP_MEMORY_SCOPE_AGENT); }
__device__ __forceinline__ unsigned xb_add(unsigned* p, unsigned v) { return __hip_atomic_fetch_add(p, v, __ATOMIC_RELAXED, __HIP_MEMORY_SCOPE_AGENT); }
__device__ __forceinline__ unsigned xb_xcc_id() { return (unsigned)__builtin_amdgcn_s_getreg((3 << 11) | 20) & 0xFu; }
#define XB_SPIN(cond, bar) do { unsigned _sp = 0; while (cond) { __builtin_amdgcn_s_sleep(1); \
    if ((++_sp & 255u) == 0u) { if (xb_ld(&(bar)[XB_TMO])) break; if (_sp > XB_SPIN_CAP) { atomicAdd(&(bar)[XB_TMO], 1u); break; } } } } while (0)
struct XcdBarrier { unsigned* bar; unsigned x; volatile LAS unsigned* st; };
__device__ __forceinline__ XcdBarrier xcd_barrier_post(unsigned* bar, volatile LAS unsigned* st) {
    XcdBarrier b; b.bar = bar; b.x = xb_xcc_id(); b.st = st;
    if (threadIdx.x == 0) (void)xb_add(&bar[XB_XCNT(b.x)], 1u);
    return b;
}
__device__ __forceinline__ void xcd_barrier_complete(unsigned* bar, unsigned x, unsigned& nloc, unsigned& nx) {
    const unsigned G = gridDim.x * gridDim.y * gridDim.z;
    unsigned sum, cnt, mine, sp = 0u;
    for (;;) {
        sum = 0u; cnt = 0u; mine = 0u;
#pragma unroll
        for (unsigned j = 0; j < 16; ++j) { const unsigned c = xb_ld(&bar[XB_XCNT(j)]); sum += c; cnt += (c > 0u) ? 1u : 0u; mine = (j == x) ? c : mine; }
        if (sum == G) break;
        __builtin_amdgcn_s_sleep(1);
        if ((++sp & 255u) == 0u) { if (xb_ld(&bar[XB_TMO])) break; if (sp > XB_SPIN_CAP) { atomicAdd(&bar[XB_TMO], 1u); break; } }
    }
    nloc = mine > 0u ? mine : 1u; nx = cnt > 0u ? cnt : 1u;
}
__device__ __forceinline__ void xcd_barrier(const XcdBarrier& b) {
    asm volatile("s_waitcnt vmcnt(0)" ::: "memory");
    __syncthreads();
    if (threadIdx.x == 0) {
        unsigned* bar = b.bar;
        __builtin_amdgcn_s_waitcnt(0);
        unsigned nloc = b.st[0], nx = b.st[1];
        if (nloc == 0u) { xcd_barrier_complete(bar, b.x, nloc, nx); b.st[0] = nloc; b.st[1] = nx; }
        const unsigned old = xb_add(&bar[XB_XSUB(b.x)], 1u);
        const unsigned gen = old / nloc;
        if (old + 1u == (gen + 1u) * nloc) {
            __builtin_amdgcn_fence(__ATOMIC_RELEASE, "agent");
            asm volatile("s_waitcnt vmcnt(0)" ::: "memory");
            const unsigned og = xb_add(&bar[XB_TOP], 1u);
            const unsigned tg = og / nx;
            if (og + 1u == (tg + 1u) * nx) xb_add(&bar[XB_TOPGEN], 1u);
            else XB_SPIN(xb_ld(&bar[XB_TOPGEN]) == tg, bar);
            __builtin_amdgcn_fence(__ATOMIC_ACQUIRE, "agent");
            xb_add(&bar[XB_XGEN(b.x)], 1u);
            asm volatile("s_waitcnt vmcnt(0)" ::: "memory");
        } else {
            XB_SPIN(xb_ld(&bar[XB_XGEN(b.x)]) == gen, bar);
            __builtin_amdgcn_fence(__ATOMIC_ACQUIRE, "agent");
            asm volatile("s_waitcnt vmcnt(0)" ::: "memory");
        }
    }
    __syncthreads();
}

enum { OP_CIN, OP_CONV3, OP_COUT, OP_GU, OP_DOWN, OP_LIN, OP_CONV4, OP_GATE, OP_SCAN1, OP_SCAN2, OP_LOUT, OP_MDOWN, OP_UQ, OP_UKV, OP_PREP, OP_ATTN, OP_WO };
enum { GT_NONE, GT_PAIR, GT_STORE, GT_RESID, GT_GATE };
__device__ const unsigned char g_prog[26][3] = {
    {OP_CIN, 0, 1}, {OP_CONV3, 0, 1}, {OP_COUT, 0, 1}, {OP_GU, 0, 1}, {OP_DOWN, 0, 1},
    {OP_LIN, 1, 1}, {OP_CONV4, 1, 1}, {OP_GATE, 1, 1}, {OP_SCAN1, 1, 1}, {OP_SCAN2, 1, 1}, {OP_LOUT, 1, 1}, {OP_GU, 1, 1}, {OP_DOWN, 1, 1},
    {OP_MDOWN, 2, 1}, {OP_UQ, 2, 0}, {OP_UKV, 2, 1}, {OP_PREP, 2, 1}, {OP_ATTN, 2, 1}, {OP_WO, 2, 1}, {OP_GU, 2, 1}, {OP_DOWN, 2, 1},
    {OP_CIN, 3, 1}, {OP_CONV3, 3, 1}, {OP_COUT, 3, 1}, {OP_GU, 3, 1}, {OP_DOWN, 3, 1}};

__global__ void __launch_bounds__(NTHREADS) mega_fwd(Params p) {
    extern __shared__ __attribute__((aligned(16))) unsigned char lds_raw[];
    LAS unsigned char* lds = (LAS unsigned char*)lds_raw;
    cg::grid_group grid = cg::this_grid();
    KA ka = (KA)__builtin_amdgcn_kernarg_segment_ptr();
    (void)p;
    volatile LAS unsigned* xst = (volatile LAS unsigned*)(lds + pg8::STAGE_BYTES);
    if (threadIdx.x < 4) xst[threadIdx.x] = 0u;
    __syncthreads();
    for (int i = 0; i < PROBE_P0; ++i) { phase0(ka, lds); grid.sync(); }
    phase0(ka, lds);
    grid.sync();
    (void)xcd_barrier_post((unsigned*)(P_WS + OFF_BAR), xst);
#define GRID_BAR() do { XcdBarrier xb_; xb_.bar = (unsigned*)(P_WS + OFF_BAR); xb_.x = xb_xcc_id(); xb_.st = (volatile LAS unsigned*)(lds + pg8::STAGE_BYTES); xcd_barrier(xb_); } while (0)
    for (int i = 0; i < PROBE_SYNCS; ++i) GRID_BAR();
    for (int st = 0, rep = 0; st < 26; ++st) {
        asm volatile("" : "+s"(ka));
        unsigned char* const ws = P_WS;
        float* const ssq = (float*)(ws + OFF_SSQ);
        bf16_t* const hb = (bf16_t*)(ws + OFF_HB);
        const int op = g_prog[st][0], L = g_prog[st][1], sync_after = g_prog[st][2];
        const int j = L / 3;
        int gt = GT_NONE; pg8::Gemm g{}; EP e{};
        const float* resid_in = (L == 0) ? (const float*)P_IN(0) : (const float*)P_OUT;
        switch (op) {
        case OP_CIN:
            gt = GT_PAIR; g = pg8::Gemm{hb, (const bf16_t*)(ws + OFF_WCIN) + (size_t)j * 3072 * DM, T, 3072, DM, DM, 0};
            e.o0 = (bf16_t*)(ws + OFF_U); e.ld0 = DM; e.o1 = (bf16_t*)(ws + OFF_BG); e.ld1 = DM; e.split = 8; e.mode = 1; e.q2 = ssq + (size_t)(2 * L) * T; e.inv_dim = 1.0f / DM; break;
        case OP_CONV3: conv3_phase(ka, (const float*)P_IN(4) + (size_t)j * 3 * DM); break;
        case OP_COUT:
            gt = GT_RESID; g = pg8::Gemm{(const bf16_t*)(ws + OFF_Y), (const bf16_t*)(ws + OFF_WCOUT) + (size_t)j * DM * DM, T, DM, DM, DM, 0};
            e.q2 = resid_in; e.q4 = P_OUT; e.o0 = hb; e.q3 = ssq + (size_t)(2 * L + 1) * T; break;
        case OP_GU:
            gt = GT_PAIR; g = pg8::Gemm{hb, (const bf16_t*)(ws + OFF_WGU) + (size_t)L * 2 * DFF * DM, T, 2 * DFF, DM, DM, 0};
            e.o0 = (bf16_t*)(ws + OFF_ACT); e.ld0 = DFF; e.split = 1 << 20; e.mode = 0; e.q2 = ssq + (size_t)(2 * L + 1) * T; e.inv_dim = 1.0f / DM; break;
        case OP_DOWN:
            gt = GT_RESID; g = pg8::Gemm{(const bf16_t*)(ws + OFF_ACT), (const bf16_t*)(ws + OFF_WDN) + (size_t)L * DM * DFF, T, DM, DFF, DFF, 0};
            e.q2 = P_OUT; e.q4 = P_OUT; e.o0 = hb; e.q3 = ssq + (size_t)(L < 3 ? 2 * L + 2 : 10) * T; break;
        case OP_LIN:
            gt = GT_STORE; g = pg8::Gemm{hb, (const bf16_t*)(ws + OFF_WLIN), T, 2 * LW, DM, DM, 0};
            e.o0 = (bf16_t*)(ws + OFF_GATE); e.ld0 = LW; e.o1 = (bf16_t*)(ws + OFF_RECB); e.ld1 = LW; e.split = 5; e.mode = 1; e.q2 = ssq + (size_t)(2 * L) * T; e.inv_dim = 1.0f / DM; break;
        case OP_CONV4: conv4_phase(ka); break;
        case OP_GATE:
            gt = GT_GATE; g = pg8::Gemm{(const bf16_t*)(ws + OFF_XS), (const bf16_t*)(ws + OFF_WLG), T, 2 * LW, 256, LW, 256};
            e.o0 = (bf16_t*)(ws + OFF_LA); e.o1 = (bf16_t*)(ws + OFF_RECB); e.q2 = (const bf16_t*)(ws + OFF_XS);
            e.q3 = (void*)P_IN(10); e.q4 = (void*)P_IN(12); e.q5 = (const float*)(ws + OFF_CL); break;
        case OP_SCAN1: scan1_phase(ka); break;
        case OP_SCAN2: scan2_phase(ka); break;
        case OP_LOUT:
            gt = GT_RESID; g = pg8::Gemm{(const bf16_t*)(ws + OFF_GATE), (const bf16_t*)(ws + OFF_WLOUT), T, DM, LW, LW, 0};
            e.q2 = resid_in; e.q4 = P_OUT; e.o0 = hb; e.q3 = ssq + (size_t)(2 * L + 1) * T; break;
        case OP_MDOWN:
            gt = GT_STORE; g = pg8::Gemm{hb, (const bf16_t*)(ws + OFF_WMD), T, 768, DM, DM, 0};
            e.o0 = (bf16_t*)(ws + OFF_CBUF); e.ld0 = 768; e.split = 1 << 20; e.mode = 2; e.q2 = ssq + (size_t)(2 * L) * T; e.inv_dim = 1.0f / DM;
            e.q3 = ssq + (size_t)8 * T; e.q4 = ssq + (size_t)9 * T; break;
        case OP_UQ:
            gt = GT_STORE; g = pg8::Gemm{(const bf16_t*)(ws + OFF_CBUF) + 256, (const bf16_t*)(ws + OFF_WUQ), T, 1536, 384, 768, 0};
            e.o0 = (bf16_t*)(ws + OFF_QB); e.ld0 = 1536; e.split = 1 << 20; e.mode = 0; e.q2 = ssq + (size_t)9 * T; e.inv_dim = 1.0f / 384.0f; break;
        case OP_UKV:
            gt = GT_STORE; g = pg8::Gemm{(const bf16_t*)(ws + OFF_CBUF), (const bf16_t*)(ws + OFF_WUKV), T, 2048, 256, 768, 0};
            e.o0 = (bf16_t*)(ws + OFF_KVB); e.ld0 = 2048; e.split = 1 << 20; e.mode = 0; e.q2 = ssq + (size_t)8 * T; e.inv_dim = 1.0f / 256.0f; break;
        case OP_PREP: prep_phase(ka); break;
        case OP_ATTN: attn_phase(ka, lds); break;
        case OP_WO:
            gt = GT_RESID; g = pg8::Gemm{(const bf16_t*)(ws + OFF_OBUF), (const bf16_t*)(ws + OFF_WO), T, DM, DM, DM, 0};
            e.q2 = resid_in; e.q4 = P_OUT; e.o0 = hb; e.q3 = ssq + (size_t)(2 * L + 1) * T; break;
        default: break;
        }
        if (gt != GT_NONE) {
            pg8::StaticOrder S; S.init(g.M, g.N, ogrid(), obid());
            e.type = gt - 1;
            EpiAll E{e}; pg8::gemm_phase<EpiAll>(lds, g, S, E);
        }
        if (sync_after) GRID_BAR();
        if (PROBE_OP >= 0 && op == PROBE_OP && rep == 0) { if (!sync_after) GRID_BAR(); rep = 1; --st; } else rep = 0;
    }
}

constexpr int LDS_BYTES = pg8::STAGE_BYTES + 64;

extern "C" void kernel_launch(void* const* d_in, const int* in_sizes, int n_in, void* d_out, int out_size, void* d_ws, size_t ws_size, hipStream_t stream) {
    static int grid_blocks = 0;
    if (grid_blocks == 0) {
        if (n_in != 28 || ws_size < WS_NEED) { fprintf(stderr, "kernel_launch: unexpected inputs (n_in %d, ws %zu, need %zu)\n", n_in, ws_size, (size_t)WS_NEED); grid_blocks = -1; return; }
        int dev = 0, cus = 0, per_cu = 0;
        hipGetDevice(&dev);
        hipDeviceGetAttribute(&cus, hipDeviceAttributeMultiprocessorCount, dev);
        hipFuncSetAttribute((const void*)mega_fwd, hipFuncAttributeMaxDynamicSharedMemorySize, LDS_BYTES);
        hipOccupancyMaxActiveBlocksPerMultiprocessor(&per_cu, (const void*)mega_fwd, NTHREADS, LDS_BYTES);
        if (per_cu < 1) { fprintf(stderr, "kernel_launch: occupancy query returned %d\n", per_cu); per_cu = 1; }
        grid_blocks = cus;
        (void)hipGetLastError();
    }
    if (grid_blocks < 0) return;
    Params p{};
    for (int i = 0; i < 28; ++i) p.in[i] = d_in[i];
    p.out = (float*)d_out; p.ws = (unsigned char*)d_ws;
    void* args[] = {&p};
    hipError_t e = hipLaunchCooperativeKernel((const void*)mega_fwd, dim3(grid_blocks), dim3(NTHREADS), args, LDS_BYTES, stream);
    if (e != hipSuccess) fprintf(stderr, "cooperative launch failed: %s (grid %d)\n", hipGetErrorString(e), grid_blocks);
}
```

```cpp
#include <hip/hip_runtime.h>
#include <hip/hip_cooperative_groups.h>
#include <cstdio>
namespace cg = cooperative_groups;

#define LAS __attribute__((address_space(3)))
typedef unsigned short bf16_t;
typedef short bf16x8 __attribute__((ext_vector_type(8)));
typedef short s16x4 __attribute__((ext_vector_type(4)));
typedef float f32x2 __attribute__((ext_vector_type(2)));
typedef float f32x4 __attribute__((ext_vector_type(4)));
typedef float f32x16 __attribute__((ext_vector_type(16)));
typedef unsigned u32x2 __attribute__((ext_vector_type(2)));
typedef unsigned u32x4 __attribute__((ext_vector_type(4)));
typedef __bf16 bf2_t __attribute__((ext_vector_type(2)));

#define PROBE_MASK 0x0u
#define PROBE_SYNCS 0
#define PROBE_P0 0
constexpr int T = 32768, DM = 1024, SEQ = 4096, NBATCH = 8, DFF = 2816, LW = 1280;
constexpr int NTHREADS = 512;
constexpr float EPS = 1e-6f;
constexpr size_t MiB = 1ull << 20;
constexpr size_t OFF_WCIN = 0;
constexpr size_t OFF_WCOUT = 12 * MiB;
constexpr size_t OFF_WLIN = 16 * MiB;
constexpr size_t OFF_WLG = 21 * MiB;
constexpr size_t OFF_WLOUT = 22 * MiB + MiB / 4;
constexpr size_t OFF_WMD = 24 * MiB + 3 * MiB / 4;
constexpr size_t OFF_WUQ = 26 * MiB + MiB / 4;
constexpr size_t OFF_WUKV = 27 * MiB + 3 * MiB / 8;
constexpr size_t OFF_WO = 28 * MiB + 3 * MiB / 8;
constexpr size_t OFF_WGU = 31 * MiB;
constexpr size_t OFF_WDN = 75 * MiB;
constexpr size_t OFF_HB = 97 * MiB;
constexpr size_t OFF_SSQ = 161 * MiB;
constexpr size_t OFF_CL = OFF_SSQ + 11ull * T * 4;
constexpr size_t OFF_BAR = OFF_CL + 8192;
constexpr size_t OFF_R = 163 * MiB;
constexpr size_t OFF_ACT = OFF_R;
constexpr size_t OFF_U = OFF_R, OFF_BG = OFF_R + 64 * MiB, OFF_Y = OFF_R + 128 * MiB;
constexpr size_t OFF_GATE = OFF_R, OFF_RECB = OFF_R + 80 * MiB, OFF_XS = OFF_R + 160 * MiB, OFF_LA = OFF_R + 240 * MiB, OFF_CARRY = OFF_R + 320 * MiB;
constexpr size_t OFF_CBUF = OFF_R, OFF_OBUF = OFF_R, OFF_QB = OFF_R + 64 * MiB, OFF_KVB = OFF_R + 160 * MiB, OFF_KR = OFF_R + 288 * MiB;
constexpr size_t WS_NEED = OFF_R + 326 * MiB;

struct Params { const void* in[28]; float* out; unsigned char* ws; };
typedef const void* kptr_t;
typedef const __attribute__((address_space(4))) kptr_t* KA;
#define P_IN(i) (ka[(i)])
#define P_OUT ((float*)ka[28])
#define P_WS ((unsigned char*)ka[29])

__device__ __forceinline__ unsigned pk_bf16(float lo, float hi) { bf2_t v = __builtin_convertvector((f32x2){lo, hi}, bf2_t); return __builtin_bit_cast(unsigned, v); }
__device__ __forceinline__ float bf_lo(unsigned w) { return __uint_as_float(w << 16); }
__device__ __forceinline__ float bf_hi(unsigned w) { return __uint_as_float(w & 0xffff0000u); }
__device__ __forceinline__ float bf1(bf16_t b) { return __uint_as_float(((unsigned)b) << 16); }
__device__ __forceinline__ float wave_sum(float v) {
#pragma unroll
    for (int o = 32; o >= 1; o >>= 1) v += __shfl_xor(v, o);
    return v;
}
__device__ __forceinline__ int otid() { int t = threadIdx.x; asm volatile("" : "+v"(t)); return t; }
__device__ __forceinline__ int obid() { int t = blockIdx.x; asm volatile("" : "+s"(t)); return t; }
__device__ __forceinline__ int ogrid() { int t = gridDim.x; asm volatile("" : "+s"(t)); return t; }
__device__ __forceinline__ float fast_sigmoid(float x) { return __builtin_amdgcn_rcpf(1.0f + __expf(-x)); }

namespace pg8 {
constexpr int BM = 256, BK = 64, HALF = 128, HTB = HALF * BK * 2, STAGE_BYTES = 8 * HTB, NXCD = 8, WGM = 8;
__device__ __forceinline__ int lds_byte(int r, int c) { const int st = (r >> 4) * 2 + (c >> 5), rr = r & 15, cc = c & 31, ob = rr * 64 + cc * 2; return st * 1024 + (ob ^ (((ob >> 9) & 1) << 5)); }
__device__ __forceinline__ void stage_rc(int b, int& R, int& C) { const int st = b / 1024, sb = b % 1024, swz = sb ^ (((sb >> 9) & 1) << 5); R = (st >> 1) * 16 + swz / 64; C = (st & 1) * 32 + (swz % 64) / 2; }
__device__ __forceinline__ int perm32(int rho) { const int n = rho >> 4, i = rho & 15; return 8 * (i >> 2) + 4 * n + (i & 3); }
struct Unit { int pm, pn; };
struct Gemm { const bf16_t* A; const bf16_t* Bt; int M, N, K, lda, akoff; };
struct StaticOrder {
    int nM, nN, nwg, G, c;
    __device__ void init(int M, int N, int G_, int c_) { nM = M / BM; nN = N / BM; nwg = nM * nN; G = G_; c = c_; }
    __device__ bool next(int i, Unit& u) const {
        const long L = (long)i * G + c; if (L >= nwg) return false;
        int wgid = (int)L; { const int q = nwg / NXCD, r = nwg % NXCD, xcd = wgid % NXCD, off = wgid / NXCD; wgid = (xcd < r ? xcd * (q + 1) : r * (q + 1) + (xcd - r) * q) + off; }
        const int nig = WGM * nN, gid = wgid / nig, fm = gid * WGM, gsz = (nM - fm) < WGM ? (nM - fm) : WGM;
        u.pm = fm + ((wgid % nig) % gsz); u.pn = (wgid % nig) / gsz; return true;
    }
};

template <class Epi>
__device__ __forceinline__ void gemm_phase(LAS unsigned char* lds, const Gemm g, const StaticOrder& S, const Epi& E) {
    const int tid = otid(), wid = __builtin_amdgcn_readfirstlane(tid >> 6), lane = tid & 63, wr = wid >> 2, wc = wid & 3, fr = lane & 15, fq = lane >> 4;
    const int K = g.K, nt = K / BK, lda = g.lda;
    unsigned voffA[2], voffB[2];
#pragma unroll
    for (int i = 0; i < 2; ++i) { int R, C; stage_rc(tid * 16 + i * 8192, R, C); const int Rb = Epi::PERM ? ((R & ~31) + perm32(R & 31)) : R;
        voffA[i] = (unsigned)(R * lda + C) * 2u; voffB[i] = (unsigned)(Rb * K + C) * 2u; }
    const size_t kstep = (size_t)(BK * 2);
    const size_t hstepA = (size_t)HALF * lda * 2, hstepB = (size_t)HALF * K * 2;
    const size_t tstepA = 2 * hstepA, tstepB = 2 * hstepB;
    const size_t akoffb = (size_t)g.akoff * 2;
    const unsigned ldsw = (unsigned)wid * 1024u;
    const int aoff = lds_byte(wr * 64 + fr, fq * 8), boff = lds_byte(wc * 32 + fr, fq * 8);
#define PG8_SA(b, h) (((b) * 2 + (h)) * HTB)
#define PG8_SB(b, h) ((4 + (b) * 2 + (h)) * HTB)
#define PG8_STAGE(bufoff, gbase, voff) do { _Pragma("unroll") for (int _i = 0; _i < 2; ++_i) \
        __builtin_amdgcn_global_load_lds((const unsigned*)((const char*)(gbase) + (voff)[_i]), (LAS unsigned*)(lds + (bufoff) + ldsw + _i * 8192), 16, 0, 0); } while (0)
#define PG8_LDA(dst, b, h) do { _Pragma("unroll") for (int m = 0; m < 4; ++m) _Pragma("unroll") for (int k = 0; k < 2; ++k) dst[m][k] = *(const LAS bf16x8*)(lds + PG8_SA(b, h) + aoff + m * 2048 + k * 1024); } while (0)
#define PG8_LDB(dst, b, h) do { _Pragma("unroll") for (int n = 0; n < 2; ++n) _Pragma("unroll") for (int k = 0; k < 2; ++k) dst[n][k] = *(const LAS bf16x8*)(lds + PG8_SB(b, h) + boff + n * 2048 + k * 1024); } while (0)
#define PG8_MMA(ai, bj, At, Bt) do { __builtin_amdgcn_s_setprio(1); _Pragma("unroll") for (int m = 0; m < 4; ++m) _Pragma("unroll") for (int n = 0; n < 2; ++n) _Pragma("unroll") for (int k = 0; k < 2; ++k) \
        acc[ai][bj][m][n] = __builtin_amdgcn_mfma_f32_16x16x32_bf16(Bt[n][k], At[m][k], acc[ai][bj][m][n], 0, 0, 0); __builtin_amdgcn_s_setprio(0); } while (0)
#define PG8_WAIT_V(n) asm volatile("s_waitcnt vmcnt(" #n ")" ::: "memory")
#define PG8_WAIT_L(n) asm volatile("s_waitcnt lgkmcnt(" #n ")" ::: "memory")
#define PG8_BAR __builtin_amdgcn_s_barrier()
#define PG8_SCHED __builtin_amdgcn_sched_barrier(0)
    Unit cur, nxt; int ui = 0;
    if (!S.next(0, cur)) return;
    f32x4 acc[2][2][4][2];
#pragma unroll
    for (int a = 0; a < 2; ++a)
#pragma unroll
        for (int b = 0; b < 2; ++b)
#pragma unroll
            for (int m = 0; m < 4; ++m)
#pragma unroll
                for (int n = 0; n < 2; ++n) acc[a][b][m][n] = (f32x4){0.f, 0.f, 0.f, 0.f};
    bf16x8 At[4][2], B0[2][2], B1[2][2];
    const char* cA = (const char*)g.A + (size_t)cur.pm * tstepA + (size_t)(cur.pn >> 1) * akoffb; const char* cB = (const char*)g.Bt + (size_t)cur.pn * tstepB;
    PG8_STAGE(PG8_SB(0, 0), cB, voffB); PG8_STAGE(PG8_SA(0, 0), cA, voffA); PG8_STAGE(PG8_SB(0, 1), cB + hstepB, voffB); PG8_STAGE(PG8_SA(0, 1), cA + hstepA, voffA);
    if (wr == 1) PG8_BAR;
    PG8_WAIT_V(4); PG8_BAR;
    PG8_STAGE(PG8_SB(1, 0), cB + kstep, voffB); PG8_STAGE(PG8_SA(1, 0), cA + kstep, voffA); PG8_STAGE(PG8_SB(1, 1), cB + hstepB + kstep, voffB);
    PG8_WAIT_V(6); PG8_BAR;
    for (;;) {
        const bool has_next = S.next(ui + 1, nxt);
        const char* nA = has_next ? (const char*)g.A + (size_t)nxt.pm * tstepA + (size_t)(nxt.pn >> 1) * akoffb : cA; const char* nB = has_next ? (const char*)g.Bt + (size_t)nxt.pn * tstepB : cB;
        for (int t = 0; t < nt; t += 2) {
            const bool last = (t == nt - 2);
            const char* a1 = cA + (size_t)(t + 1) * kstep;
            const char* a2 = last ? nA : cA + (size_t)(t + 2) * kstep; const char* b2 = last ? nB : cB + (size_t)(t + 2) * kstep;
            const char* a3 = a2 + kstep; const char* b3 = b2 + kstep;
            PG8_LDB(B0, 0, 0); PG8_SCHED; PG8_LDA(At, 0, 0); PG8_STAGE(PG8_SA(1, 1), a1 + hstepA, voffA);
            PG8_WAIT_L(8); PG8_BAR; PG8_WAIT_L(0); PG8_MMA(0, 0, At, B0); PG8_BAR; PG8_SCHED;
            PG8_LDB(B1, 0, 1); PG8_STAGE(PG8_SB(0, 0), b2, voffB);
            PG8_BAR; PG8_WAIT_L(0); PG8_MMA(0, 1, At, B1); PG8_BAR;
            PG8_LDA(At, 0, 1); PG8_STAGE(PG8_SA(0, 0), a2, voffA);
            PG8_BAR; PG8_WAIT_L(0); PG8_MMA(1, 0, At, B0); PG8_BAR; PG8_SCHED;
            PG8_STAGE(PG8_SB(0, 1), b2 + hstepB, voffB);
            PG8_WAIT_V(6); PG8_BAR; PG8_MMA(1, 1, At, B1); PG8_BAR;
            PG8_LDB(B0, 1, 0); PG8_SCHED; PG8_LDA(At, 1, 0); PG8_STAGE(PG8_SA(0, 1), a2 + hstepA, voffA);
            PG8_WAIT_L(8); PG8_BAR; PG8_WAIT_L(0); PG8_MMA(0, 0, At, B0); PG8_BAR; PG8_SCHED;
            PG8_LDB(B1, 1, 1); PG8_STAGE(PG8_SB(1, 0), b3, voffB);
            PG8_BAR; PG8_WAIT_L(0); PG8_MMA(0, 1, At, B1); PG8_BAR;
            PG8_LDA(At, 1, 1); PG8_STAGE(PG8_SA(1, 0), a3, voffA);
            PG8_BAR; PG8_WAIT_L(0); PG8_MMA(1, 0, At, B0); PG8_BAR; PG8_SCHED;
            PG8_STAGE(PG8_SB(1, 1), b3 + hstepB, voffB);
            PG8_WAIT_V(6); PG8_BAR; PG8_MMA(1, 1, At, B1); PG8_BAR;
        }
        E(acc, cur, wr, wc, fr, fq);
        if (!has_next) break;
#pragma unroll
        for (int a = 0; a < 2; ++a)
#pragma unroll
            for (int b = 0; b < 2; ++b)
#pragma unroll
                for (int m = 0; m < 4; ++m)
#pragma unroll
                    for (int n = 0; n < 2; ++n) acc[a][b][m][n] = (f32x4){0.f, 0.f, 0.f, 0.f};
        cur = nxt; cA = nA; cB = nB; ++ui;
    }
    PG8_WAIT_V(0);
    if (wr == 0) PG8_BAR;
    PG8_BAR;
#undef PG8_SA
#undef PG8_SB
#undef PG8_STAGE
#undef PG8_LDA
#undef PG8_LDB
#undef PG8_MMA
#undef PG8_WAIT_V
#undef PG8_WAIT_L
#undef PG8_BAR
#undef PG8_SCHED
}
}

struct EP {
    bf16_t* o0; bf16_t* o1; const void* q2; void* q3; void* q4; const void* q5;
    int ld0, ld1, split, mode, type; float inv_dim;
};
#define EP_RS(p) ((const float*)(p).q2)
#define EP_SSQ0(p) ((float*)(p).q3)
#define EP_SSQ1(p) ((float*)(p).q4)
#define EP_RESID(p) ((const float*)(p).q2)
#define EP_FOUT(p) ((float*)(p).q4)
#define EP_XS(p) ((const bf16_t*)(p).q2)
#define EP_BA(p) ((const float*)(p).q3)
#define EP_BX(p) ((const float*)(p).q4)
#define EP_CL(p) ((const float*)(p).q5)
__device__ __forceinline__ void load_rstd(const EP& p, int row0, float (&rstd)[2][4]) {
#pragma unroll
    for (int ai = 0; ai < 2; ++ai)
#pragma unroll
        for (int m = 0; m < 4; ++m) rstd[ai][m] = __builtin_amdgcn_rsqf(EP_RS(p)[row0 + ai * 128 + m * 16] * p.inv_dim + EPS);
}
__device__ __forceinline__ u32x4 pack8(const f32x4 a, const f32x4 b) { u32x4 w; w.x = pk_bf16(a[0], a[1]); w.y = pk_bf16(a[2], a[3]); w.z = pk_bf16(b[0], b[1]); w.w = pk_bf16(b[2], b[3]); return w; }

struct EpiAll {
    static constexpr bool PERM = true;
    EP p;
    __device__ __forceinline__ void operator()(const f32x4 (&acc)[2][2][4][2], const pg8::Unit& u, int wr, int wc, int fr, int fq) const {
        const int row0 = u.pm * 256 + wr * 64 + fr;
        if (p.type == 0) {
            float rstd[2][4]; load_rstd(p, row0, rstd);
            if (u.pn < p.split) {
                const int col = u.pn * 128 + wc * 32 + fq * 8;
#pragma unroll
                for (int ai = 0; ai < 2; ++ai)
#pragma unroll
                    for (int m = 0; m < 4; ++m) {
                        const float r = rstd[ai][m];
                        f32x4 v[2];
#pragma unroll
                        for (int n = 0; n < 2; ++n) {
                            const f32x4 g = acc[ai][0][m][n] * r, uu = acc[ai][1][m][n] * r;
                            if (p.mode == 0) {
#pragma unroll
                                for (int j = 0; j < 4; ++j) v[n][j] = g[j] * fast_sigmoid(g[j]) * uu[j];
                            } else v[n] = g * uu;
                        }
                        *(u32x4*)(p.o0 + (size_t)(row0 + ai * 128 + m * 16) * p.ld0 + col) = pack8(v[0], v[1]);
                    }
            } else {
                const int col = (u.pn - p.split) * 256 + wc * 32 + fq * 8;
#pragma unroll
                for (int ai = 0; ai < 2; ++ai)
#pragma unroll
                    for (int m = 0; m < 4; ++m) {
                        const float r = rstd[ai][m];
#pragma unroll
                        for (int bj = 0; bj < 2; ++bj)
                            *(u32x4*)(p.o1 + (size_t)(row0 + ai * 128 + m * 16) * p.ld1 + col + bj * 128) = pack8(acc[ai][bj][m][0] * r, acc[ai][bj][m][1] * r);
                    }
            }
        } else if (p.type == 1) {
            float rstd[2][4]; load_rstd(p, row0, rstd);
            const bool second = u.pn >= p.split;
            bf16_t* ob = second ? p.o1 : p.o0; const int ld = second ? p.ld1 : p.ld0;
            const int col = (second ? u.pn - p.split : u.pn) * 256 + wc * 32 + fq * 8;
            const bool gelu = (p.mode == 1) && !second;
#pragma unroll
            for (int ai = 0; ai < 2; ++ai)
#pragma unroll
                for (int m = 0; m < 4; ++m) {
                    const float r = rstd[ai][m]; const int row = row0 + ai * 128 + m * 16;
                    float sq[2];
#pragma unroll
                    for (int bj = 0; bj < 2; ++bj) {
                        f32x4 v0 = acc[ai][bj][m][0] * r, v1 = acc[ai][bj][m][1] * r;
                        if (gelu) {
#pragma unroll
                            for (int j = 0; j < 4; ++j) {
                                const float a = v0[j], b = v1[j];
                                v0[j] = a * fast_sigmoid(1.5957691216f * (a + 0.044715f * a * a * a));
                                v1[j] = b * fast_sigmoid(1.5957691216f * (b + 0.044715f * b * b * b));
                            }
                        }
                        sq[bj] = (v0[0] * v0[0] + v0[1] * v0[1]) + (v0[2] * v0[2] + v0[3] * v0[3]) + (v1[0] * v1[0] + v1[1] * v1[1]) + (v1[2] * v1[2] + v1[3] * v1[3]);
                        *(u32x4*)(ob + (size_t)row * ld + col + bj * 128) = pack8(v0, v1);
                    }
                    if (p.mode == 2) {
                        float s = (u.pn == 2) ? sq[0] : sq[0] + sq[1];
                        s += __shfl_xor(s, 16); s += __shfl_xor(s, 32);
                        if (fq == 0) atomicAdd((u.pn == 0 ? EP_SSQ0(p) : EP_SSQ1(p)) + row, s);
                    }
                }
        } else if (p.type == 2) {
            const int col0 = u.pn * 256 + wc * 32 + 8 * fq;
#pragma unroll
            for (int ai = 0; ai < 2; ++ai) {
                f32x4 rb[4][2][2];
#pragma unroll
                for (int m = 0; m < 4; ++m)
#pragma unroll
                    for (int bj = 0; bj < 2; ++bj) {
                        const float* rp = EP_RESID(p) + (size_t)(row0 + ai * 128 + m * 16) * DM + col0 + bj * 128;
                        rb[m][bj][0] = *(const f32x4*)rp; rb[m][bj][1] = *(const f32x4*)(rp + 4);
                    }
                asm volatile("" ::: "memory");
#pragma unroll
                for (int m = 0; m < 4; ++m) {
                    const int row = row0 + ai * 128 + m * 16; const size_t off = (size_t)row * DM + col0;
                    float s = 0.f;
#pragma unroll
                    for (int bj = 0; bj < 2; ++bj) {
                        const f32x4 o0 = rb[m][bj][0] + acc[ai][bj][m][0], o1 = rb[m][bj][1] + acc[ai][bj][m][1];
                        *(f32x4*)(EP_FOUT(p) + off + bj * 128) = o0; *(f32x4*)(EP_FOUT(p) + off + bj * 128 + 4) = o1;
                        *(u32x4*)(p.o0 + off + bj * 128) = pack8(o0, o1);
                        s += (o0[0] * o0[0] + o0[1] * o0[1]) + (o0[2] * o0[2] + o0[3] * o0[3]) + (o1[0] * o1[0] + o1[1] * o1[1]) + (o1[2] * o1[2] + o1[3] * o1[3]);
                    }
                    s += __shfl_xor(s, 16); s += __shfl_xor(s, 32);
                    if (fq == 0) atomicAdd(EP_SSQ0(p) + row, s);
                }
                asm volatile("" ::: "memory");
            }
        } else {
            const int col = u.pn * 128 + wc * 32 + fq * 8;
#pragma unroll
            for (int n = 0; n < 2; ++n) {
                const f32x4 ba = *(const f32x4*)(EP_BA(p) + col + 4 * n), bx = *(const f32x4*)(EP_BX(p) + col + 4 * n), cl = *(const f32x4*)(EP_CL(p) + col + 4 * n);
                u32x2 xw[2][4];
#pragma unroll
                for (int ai = 0; ai < 2; ++ai)
#pragma unroll
                    for (int m = 0; m < 4; ++m) xw[ai][m] = *(const u32x2*)(EP_XS(p) + (size_t)(row0 + ai * 128 + m * 16) * LW + col + 4 * n);
                asm volatile("" ::: "memory");
#pragma unroll
                for (int ai = 0; ai < 2; ++ai)
#pragma unroll
                    for (int m = 0; m < 4; ++m) {
                        const size_t off = (size_t)(row0 + ai * 128 + m * 16) * LW + col + 4 * n;
                        const float xv[4] = {bf_lo(xw[ai][m].x), bf_hi(xw[ai][m].x), bf_lo(xw[ai][m].y), bf_hi(xw[ai][m].y)};
                        f32x4 la, bb;
#pragma unroll
                        for (int j = 0; j < 4; ++j) {
                            const float r = fast_sigmoid(acc[ai][0][m][n][j] + ba[j]), ig = fast_sigmoid(acc[ai][1][m][n][j] + bx[j]);
                            const float l = r * cl[j];
                            const float a2 = __builtin_amdgcn_exp2f(2.0f * l);
                            la[j] = l; bb[j] = __builtin_amdgcn_sqrtf(fmaxf(1.0f - a2, 0.f)) * ig * xv[j];
                        }
                        u32x2 w0, w1; w0.x = pk_bf16(la[0], la[1]); w0.y = pk_bf16(la[2], la[3]); w1.x = pk_bf16(bb[0], bb[1]); w1.y = pk_bf16(bb[2], bb[3]);
                        *(u32x2*)(p.o0 + off) = w0;
                        *(u32x2*)(p.o1 + off) = w1;
                    }
                asm volatile("" ::: "memory");
            }
        }
    }
};

struct Job { const float* src; int K, ldsrc; bf16_t* dst; int ndst; const float* gain; int perm; };
__device__ __forceinline__ int src_col(int perm, int n0, int nsrc) {
    const int tile = n0 >> 8, r = n0 & 255;
    if (perm == 1) return r < 128 ? 128 * tile + r : DFF + 128 * tile + (r - 128);
    if (perm == 2) return tile < 8 ? (r < 128 ? 1024 + 128 * tile + r : 2048 + 128 * tile + (r - 128)) : (tile - 8) * 256 + r;
    if (perm == 3) return n0 < 256 ? 384 + n0 : (n0 < 640 ? n0 - 256 : (n0 == 640 ? 640 : -1));
    return n0 < nsrc ? n0 : -1;
}
__device__ __forceinline__ void get_job(KA ka, int j, Job& jb) {
    unsigned char* const ws = P_WS;
    const float* mixn = (const float*)P_IN(2); const float* ffnn = (const float*)P_IN(25);
        if (j < 2) { jb = Job{(const float*)P_IN(3) + (size_t)j * DM * 3072, DM, 3072, (bf16_t*)(ws + OFF_WCIN) + (size_t)j * 3072 * DM, 3072, mixn + (j == 0 ? 0 : 3) * DM, 2}; }
    else if (j < 4) { const int i = j - 2; jb = Job{(const float*)P_IN(5) + (size_t)i * DM * DM, DM, DM, (bf16_t*)(ws + OFF_WCOUT) + (size_t)i * DM * DM, DM, nullptr, 0}; }
    else if (j == 4) jb = Job{(const float*)P_IN(6), DM, 2 * LW, (bf16_t*)(ws + OFF_WLIN), 2 * LW, mixn + 1 * DM, 0};
    else if (j == 5) jb = Job{(const float*)P_IN(14), LW, DM, (bf16_t*)(ws + OFF_WLOUT), DM, nullptr, 0};
    else if (j == 6) jb = Job{(const float*)P_IN(15), DM, 704, (bf16_t*)(ws + OFF_WMD), 768, mixn + 2 * DM, 3};
    else if (j == 7) jb = Job{(const float*)P_IN(18), 384, 1536, (bf16_t*)(ws + OFF_WUQ), 1536, (const float*)P_IN(16), 0};
    else if (j == 8) jb = Job{(const float*)P_IN(19), 256, 2048, (bf16_t*)(ws + OFF_WUKV), 2048, (const float*)P_IN(17), 0};
    else if (j == 9) jb = Job{(const float*)P_IN(24), DM, DM, (bf16_t*)(ws + OFF_WO), DM, nullptr, 0};
    else if (j < 14) { const int i = j - 10; jb = Job{(const float*)P_IN(26) + (size_t)i * DM * 2 * DFF, DM, 2 * DFF, (bf16_t*)(ws + OFF_WGU) + (size_t)i * 2 * DFF * DM, 2 * DFF, ffnn + i * DM, 1}; }
    else { const int i = j - 14; jb = Job{(const float*)P_IN(27) + (size_t)i * DFF * DM, DFF, DM, (bf16_t*)(ws + OFF_WDN) + (size_t)i * DM * DFF, DM, nullptr, 0}; }
}
__device__ void phase0(KA ka, LAS unsigned char* lds) {
    unsigned char* const ws = P_WS;
    const int tid = otid(), G = ogrid(), bx = obid(), lane = tid & 63, wid = tid >> 6;
    { float* z = (float*)(ws + OFF_SSQ) + T; const int n = 10 * T; for (int i = bx * NTHREADS + tid; i < n; i += G * NTHREADS) z[i] = 0.f; }
    if (bx == 0) { unsigned* bw = (unsigned*)(ws + OFF_BAR); for (int i = tid; i < 3456; i += NTHREADS) bw[i] = 0u; }
    if (bx == 0) { const float* lam = (const float*)P_IN(13); float* cl = (float*)(ws + OFF_CL); for (int c = tid; c < LW; c += NTHREADS) cl[c] = -8.0f * 1.4426950408889634f * log1pf(expf(-lam[c])); }
    { bf16_t* wlg = (bf16_t*)(ws + OFF_WLG); const float* wa = (const float*)P_IN(9); const float* wx = (const float*)P_IN(11);
      for (int i = bx * NTHREADS + tid; i < 2560 * 256; i += G * NTHREADS) { const int k = i & 255, row = i >> 8, n = row >> 8, gsel = (row >> 7) & 1, e = row & 127;
          float v = 0.f; if ((k >> 7) == (n & 1)) v = (gsel ? wx : wa)[((size_t)n * 128 + (k & 127)) * 128 + e];
          wlg[i] = (bf16_t)(pk_bf16(v, 0.f) & 0xffffu); } }
    { const float* x = (const float*)P_IN(0); bf16_t* hb = (bf16_t*)(ws + OFF_HB); float* ssq = (float*)(ws + OFF_SSQ);
      for (int row = bx * 8 + wid; row < T; row += G * 8) { float s = 0.f;
#pragma unroll
          for (int i = 0; i < 4; ++i) { const f32x4 v = *(const f32x4*)(x + (size_t)row * DM + i * 256 + lane * 4); s += (v[0] * v[0] + v[1] * v[1]) + (v[2] * v[2] + v[3] * v[3]);
              u32x2 w; w.x = pk_bf16(v[0], v[1]); w.y = pk_bf16(v[2], v[3]); *(u32x2*)(hb + (size_t)row * DM + i * 256 + lane * 4) = w; }
          s = wave_sum(s); if (lane == 0) ssq[row] = s; } }
    LAS float* tile = (LAS float*)lds;
    for (int j = 0; j < 18; ++j) {
        Job jb; get_job(ka, j, jb);
        const int tk = jb.K / 64, tn = jb.ndst / 64, ntile = tk * tn;
        for (int t = bx; t < ntile; t += G) {
            const int k0 = (t % tk) * 64, n0 = (t / tk) * 64; const int sc = src_col(jb.perm, n0, jb.ldsrc);
            __syncthreads();
#pragma unroll
            for (int i = 0; i < 8; ++i) { const int k = i * 8 + (tid >> 6), n = tid & 63; tile[k * 65 + n] = sc >= 0 ? jb.src[(size_t)(k0 + k) * jb.ldsrc + sc + n] : 0.f; }
            __syncthreads();
            const int n = tid >> 3, kc = (tid & 7) * 8; float v[8];
#pragma unroll
            for (int i = 0; i < 8; ++i) v[i] = tile[(kc + i) * 65 + n] * (jb.gain ? jb.gain[k0 + kc + i] : 1.0f);
            u32x4 w; w.x = pk_bf16(v[0], v[1]); w.y = pk_bf16(v[2], v[3]); w.z = pk_bf16(v[4], v[5]); w.w = pk_bf16(v[6], v[7]);
            *(u32x4*)(jb.dst + (size_t)(n0 + n) * jb.K + k0 + kc) = w;
        }
    }
    __syncthreads();
}

__device__ void conv3_phase(KA ka, const float* cw) {
    unsigned char* const ws = P_WS;
    const bf16_t* U = (const bf16_t*)(ws + OFF_U); const bf16_t* BG = (const bf16_t*)(ws + OFF_BG); bf16_t* Y = (bf16_t*)(ws + OFF_Y);
    const int nitem = (T / 16) * 128;
    const int gstride = ogrid() * NTHREADS;
    for (int id = obid() * NTHREADS + otid(); id < nitem; id += gstride) {
        const int cgp = id & 127, rc = id >> 7, c0 = cgp * 8, t0 = rc * 16;
        float w0[8], w1[8], w2[8], um2[8], um1[8];
#pragma unroll
        for (int j = 0; j < 8; ++j) { w0[j] = cw[c0 + j]; w1[j] = cw[DM + c0 + j]; w2[j] = cw[2 * DM + c0 + j]; um2[j] = 0.f; um1[j] = 0.f; }
        if ((t0 & (SEQ - 1)) != 0) {
            const u32x4 a = *(const u32x4*)(U + (size_t)(t0 - 2) * DM + c0), b = *(const u32x4*)(U + (size_t)(t0 - 1) * DM + c0);
            um2[0] = bf_lo(a.x); um2[1] = bf_hi(a.x); um2[2] = bf_lo(a.y); um2[3] = bf_hi(a.y); um2[4] = bf_lo(a.z); um2[5] = bf_hi(a.z); um2[6] = bf_lo(a.w); um2[7] = bf_hi(a.w);
            um1[0] = bf_lo(b.x); um1[1] = bf_hi(b.x); um1[2] = bf_lo(b.y); um1[3] = bf_hi(b.y); um1[4] = bf_lo(b.z); um1[5] = bf_hi(b.z); um1[6] = bf_lo(b.w); um1[7] = bf_hi(b.w);
        }
#pragma unroll 4
        for (int r = 0; r < 16; ++r) {
            const size_t off = (size_t)(t0 + r) * DM + c0;
            const u32x4 a = *(const u32x4*)(U + off), g = *(const u32x4*)(BG + off);
            const float uc[8] = {bf_lo(a.x), bf_hi(a.x), bf_lo(a.y), bf_hi(a.y), bf_lo(a.z), bf_hi(a.z), bf_lo(a.w), bf_hi(a.w)};
            const float gv[8] = {bf_lo(g.x), bf_hi(g.x), bf_lo(g.y), bf_hi(g.y), bf_lo(g.z), bf_hi(g.z), bf_lo(g.w), bf_hi(g.w)};
            float y[8];
#pragma unroll
            for (int j = 0; j < 8; ++j) { y[j] = gv[j] * (w0[j] * um2[j] + w1[j] * um1[j] + w2[j] * uc[j]); um2[j] = um1[j]; um1[j] = uc[j]; }
            u32x4 w; w.x = pk_bf16(y[0], y[1]); w.y = pk_bf16(y[2], y[3]); w.z = pk_bf16(y[4], y[5]); w.w = pk_bf16(y[6], y[7]);
            *(u32x4*)(Y + off) = w;
        }
    }
}
__device__ void conv4_phase(KA ka) {
    unsigned char* const ws = P_WS;
    const bf16_t* R = (const bf16_t*)(ws + OFF_RECB); bf16_t* XS = (bf16_t*)(ws + OFF_XS);
    const float* cw = (const float*)P_IN(7); const float* cb = (const float*)P_IN(8);
    const int nitem = (T / 16) * 160;
    const int gstride = ogrid() * NTHREADS;
    for (int id = obid() * NTHREADS + otid(); id < nitem; id += gstride) {
        const int cgp = id % 160, rc = id / 160, c0 = cgp * 8, t0 = rc * 16;
        float w0[8], w1[8], w2[8], w3[8], bs[8], x3[8], x2[8], x1[8];
#pragma unroll
        for (int j = 0; j < 8; ++j) { w0[j] = cw[c0 + j]; w1[j] = cw[LW + c0 + j]; w2[j] = cw[2 * LW + c0 + j]; w3[j] = cw[3 * LW + c0 + j]; bs[j] = cb[c0 + j]; x3[j] = 0.f; x2[j] = 0.f; x1[j] = 0.f; }
        if ((t0 & (SEQ - 1)) != 0) {
            const u32x4 a = *(const u32x4*)(R + (size_t)(t0 - 3) * LW + c0), b = *(const u32x4*)(R + (size_t)(t0 - 2) * LW + c0), c = *(const u32x4*)(R + (size_t)(t0 - 1) * LW + c0);
            x3[0] = bf_lo(a.x); x3[1] = bf_hi(a.x); x3[2] = bf_lo(a.y); x3[3] = bf_hi(a.y); x3[4] = bf_lo(a.z); x3[5] = bf_hi(a.z); x3[6] = bf_lo(a.w); x3[7] = bf_hi(a.w);
            x2[0] = bf_lo(b.x); x2[1] = bf_hi(b.x); x2[2] = bf_lo(b.y); x2[3] = bf_hi(b.y); x2[4] = bf_lo(b.z); x2[5] = bf_hi(b.z); x2[6] = bf_lo(b.w); x2[7] = bf_hi(b.w);
            x1[0] = bf_lo(c.x); x1[1] = bf_hi(c.x); x1[2] = bf_lo(c.y); x1[3] = bf_hi(c.y); x1[4] = bf_lo(c.z); x1[5] = bf_hi(c.z); x1[6] = bf_lo(c.w); x1[7] = bf_hi(c.w);
        }
#pragma unroll 4
        for (int r = 0; r < 16; ++r) {
            const size_t off = (size_t)(t0 + r) * LW + c0;
            const u32x4 a = *(const u32x4*)(R + off);
            const float xc[8] = {bf_lo(a.x), bf_hi(a.x), bf_lo(a.y), bf_hi(a.y), bf_lo(a.z), bf_hi(a.z), bf_lo(a.w), bf_hi(a.w)};
            float y[8];
#pragma unroll
            for (int j = 0; j < 8; ++j) { y[j] = bs[j] + w0[j] * x3[j] + w1[j] * x2[j] + w2[j] * x1[j] + w3[j] * xc[j]; x3[j] = x2[j]; x2[j] = x1[j]; x1[j] = xc[j]; }
            u32x4 w; w.x = pk_bf16(y[0], y[1]); w.y = pk_bf16(y[2], y[3]); w.z = pk_bf16(y[4], y[5]); w.w = pk_bf16(y[6], y[7]);
            *(u32x4*)(XS + off) = w;
        }
    }
}
__device__ __forceinline__ void unpack8(const u32x4 w, float (&v)[8]) { v[0] = bf_lo(w.x); v[1] = bf_hi(w.x); v[2] = bf_lo(w.y); v[3] = bf_hi(w.y); v[4] = bf_lo(w.z); v[5] = bf_hi(w.z); v[6] = bf_lo(w.w); v[7] = bf_hi(w.w); }
__device__ void scan1_phase(KA ka) {
    unsigned char* const ws = P_WS;
    const bf16_t* LA = (const bf16_t*)(ws + OFF_LA); const bf16_t* BB = (const bf16_t*)(ws + OFF_RECB);
    float* CA = (float*)(ws + OFF_CARRY); float* CH = CA + NBATCH * 64 * LW;
    const int nitem = NBATCH * 64 * 160;
    const int gstride = ogrid() * NTHREADS;
    for (int id = obid() * NTHREADS + otid(); id < nitem; id += gstride) {
        const int c8 = id % 160, bj = id / 160;
        const size_t base = (size_t)bj * 64 * LW + c8 * 8;
        float s[8], h[8];
#pragma unroll
        for (int k = 0; k < 8; ++k) { s[k] = 0.f; h[k] = 0.f; }
#pragma unroll 8
        for (int t = 0; t < 64; ++t) {
            float l[8], b[8]; unpack8(*(const u32x4*)(LA + base + (size_t)t * LW), l); unpack8(*(const u32x4*)(BB + base + (size_t)t * LW), b);
#pragma unroll
            for (int k = 0; k < 8; ++k) { s[k] += l[k]; h[k] = __builtin_amdgcn_exp2f(l[k]) * h[k] + b[k]; }
        }
        float* ca = CA + (size_t)bj * LW + c8 * 8; float* ch = CH + (size_t)bj * LW + c8 * 8;
        *(f32x4*)ca = (f32x4){s[0], s[1], s[2], s[3]}; *(f32x4*)(ca + 4) = (f32x4){s[4], s[5], s[6], s[7]};
        *(f32x4*)ch = (f32x4){h[0], h[1], h[2], h[3]}; *(f32x4*)(ch + 4) = (f32x4){h[4], h[5], h[6], h[7]};
    }
}
__device__ void scan2_phase(KA ka) {
    unsigned char* const ws = P_WS;
    const bf16_t* LA = (const bf16_t*)(ws + OFF_LA); const bf16_t* BB = (const bf16_t*)(ws + OFF_RECB); bf16_t* GT = (bf16_t*)(ws + OFF_GATE);
    const float* CA = (const float*)(ws + OFF_CARRY); const float* CH = CA + NBATCH * 64 * LW;
    const int nitem = NBATCH * 64 * 160;
    const int gstride = ogrid() * NTHREADS;
    for (int id = obid() * NTHREADS + otid(); id < nitem; id += gstride) {
        const int c8 = id % 160, bj = id / 160, j = bj & 63, b0 = bj - j;
        float h[8];
#pragma unroll
        for (int k = 0; k < 8; ++k) h[k] = 0.f;
        const float* ca = CA + (size_t)b0 * LW + c8 * 8; const float* ch = CH + (size_t)b0 * LW + c8 * 8;
#pragma unroll 8
        for (int jj = 0; jj < j; ++jj) {
            const f32x4 a0 = *(const f32x4*)(ca + (size_t)jj * LW), a1 = *(const f32x4*)(ca + (size_t)jj * LW + 4);
            const f32x4 h0 = *(const f32x4*)(ch + (size_t)jj * LW), h1 = *(const f32x4*)(ch + (size_t)jj * LW + 4);
#pragma unroll
            for (int k = 0; k < 4; ++k) { h[k] = __builtin_amdgcn_exp2f(a0[k]) * h[k] + h0[k]; h[4 + k] = __builtin_amdgcn_exp2f(a1[k]) * h[4 + k] + h1[k]; }
        }
        const size_t base = (size_t)bj * 64 * LW + c8 * 8;
#pragma unroll 8
        for (int t = 0; t < 64; ++t) {
            const size_t o = base + (size_t)t * LW;
            float l[8], b[8], g[8]; unpack8(*(const u32x4*)(LA + o), l); unpack8(*(const u32x4*)(BB + o), b); unpack8(*(const u32x4*)(GT + o), g);
#pragma unroll
            for (int k = 0; k < 8; ++k) { h[k] = __builtin_amdgcn_exp2f(l[k]) * h[k] + b[k]; g[k] *= h[k]; }
            u32x4 w; w.x = pk_bf16(g[0], g[1]); w.y = pk_bf16(g[2], g[3]); w.z = pk_bf16(g[4], g[5]); w.w = pk_bf16(g[6], g[7]);
            *(u32x4*)(GT + o) = w;
        }
    }
}
__device__ __forceinline__ float sum8(float v) { v += __shfl_xor(v, 1); v += __shfl_xor(v, 2); v += __shfl_xor(v, 4); return v; }
__device__ void prep_phase(KA ka) {
    unsigned char* const ws = P_WS;
    const int tid = otid(), lane = tid & 63, wid = tid >> 6, G = ogrid(), bx = obid();
    bf16_t* QB = (bf16_t*)(ws + OFF_QB); bf16_t* KVB = (bf16_t*)(ws + OFF_KVB); bf16_t* KR = (bf16_t*)(ws + OFF_KR); const bf16_t* CB = (const bf16_t*)(ws + OFF_CBUF);
    const int* pos = (const int*)P_IN(1);
    const float* qn = (const float*)P_IN(20); const float* qr = (const float*)P_IN(21); const float* kn = (const float*)P_IN(22); const float* kr = (const float*)P_IN(23);
    const float QS = 0.07216878364870322f * 1.4426950408889634f;
    const int h = lane >> 3, j = lane & 7;
    float qng[16], kng[16], qrg[8], krg[8], ifq[8];
#pragma unroll
    for (int e = 0; e < 16; ++e) { qng[e] = qn[16 * j + e] * QS; kng[e] = kn[16 * j + e]; }
#pragma unroll
    for (int e = 0; e < 8; ++e) { qrg[e] = qr[8 * j + e] * QS; krg[e] = kr[8 * j + e]; ifq[e] = exp2f(-(float)(8 * (j & 3) + e) * (13.287712379549449f / 32.0f)); }
    for (int t = bx * 8 + wid; t < T; t += G * 8) {
        bf16_t* qp = QB + (size_t)t * 1536 + h * 192; bf16_t* kp = KVB + (size_t)t * 2048 + h * 256;
        const u32x4 qa = *(const u32x4*)(qp + 16 * j), qb2 = *(const u32x4*)(qp + 16 * j + 8), qc = *(const u32x4*)(qp + 128 + 8 * j);
        const u32x4 kA = *(const u32x4*)(kp + 16 * j), kB = *(const u32x4*)(kp + 16 * j + 8);
        const u32x4 kc = *(const u32x4*)(CB + (size_t)t * 768 + 640 + 8 * j);
        const float fp = (float)pos[t];
        float cs[8], sn[8];
#pragma unroll
        for (int e = 0; e < 8; ++e) {
            const float ang = fp * ifq[e];
            const float nrev = rintf(ang * 0.15915494309189535f);
            float rr = fmaf(-nrev, 6.2831854820251465f, ang); rr = fmaf(-nrev, -1.7484556000744883e-07f, rr);
            sn[e] = __sinf(rr); cs[e] = __cosf(rr);
        }
        float q[16], k[16], xq[8], xk[8];
        unpack8(qa, *(float(*)[8])&q[0]); unpack8(qb2, *(float(*)[8])&q[8]); unpack8(kA, *(float(*)[8])&k[0]); unpack8(kB, *(float(*)[8])&k[8]); unpack8(qc, xq); unpack8(kc, xk);
        float sq = 0.f, sk = 0.f, sqr = 0.f, skr = 0.f;
#pragma unroll
        for (int e = 0; e < 16; ++e) { sq += q[e] * q[e]; sk += k[e] * k[e]; }
#pragma unroll
        for (int e = 0; e < 8; ++e) { sqr += xq[e] * xq[e]; skr += xk[e] * xk[e]; }
        sq = sum8(sq); sk = sum8(sk); sqr = sum8(sqr); skr = sum8(skr);
        const float rq = rsqrtf(sq * (1.0f / 128.0f) + EPS), rk = rsqrtf(sk * (1.0f / 128.0f) + EPS), rqr = rsqrtf(sqr * (1.0f / 64.0f) + EPS), rkr = rsqrtf(skr * (1.0f / 64.0f) + EPS);
#pragma unroll
        for (int e = 0; e < 16; ++e) { q[e] *= rq * qng[e]; k[e] *= rk * kng[e]; }
        float oq[8], ok[8];
#pragma unroll
        for (int e = 0; e < 8; ++e) {
            const float a = xq[e] * rqr * qrg[e], pa = __shfl_xor(a, 4);
            const float b = xk[e] * rkr * krg[e], pb = __shfl_xor(b, 4);
            oq[e] = j < 4 ? a * cs[e] - pa * sn[e] : a * cs[e] + pa * sn[e];
            ok[e] = j < 4 ? b * cs[e] - pb * sn[e] : b * cs[e] + pb * sn[e];
        }
        u32x4 w;
        w.x = pk_bf16(q[0], q[1]); w.y = pk_bf16(q[2], q[3]); w.z = pk_bf16(q[4], q[5]); w.w = pk_bf16(q[6], q[7]); *(u32x4*)(qp + 16 * j) = w;
        w.x = pk_bf16(q[8], q[9]); w.y = pk_bf16(q[10], q[11]); w.z = pk_bf16(q[12], q[13]); w.w = pk_bf16(q[14], q[15]); *(u32x4*)(qp + 16 * j + 8) = w;
        w.x = pk_bf16(oq[0], oq[1]); w.y = pk_bf16(oq[2], oq[3]); w.z = pk_bf16(oq[4], oq[5]); w.w = pk_bf16(oq[6], oq[7]); *(u32x4*)(qp + 128 + 8 * j) = w;
        w.x = pk_bf16(k[0], k[1]); w.y = pk_bf16(k[2], k[3]); w.z = pk_bf16(k[4], k[5]); w.w = pk_bf16(k[6], k[7]); *(u32x4*)(kp + 16 * j) = w;
        w.x = pk_bf16(k[8], k[9]); w.y = pk_bf16(k[10], k[11]); w.z = pk_bf16(k[12], k[13]); w.w = pk_bf16(k[14], k[15]); *(u32x4*)(kp + 16 * j + 8) = w;
        if (h == 0) { w.x = pk_bf16(ok[0], ok[1]); w.y = pk_bf16(ok[2], ok[3]); w.z = pk_bf16(ok[4], ok[5]); w.w = pk_bf16(ok[6], ok[7]); *(u32x4*)(KR + (size_t)t * 64 + 8 * j) = w; }
    }
}

constexpr int KP = 400, VP = 320, KBUF = 64 * KP, VBUF = 64 * VP;
__device__ __forceinline__ int crow(int r, int hi) { return (r & 3) + 8 * (r >> 2) + 4 * hi; }
__device__ void attn_phase(KA ka, LAS unsigned char* lds) {
    unsigned char* const ws = P_WS;
    const int tid = otid(), lane = tid & 63, w = __builtin_amdgcn_readfirstlane(tid >> 6), G = ogrid(), bx = obid();
    const bf16_t* QB = (const bf16_t*)(ws + OFF_QB); const bf16_t* KVB = (const bf16_t*)(ws + OFF_KVB); const bf16_t* KR = (const bf16_t*)(ws + OFF_KR); bf16_t* OB = (bf16_t*)(ws + OFF_OBUF);
    const int c = lane & 31, hi = lane >> 5;
    const int kn_key0 = tid >> 4, kn_ch = tid & 15;
    const int kr_key = tid >> 3, kr_ch = tid & 7;
    const unsigned kvoff = (unsigned)(kn_key0 * 4096 + kn_ch * 16), kroff = (unsigned)(kr_key * 128 + kr_ch * 16);
    const unsigned k_rd = (unsigned)(c * KP + hi * 16);
    const int g4 = lane >> 4, i16 = lane & 15, qq = i16 >> 2, pp = i16 & 3;
    const unsigned v_rd = (unsigned)((4 * hi + qq) * VP + (g4 & 1) * 32 + pp * 8);
    const int vcu = (G % 8 == 0) ? (bx % 8) * (G / 8) + bx / 8 : bx;
    for (int vw = vcu; vw < 256; vw += G) {
        const int bh = vw >> 2, sub = vw & 3, b = bh >> 3, h = bh & 7;
        for (int ui = 0; ui < 4; ++ui) {
            const int qb = ui == 0 ? 15 - sub : (ui == 1 ? 8 + sub : (ui == 2 ? 7 - sub : sub));
            const int q0 = qb * 256 + w * 32;
            const char* qbase = (const char*)(QB + ((size_t)b * SEQ + q0) * 1536 + h * 192);
            asm volatile("" : "+s"(qbase));
            const unsigned qoff = (unsigned)(c * 3072 + hi * 16);
            bf16x8 qf[12];
#pragma unroll
            for (int ks = 0; ks < 12; ++ks) qf[ks] = *(const bf16x8*)(qbase + qoff + ks * 32);
            f32x16 oacc[4];
#pragma unroll
            for (int i = 0; i < 4; ++i)
#pragma unroll
                for (int j = 0; j < 16; ++j) oacc[i][j] = 0.f;
            float mrun = -1e30f, lrun = 0.f;
            const int ntile = 4 * qb + 4, wlast = 4 * qb + (w >> 1);
            const char* kvbase = (const char*)(KVB + (size_t)b * SEQ * 2048 + h * 256);
            const char* krbase = (const char*)(KR + (size_t)b * SEQ * 64);
            asm volatile("" : "+s"(kvbase), "+s"(krbase));
            u32x4 sk0, sk1, skr, sv0, sv1;
#define ATT_LOADK(kt) do { const char* tb_ = kvbase + (size_t)(kt) * (64 * 4096); const char* tr_ = krbase + (size_t)(kt) * (64 * 128); \
                sk0 = *(const u32x4*)(tb_ + kvoff); sk1 = *(const u32x4*)(tb_ + 32 * 4096 + kvoff); skr = *(const u32x4*)(tr_ + kroff); } while (0)
#define ATT_LOADV(kt) do { const char* tb_ = kvbase + (size_t)(kt) * (64 * 4096) + 256; \
                sv0 = *(const u32x4*)(tb_ + kvoff); sv1 = *(const u32x4*)(tb_ + 32 * 4096 + kvoff); } while (0)
#define ATT_WRITEK(buf) do { LAS unsigned char* kb_ = lds + (buf) * KBUF; \
                *(LAS u32x4*)(kb_ + kn_key0 * KP + kn_ch * 16) = sk0; *(LAS u32x4*)(kb_ + (kn_key0 + 32) * KP + kn_ch * 16) = sk1; \
                *(LAS u32x4*)(kb_ + kr_key * KP + 256 + kr_ch * 16) = skr; } while (0)
#define ATT_WRITEV(buf) do { LAS unsigned char* vb_ = lds + 2 * KBUF + (buf) * VBUF; \
                *(LAS u32x4*)(vb_ + kn_key0 * VP + kn_ch * 16) = sv0; *(LAS u32x4*)(vb_ + (kn_key0 + 32) * VP + kn_ch * 16) = sv1; } while (0)
            __syncthreads();
            ATT_LOADK(0); ATT_LOADV(0); ATT_WRITEK(0); ATT_WRITEV(0);
            __syncthreads();
            for (int kt = 0; kt < ntile; ++kt) {
                const int buf = kt & 1;
                const bool more = kt + 1 < ntile, active = kt <= wlast;
                if (more) ATT_LOADK(kt + 1);
                f32x16 sacc[2];
                if (active) {
                    const LAS unsigned char* kb = lds + buf * KBUF + k_rd;
#pragma unroll
                    for (int kb2 = 0; kb2 < 2; ++kb2)
#pragma unroll
                        for (int j = 0; j < 16; ++j) sacc[kb2][j] = 0.f;
                    bf16x8 kf[2][4];
#define ATT_LDK(dst, g) do { _Pragma("unroll") for (int q_ = 0; q_ < 4; ++q_) dst[q_] = *(const LAS bf16x8*)(kb + ((g) / 3) * 32 * KP + (((g) % 3) * 4 + q_) * 32); } while (0)
                    ATT_LDK(kf[0], 0);
#pragma unroll
                    for (int g = 0; g < 6; ++g) {
                        if (g < 5) ATT_LDK(kf[(g + 1) & 1], g + 1);
                        __builtin_amdgcn_sched_barrier(0);
#pragma unroll
                        for (int q_ = 0; q_ < 4; ++q_) sacc[g / 3] = __builtin_amdgcn_mfma_f32_32x32x16_bf16(kf[g & 1][q_], qf[(g % 3) * 4 + q_], sacc[g / 3], 0, 0, 0);
                        __builtin_amdgcn_sched_barrier(0);
                    }
#undef ATT_LDK
                }
                if (more) { ATT_WRITEK(buf ^ 1); ATT_LOADV(kt + 1); }
                if (active) {
                    const LAS unsigned char* vb = lds + 2 * KBUF + buf * VBUF + v_rd;
                    bf16x8 vf[2][4];
#define ATT_LDV(dst, gg) do { _Pragma("unroll") for (int i_ = 0; i_ < 4; ++i_) { \
                        const s16x4 lo_ = __builtin_amdgcn_ds_read_tr16_b64_v4i16((LAS s16x4*)(vb + ((gg) * 16) * VP + i_ * 64)); \
                        const s16x4 hv_ = __builtin_amdgcn_ds_read_tr16_b64_v4i16((LAS s16x4*)(vb + ((gg) * 16 + 8) * VP + i_ * 64)); \
                        dst[i_] = __builtin_shufflevector(lo_, hv_, 0, 1, 2, 3, 4, 5, 6, 7); } } while (0)
                    ATT_LDV(vf[0], 0);
                    if (kt == wlast) {
                        const int qi = q0 + c - kt * 64;
#pragma unroll
                        for (int kb2 = 0; kb2 < 2; ++kb2)
#pragma unroll
                            for (int j = 0; j < 16; ++j) if (kb2 * 32 + crow(j, hi) > qi) sacc[kb2][j] = -INFINITY;
                    }
                    float mx = sacc[0][0];
#pragma unroll
                    for (int kb2 = 0; kb2 < 2; ++kb2)
#pragma unroll
                        for (int j = 0; j < 16; ++j) mx = fmaxf(mx, sacc[kb2][j]);
                    mx = fmaxf(mx, __shfl_xor(mx, 32));
                    const float mnew = fmaxf(mrun, mx), alpha = __builtin_amdgcn_exp2f(mrun - mnew);
                    mrun = mnew;
                    float ps = 0.f;
#pragma unroll
                    for (int kb2 = 0; kb2 < 2; ++kb2)
#pragma unroll
                        for (int j = 0; j < 16; ++j) { const float e = __builtin_amdgcn_exp2f(sacc[kb2][j] - mnew); sacc[kb2][j] = e; ps += e; }
                    lrun = lrun * alpha + ps;
#pragma unroll
                    for (int i = 0; i < 4; ++i)
#pragma unroll
                        for (int j = 0; j < 16; ++j) oacc[i][j] *= alpha;
                    bf16x8 pb[2][2];
#pragma unroll
                    for (int kb2 = 0; kb2 < 2; ++kb2)
#pragma unroll
                        for (int s2 = 0; s2 < 2; ++s2) {
                            u32x4 pw;
                            pw.x = pk_bf16(sacc[kb2][8 * s2 + 0], sacc[kb2][8 * s2 + 1]); pw.y = pk_bf16(sacc[kb2][8 * s2 + 2], sacc[kb2][8 * s2 + 3]);
                            pw.z = pk_bf16(sacc[kb2][8 * s2 + 4], sacc[kb2][8 * s2 + 5]); pw.w = pk_bf16(sacc[kb2][8 * s2 + 6], sacc[kb2][8 * s2 + 7]);
                            pb[kb2][s2] = __builtin_bit_cast(bf16x8, pw);
                        }
#pragma unroll
                    for (int gg = 0; gg < 4; ++gg) {
                        if (gg < 3) ATT_LDV(vf[(gg + 1) & 1], gg + 1);
                        __builtin_amdgcn_sched_barrier(0);
#pragma unroll
                        for (int i = 0; i < 4; ++i) oacc[i] = __builtin_amdgcn_mfma_f32_32x32x16_bf16(vf[gg & 1][i], pb[gg >> 1][gg & 1], oacc[i], 0, 0, 0);
                        __builtin_amdgcn_sched_barrier(0);
                    }
#undef ATT_LDV
                }
                if (more) ATT_WRITEV(buf ^ 1);
                __syncthreads();
            }
#undef ATT_LOADK
#undef ATT_LOADV
#undef ATT_WRITEK
#undef ATT_WRITEV
            const float ltot = lrun + __shfl_xor(lrun, 32), inv = 1.0f / ltot;
            char* obase = (char*)(OB + ((size_t)b * SEQ + q0) * DM + h * 128);
            asm volatile("" : "+s"(obase));
            const unsigned ooff = (unsigned)(c * 2048 + hi * 8);
#pragma unroll
            for (int i = 0; i < 4; ++i)
#pragma unroll
                for (int g = 0; g < 4; ++g) {
                    u32x2 wv; wv.x = pk_bf16(oacc[i][4 * g] * inv, oacc[i][4 * g + 1] * inv); wv.y = pk_bf16(oacc[i][4 * g + 2] * inv, oacc[i][4 * g + 3] * inv);
                    *(u32x2*)(obase + ooff + 64 * i + 16 * g) = wv;
                }
        }
    }
    __syncthreads();
}

#define XB_TMO      128
#define XB_XCNT(j)  (256  + 64 * (j))
#define XB_XSUB(j)  (1280 + 64 * (j))
#define XB_XGEN(j)  (2304 + 64 * (j))
#define XB_TOP      3328
#define XB_TOPGEN   3392
#define XCD_BAR_WORDS 3456
#define XB_SPIN_CAP (1u << 20)
__device__ __forceinline__ unsigned xb_ld(unsigned* p)              { return __hip_atomic_load(p, __ATOMIC_RELAXED, __HIP_MEMORY_SCOPE_AGENT); }
__device__ __forceinline__ unsigned xb_add(unsigned* p, unsigned v) { return __hip_atomic_fetch_add(p, v, __ATOMIC_RELAXED, __HIP_MEMORY_SCOPE_AGENT); }
__device__ __forceinline__ unsigned xb_xcc_id() { return (unsigned)__builtin_amdgcn_s_getreg((3 << 11) | 20) & 0xFu; }
#define XB_SPIN(cond, bar) do { unsigned _sp = 0; while (cond) { __builtin_amdgcn_s_sleep(1); \
    if ((++_sp & 255u) == 0u) { if (xb_ld(&(bar)[XB_TMO])) break; if (_sp > XB_SPIN_CAP) { atomicAdd(&(bar)[XB_TMO], 1u); break; } } } } while (0)
struct XcdBarrier { unsigned* bar; unsigned x; volatile LAS unsigned* st; };
__device__ __forceinline__ XcdBarrier xcd_barrier_post(unsigned* bar, volatile LAS unsigned* st) {
    XcdBarrier b; b.bar = bar; b.x = xb_xcc_id(); b.st = st;
    if (threadIdx.x == 0) (void)xb_add(&bar[XB_XCNT(b.x)], 1u);
    return b;
}
__device__ __forceinline__ void xcd_barrier_complete(unsigned* bar, unsigned x, unsigned& nloc, unsigned& nx) {
    const unsigned G = gridDim.x * gridDim.y * gridDim.z;
    unsigned sum, cnt, mine, sp = 0u;
    for (;;) {
        sum = 0u; cnt = 0u; mine = 0u;
#pragma unroll
        for (unsigned j = 0; j < 16; ++j) { const unsigned c = xb_ld(&bar[XB_XCNT(j)]); sum += c; cnt += (c > 0u) ? 1u : 0u; mine = (j == x) ? c : mine; }
        if (sum == G) break;
        __builtin_amdgcn_s_sleep(1);
        if ((++sp & 255u) == 0u) { if (xb_ld(&bar[XB_TMO])) break; if (sp > XB_SPIN_CAP) { atomicAdd(&bar[XB_TMO], 1u); break; } }
    }
    nloc = mine > 0u ? mine : 1u; nx = cnt > 0u ? cnt : 1u;
}
__device__ __forceinline__ void xcd_barrier(const XcdBarrier& b) {
    asm volatile("s_waitcnt vmcnt(0)" ::: "memory");
    __syncthreads();
    if (threadIdx.x == 0) {
        unsigned* bar = b.bar;
        __builtin_amdgcn_s_waitcnt(0);
        unsigned nloc = b.st[0], nx = b.st[1];
        if (nloc == 0u) { xcd_barrier_complete(bar, b.x, nloc, nx); b.st[0] = nloc; b.st[1] = nx; }
        const unsigned old = xb_add(&bar[XB_XSUB(b.x)], 1u);
        const unsigned gen = old / nloc;
        if (old + 1u == (gen + 1u) * nloc) {
            __builtin_amdgcn_fence(__ATOMIC_RELEASE, "agent");
            asm volatile("s_waitcnt vmcnt(0)" ::: "memory");
            const unsigned og = xb_add(&bar[XB_TOP], 1u);
            const unsigned tg = og / nx;
            if (og + 1u == (tg + 1u) * nx) xb_add(&bar[XB_TOPGEN], 1u);
            else XB_SPIN(xb_ld(&bar[XB_TOPGEN]) == tg, bar);
            __builtin_amdgcn_fence(__ATOMIC_ACQUIRE, "agent");
            xb_add(&bar[XB_XGEN(b.x)], 1u);
            asm volatile("s_waitcnt vmcnt(0)" ::: "memory");
        } else {
            XB_SPIN(xb_ld(&bar[XB_XGEN(b.x)]) == gen, bar);
            __builtin_amdgcn_fence(__ATOMIC_ACQUIRE, "agent");
            asm volatile("s_waitcnt vmcnt(0)" ::: "memory");
        }
    }
    __syncthreads();
}

enum { OP_CIN, OP_CONV3, OP_COUT, OP_GU, OP_DOWN, OP_LIN, OP_CONV4, OP_GATE, OP_SCAN1, OP_SCAN2, OP_LOUT, OP_MDOWN, OP_UQ, OP_UKV, OP_PREP, OP_ATTN, OP_WO };
enum { GT_NONE, GT_PAIR, GT_STORE, GT_RESID, GT_GATE };
__device__ const unsigned char g_prog[26][3] = {
    {OP_CIN, 0, 1}, {OP_CONV3, 0, 1}, {OP_COUT, 0, 1}, {OP_GU, 0, 1}, {OP_DOWN, 0, 1},
    {OP_LIN, 1, 1}, {OP_CONV4, 1, 1}, {OP_GATE, 1, 1}, {OP_SCAN1, 1, 1}, {OP_SCAN2, 1, 1}, {OP_LOUT, 1, 1}, {OP_GU, 1, 1}, {OP_DOWN, 1, 1},
    {OP_MDOWN, 2, 1}, {OP_UQ, 2, 0}, {OP_UKV, 2, 1}, {OP_PREP, 2, 1}, {OP_ATTN, 2, 1}, {OP_WO, 2, 1}, {OP_GU, 2, 1}, {OP_DOWN, 2, 1},
    {OP_CIN, 3, 1}, {OP_CONV3, 3, 1}, {OP_COUT, 3, 1}, {OP_GU, 3, 1}, {OP_DOWN, 3, 1}};

__global__ void __launch_bounds__(NTHREADS) mega_fwd(Params p) {
    extern __shared__ __attribute__((aligned(16))) unsigned char lds_raw[];
    LAS unsigned char* lds = (LAS unsigned char*)lds_raw;
    cg::grid_group grid = cg::this_grid();
    KA ka = (KA)__builtin_amdgcn_kernarg_segment_ptr();
    (void)p;
    volatile LAS unsigned* xst = (volatile LAS unsigned*)(lds + pg8::STAGE_BYTES);
    if (threadIdx.x < 4) xst[threadIdx.x] = 0u;
    __syncthreads();
    for (int i = 0; i < PROBE_P0; ++i) { phase0(ka, lds); grid.sync(); }
    phase0(ka, lds);
    grid.sync();
    (void)xcd_barrier_post((unsigned*)(P_WS + OFF_BAR), xst);
#define GRID_BAR() do { XcdBarrier xb_; xb_.bar = (unsigned*)(P_WS + OFF_BAR); xb_.x = xb_xcc_id(); xb_.st = (volatile LAS unsigned*)(lds + pg8::STAGE_BYTES); xcd_barrier(xb_); } while (0)
    for (int i = 0; i < PROBE_SYNCS; ++i) GRID_BAR();
    for (int st = 0, rep = 0; st < 26; ++st) {
        asm volatile("" : "+s"(ka));
        unsigned char* const ws = P_WS;
        float* const ssq = (float*)(ws + OFF_SSQ);
        bf16_t* const hb = (bf16_t*)(ws + OFF_HB);
        const int op = g_prog[st][0], L = g_prog[st][1], sync_after = g_prog[st][2];
        const int j = L / 3;
        int gt = GT_NONE; pg8::Gemm g{}; EP e{};
        const float* resid_in = (L == 0) ? (const float*)P_IN(0) : (const float*)P_OUT;
        switch (op) {
        case OP_CIN:
            gt = GT_PAIR; g = pg8::Gemm{hb, (const bf16_t*)(ws + OFF_WCIN) + (size_t)j * 3072 * DM, T, 3072, DM, DM, 0};
            e.o0 = (bf16_t*)(ws + OFF_U); e.ld0 = DM; e.o1 = (bf16_t*)(ws + OFF_BG); e.ld1 = DM; e.split = 8; e.mode = 1; e.q2 = ssq + (size_t)(2 * L) * T; e.inv_dim = 1.0f / DM; break;
        case OP_CONV3: conv3_phase(ka, (const float*)P_IN(4) + (size_t)j * 3 * DM); break;
        case OP_COUT:
            gt = GT_RESID; g = pg8::Gemm{(const bf16_t*)(ws + OFF_Y), (const bf16_t*)(ws + OFF_WCOUT) + (size_t)j * DM * DM, T, DM, DM, DM, 0};
            e.q2 = resid_in; e.q4 = P_OUT; e.o0 = hb; e.q3 = ssq + (size_t)(2 * L + 1) * T; break;
        case OP_GU:
            gt = GT_PAIR; g = pg8::Gemm{hb, (const bf16_t*)(ws + OFF_WGU) + (size_t)L * 2 * DFF * DM, T, 2 * DFF, DM, DM, 0};
            e.o0 = (bf16_t*)(ws + OFF_ACT); e.ld0 = DFF; e.split = 1 << 20; e.mode = 0; e.q2 = ssq + (size_t)(2 * L + 1) * T; e.inv_dim = 1.0f / DM; break;
        case OP_DOWN:
            gt = GT_RESID; g = pg8::Gemm{(const bf16_t*)(ws + OFF_ACT), (const bf16_t*)(ws + OFF_WDN) + (size_t)L * DM * DFF, T, DM, DFF, DFF, 0};
            e.q2 = P_OUT; e.q4 = P_OUT; e.o0 = hb; e.q3 = ssq + (size_t)(L < 3 ? 2 * L + 2 : 10) * T; break;
        case OP_LIN:
            gt = GT_STORE; g = pg8::Gemm{hb, (const bf16_t*)(ws + OFF_WLIN), T, 2 * LW, DM, DM, 0};
            e.o0 = (bf16_t*)(ws + OFF_GATE); e.ld0 = LW; e.o1 = (bf16_t*)(ws + OFF_RECB); e.ld1 = LW; e.split = 5; e.mode = 1; e.q2 = ssq + (size_t)(2 * L) * T; e.inv_dim = 1.0f / DM; break;
        case OP_CONV4: conv4_phase(ka); break;
        case OP_GATE:
            gt = GT_GATE; g = pg8::Gemm{(const bf16_t*)(ws + OFF_XS), (const bf16_t*)(ws + OFF_WLG), T, 2 * LW, 256, LW, 256};
            e.o0 = (bf16_t*)(ws + OFF_LA); e.o1 = (bf16_t*)(ws + OFF_RECB); e.q2 = (const bf16_t*)(ws + OFF_XS);
            e.q3 = (void*)P_IN(10); e.q4 = (void*)P_IN(12); e.q5 = (const float*)(ws + OFF_CL); break;
        case OP_SCAN1: scan1_phase(ka); break;
        case OP_SCAN2: scan2_phase(ka); break;
        case OP_LOUT:
            gt = GT_RESID; g = pg8::Gemm{(const bf16_t*)(ws + OFF_GATE), (const bf16_t*)(ws + OFF_WLOUT), T, DM, LW, LW, 0};
            e.q2 = resid_in; e.q4 = P_OUT; e.o0 = hb; e.q3 = ssq + (size_t)(2 * L + 1) * T; break;
        case OP_MDOWN:
            gt = GT_STORE; g = pg8::Gemm{hb, (const bf16_t*)(ws + OFF_WMD), T, 768, DM, DM, 0};
            e.o0 = (bf16_t*)(ws + OFF_CBUF); e.ld0 = 768; e.split = 1 << 20; e.mode = 2; e.q2 = ssq + (size_t)(2 * L) * T; e.inv_dim = 1.0f / DM;
            e.q3 = ssq + (size_t)8 * T; e.q4 = ssq + (size_t)9 * T; break;
        case OP_UQ:
            gt = GT_STORE; g = pg8::Gemm{(const bf16_t*)(ws + OFF_CBUF) + 256, (const bf16_t*)(ws + OFF_WUQ), T, 1536, 384, 768, 0};
            e.o0 = (bf16_t*)(ws + OFF_QB); e.ld0 = 1536; e.split = 1 << 20; e.mode = 0; e.q2 = ssq + (size_t)9 * T; e.inv_dim = 1.0f / 384.0f; break;
        case OP_UKV:
            gt = GT_STORE; g = pg8::Gemm{(const bf16_t*)(ws + OFF_CBUF), (const bf16_t*)(ws + OFF_WUKV), T, 2048, 256, 768, 0};
            e.o0 = (bf16_t*)(ws + OFF_KVB); e.ld0 = 2048; e.split = 1 << 20; e.mode = 0; e.q2 = ssq + (size_t)8 * T; e.inv_dim = 1.0f / 256.0f; break;
        case OP_PREP: prep_phase(ka); break;
        case OP_ATTN: attn_phase(ka, lds); break;
        case OP_WO:
            gt = GT_RESID; g = pg8::Gemm{(const bf16_t*)(ws + OFF_OBUF), (const bf16_t*)(ws + OFF_WO), T, DM, DM, DM, 0};
            e.q2 = resid_in; e.q4 = P_OUT; e.o0 = hb; e.q3 = ssq + (size_t)(2 * L + 1) * T; break;
        default: break;
        }
        if (gt == GT_RESID && ((PROBE_MASK >> op) & 1u) && rep == 0) {
            e.q4 = ws + OFF_R + 192 * MiB; e.o0 = (bf16_t*)(ws + OFF_R + 256 * MiB); e.q3 = ssq + (size_t)10 * T; }
        if (gt != GT_NONE) {
            pg8::StaticOrder S; S.init(g.M, g.N, ogrid(), obid());
            e.type = gt - 1;
            EpiAll E{e}; pg8::gemm_phase<EpiAll>(lds, g, S, E);
        }
        if (sync_after) GRID_BAR();
        if (((PROBE_MASK >> op) & 1u) && rep == 0) { if (!sync_after) GRID_BAR(); rep = 1; --st; } else rep = 0;
    }
}

constexpr int LDS_BYTES = pg8::STAGE_BYTES + 64;

extern "C" void kernel_launch(void* const* d_in, const int* in_sizes, int n_in, void* d_out, int out_size, void* d_ws, size_t ws_size, hipStream_t stream) {
    static int grid_blocks = 0;
    if (grid_blocks == 0) {
        if (n_in != 28 || ws_size < WS_NEED) { fprintf(stderr, "kernel_launch: unexpected inputs (n_in %d, ws %zu, need %zu)\n", n_in, ws_size, (size_t)WS_NEED); grid_blocks = -1; return; }
        int dev = 0, cus = 0, per_cu = 0;
        hipGetDevice(&dev);
        hipDeviceGetAttribute(&cus, hipDeviceAttributeMultiprocessorCount, dev);
        hipFuncSetAttribute((const void*)mega_fwd, hipFuncAttributeMaxDynamicSharedMemorySize, LDS_BYTES);
        hipOccupancyMaxActiveBlocksPerMultiprocessor(&per_cu, (const void*)mega_fwd, NTHREADS, LDS_BYTES);
        if (per_cu < 1) { fprintf(stderr, "kernel_launch: occupancy query returned %d\n", per_cu); per_cu = 1; }
        grid_blocks = cus;
        (void)hipGetLastError();
    }
    if (grid_blocks < 0) return;
    Params p{};
    for (int i = 0; i < 28; ++i) p.in[i] = d_in[i];
    p.out = (float*)d_out; p.ws = (unsigned char*)d_ws;
    void* args[] = {&p};
    hipError_t e = hipLaunchCooperativeKernel((const void*)mega_fwd, dim3(grid_blocks), dim3(NTHREADS), args, LDS_BYTES, stream);
    if (e != hipSuccess) fprintf(stderr, "cooperative launch failed: %s (grid %d)\n", hipGetErrorString(e), grid_blocks);
}
```

```cpp
#include <hip/hip_runtime.h>
#include <hip/hip_cooperative_groups.h>
#include <cstdio>
namespace cg = cooperative_groups;

#define LAS __attribute__((address_space(3)))
typedef unsigned short bf16_t;
typedef short bf16x8 __attribute__((ext_vector_type(8)));
typedef short s16x4 __attribute__((ext_vector_type(4)));
typedef float f32x2 __attribute__((ext_vector_type(2)));
typedef float f32x4 __attribute__((ext_vector_type(4)));
typedef float f32x16 __attribute__((ext_vector_type(16)));
typedef unsigned u32x2 __attribute__((ext_vector_type(2)));
typedef unsigned u32x4 __attribute__((ext_vector_type(4)));
typedef __bf16 bf2_t __attribute__((ext_vector_type(2)));

#define PROBE_MASK 0x0u
#define PROBE_SYNCS 0
#define PROBE_P0 0
constexpr int T = 32768, DM = 1024, SEQ = 4096, NBATCH = 8, DFF = 2816, LW = 1280;
constexpr int NTHREADS = 512;
constexpr float EPS = 1e-6f;
constexpr size_t MiB = 1ull << 20;
constexpr size_t OFF_WCIN = 0;
constexpr size_t OFF_WCOUT = 12 * MiB;
constexpr size_t OFF_WLIN = 16 * MiB;
constexpr size_t OFF_WLG = 21 * MiB;
constexpr size_t OFF_WLOUT = 22 * MiB + MiB / 4;
constexpr size_t OFF_WMD = 24 * MiB + 3 * MiB / 4;
constexpr size_t OFF_WUQ = 26 * MiB + MiB / 4;
constexpr size_t OFF_WUKV = 27 * MiB + 3 * MiB / 8;
constexpr size_t OFF_WO = 28 * MiB + 3 * MiB / 8;
constexpr size_t OFF_WGU = 31 * MiB;
constexpr size_t OFF_WDN = 75 * MiB;
constexpr size_t OFF_HB = 97 * MiB;
constexpr size_t OFF_SSQ = 161 * MiB;
constexpr size_t OFF_CL = OFF_SSQ + 11ull * T * 4;
constexpr size_t OFF_BAR = OFF_CL + 8192;
constexpr size_t OFF_B3 = 163 * MiB;
constexpr size_t OFF_R = 195 * MiB;
constexpr size_t OFF_ACT = OFF_R;
constexpr size_t OFF_U = OFF_R, OFF_BG = OFF_R + 64 * MiB, OFF_Y = OFF_R + 128 * MiB;
constexpr size_t OFF_GATE = OFF_R, OFF_RECB = OFF_R + 80 * MiB, OFF_XS = OFF_R + 160 * MiB, OFF_CARRY = OFF_R + 240 * MiB;
constexpr size_t OFF_CBUF = OFF_R, OFF_OBUF = OFF_R, OFF_QB = OFF_R + 64 * MiB, OFF_KVB = OFF_R + 160 * MiB, OFF_KR = OFF_R + 288 * MiB;
constexpr size_t WS_NEED = OFF_R + 316 * MiB;

struct Params { const void* in[28]; float* out; unsigned char* ws; };
typedef const void* kptr_t;
typedef const __attribute__((address_space(4))) kptr_t* KA;
#define P_IN(i) (ka[(i)])
#define P_OUT ((float*)ka[28])
#define P_WS ((unsigned char*)ka[29])

__device__ __forceinline__ unsigned pk_bf16(float lo, float hi) { bf2_t v = __builtin_convertvector((f32x2){lo, hi}, bf2_t); return __builtin_bit_cast(unsigned, v); }
__device__ __forceinline__ float bf_lo(unsigned w) { return __uint_as_float(w << 16); }
__device__ __forceinline__ float bf_hi(unsigned w) { return __uint_as_float(w & 0xffff0000u); }
__device__ __forceinline__ float bf1(bf16_t b) { return __uint_as_float(((unsigned)b) << 16); }
__device__ __forceinline__ float wave_sum(float v) {
#pragma unroll
    for (int o = 32; o >= 1; o >>= 1) v += __shfl_xor(v, o);
    return v;
}
__device__ __forceinline__ float res_dec(unsigned hb16, unsigned b3) { return __uint_as_float(((hb16 - (b3 >> 7)) << 16) | (b3 << 8) | 0x80u); }
__device__ __forceinline__ void res_dec8(const u32x4 h, const u32x2 b, float (&v)[8]) {
    v[0] = res_dec(h.x & 0xffffu, b.x & 0xffu); v[1] = res_dec(h.x >> 16, (b.x >> 8) & 0xffu); v[2] = res_dec(h.y & 0xffffu, (b.x >> 16) & 0xffu); v[3] = res_dec(h.y >> 16, b.x >> 24);
    v[4] = res_dec(h.z & 0xffffu, b.y & 0xffu); v[5] = res_dec(h.z >> 16, (b.y >> 8) & 0xffu); v[6] = res_dec(h.w & 0xffffu, (b.y >> 16) & 0xffu); v[7] = res_dec(h.w >> 16, b.y >> 24);
}
__device__ __forceinline__ unsigned res_hb2(float a, float b) { return ((__float_as_uint(a) + 0x8000u) >> 16) | ((__float_as_uint(b) + 0x8000u) & 0xffff0000u); }
__device__ __forceinline__ unsigned res_b4(float a, float b, float c, float d) {
    return ((__float_as_uint(a) >> 8) & 0xffu) | (__float_as_uint(b) & 0xff00u) | ((__float_as_uint(c) << 8) & 0xff0000u) | ((__float_as_uint(d) << 16) & 0xff000000u); }
__device__ __forceinline__ int otid() { int t = threadIdx.x; asm volatile("" : "+v"(t)); return t; }
__device__ __forceinline__ int obid() { int t = blockIdx.x; asm volatile("" : "+s"(t)); return t; }
__device__ __forceinline__ int ogrid() { int t = gridDim.x; asm volatile("" : "+s"(t)); return t; }
__device__ __forceinline__ float fast_sigmoid(float x) { return __builtin_amdgcn_rcpf(1.0f + __expf(-x)); }

namespace pg8 {
constexpr int BM = 256, BK = 64, HALF = 128, HTB = HALF * BK * 2, STAGE_BYTES = 8 * HTB, NXCD = 8, WGM = 8;
__device__ __forceinline__ int lds_byte(int r, int c) { const int st = (r >> 4) * 2 + (c >> 5), rr = r & 15, cc = c & 31, ob = rr * 64 + cc * 2; return st * 1024 + (ob ^ (((ob >> 9) & 1) << 5)); }
__device__ __forceinline__ void stage_rc(int b, int& R, int& C) { const int st = b / 1024, sb = b % 1024, swz = sb ^ (((sb >> 9) & 1) << 5); R = (st >> 1) * 16 + swz / 64; C = (st & 1) * 32 + (swz % 64) / 2; }
__device__ __forceinline__ int perm32(int rho) { const int n = rho >> 4, i = rho & 15; return 8 * (i >> 2) + 4 * n + (i & 3); }
struct Unit { int pm, pn; };
struct Gemm { const bf16_t* A; const bf16_t* Bt; int M, N, K, lda, akoff; };
struct StaticOrder {
    int nM, nN, nwg, G, c;
    __device__ void init(int M, int N, int G_, int c_) { nM = M / BM; nN = N / BM; nwg = nM * nN; G = G_; c = c_; }
    __device__ bool next(int i, Unit& u) const {
        const long L = (long)i * G + c; if (L >= nwg) return false;
        int wgid = (int)L; { const int q = nwg / NXCD, r = nwg % NXCD, xcd = wgid % NXCD, off = wgid / NXCD; wgid = (xcd < r ? xcd * (q + 1) : r * (q + 1) + (xcd - r) * q) + off; }
        const int nig = WGM * nN, gid = wgid / nig, fm = gid * WGM, gsz = (nM - fm) < WGM ? (nM - fm) : WGM;
        u.pm = fm + ((wgid % nig) % gsz); u.pn = (wgid % nig) / gsz; return true;
    }
};

template <class Epi>
__device__ __forceinline__ void gemm_phase(LAS unsigned char* lds, const Gemm g, const StaticOrder& S, const Epi& E) {
    const int tid = otid(), wid = __builtin_amdgcn_readfirstlane(tid >> 6), lane = tid & 63, wr = wid >> 2, wc = wid & 3, fr = lane & 15, fq = lane >> 4;
    const int K = g.K, nt = K / BK, lda = g.lda;
    unsigned voffA[2], voffB[2];
#pragma unroll
    for (int i = 0; i < 2; ++i) { int R, C; stage_rc(tid * 16 + i * 8192, R, C); const int Rb = Epi::PERM ? ((R & ~31) + perm32(R & 31)) : R;
        voffA[i] = (unsigned)(R * lda + C) * 2u; voffB[i] = (unsigned)(Rb * K + C) * 2u; }
    const size_t kstep = (size_t)(BK * 2);
    const size_t hstepA = (size_t)HALF * lda * 2, hstepB = (size_t)HALF * K * 2;
    const size_t tstepA = 2 * hstepA, tstepB = 2 * hstepB;
    const size_t akoffb = (size_t)g.akoff * 2;
    const unsigned ldsw = (unsigned)wid * 1024u;
    const int aoff = lds_byte(wr * 64 + fr, fq * 8), boff = lds_byte(wc * 32 + fr, fq * 8);
#define PG8_SA(b, h) (((b) * 2 + (h)) * HTB)
#define PG8_SB(b, h) ((4 + (b) * 2 + (h)) * HTB)
#define PG8_STAGE(bufoff, gbase, voff) do { _Pragma("unroll") for (int _i = 0; _i < 2; ++_i) \
        __builtin_amdgcn_global_load_lds((const unsigned*)((const char*)(gbase) + (voff)[_i]), (LAS unsigned*)(lds + (bufoff) + ldsw + _i * 8192), 16, 0, 0); } while (0)
#define PG8_LDA(dst, b, h) do { _Pragma("unroll") for (int m = 0; m < 4; ++m) _Pragma("unroll") for (int k = 0; k < 2; ++k) dst[m][k] = *(const LAS bf16x8*)(lds + PG8_SA(b, h) + aoff + m * 2048 + k * 1024); } while (0)
#define PG8_LDB(dst, b, h) do { _Pragma("unroll") for (int n = 0; n < 2; ++n) _Pragma("unroll") for (int k = 0; k < 2; ++k) dst[n][k] = *(const LAS bf16x8*)(lds + PG8_SB(b, h) + boff + n * 2048 + k * 1024); } while (0)
#define PG8_MMA(ai, bj, At, Bt) do { __builtin_amdgcn_s_setprio(1); _Pragma("unroll") for (int m = 0; m < 4; ++m) _Pragma("unroll") for (int n = 0; n < 2; ++n) _Pragma("unroll") for (int k = 0; k < 2; ++k) \
        acc[ai][bj][m][n] = __builtin_amdgcn_mfma_f32_16x16x32_bf16(Bt[n][k], At[m][k], acc[ai][bj][m][n], 0, 0, 0); __builtin_amdgcn_s_setprio(0); } while (0)
#define PG8_WAIT_V(n) asm volatile("s_waitcnt vmcnt(" #n ")" ::: "memory")
#define PG8_WAIT_L(n) asm volatile("s_waitcnt lgkmcnt(" #n ")" ::: "memory")
#define PG8_BAR __builtin_amdgcn_s_barrier()
#define PG8_SCHED __builtin_amdgcn_sched_barrier(0)
    Unit cur, nxt; int ui = 0;
    if (!S.next(0, cur)) return;
    f32x4 acc[2][2][4][2];
#pragma unroll
    for (int a = 0; a < 2; ++a)
#pragma unroll
        for (int b = 0; b < 2; ++b)
#pragma unroll
            for (int m = 0; m < 4; ++m)
#pragma unroll
                for (int n = 0; n < 2; ++n) acc[a][b][m][n] = (f32x4){0.f, 0.f, 0.f, 0.f};
    bf16x8 At[4][2], B0[2][2], B1[2][2];
    const char* cA = (const char*)g.A + (size_t)cur.pm * tstepA + (size_t)(cur.pn >> 1) * akoffb; const char* cB = (const char*)g.Bt + (size_t)cur.pn * tstepB;
    PG8_STAGE(PG8_SB(0, 0), cB, voffB); PG8_STAGE(PG8_SA(0, 0), cA, voffA); PG8_STAGE(PG8_SB(0, 1), cB + hstepB, voffB); PG8_STAGE(PG8_SA(0, 1), cA + hstepA, voffA);
    if (wr == 1) PG8_BAR;
    PG8_WAIT_V(4); PG8_BAR;
    PG8_STAGE(PG8_SB(1, 0), cB + kstep, voffB); PG8_STAGE(PG8_SA(1, 0), cA + kstep, voffA); PG8_STAGE(PG8_SB(1, 1), cB + hstepB + kstep, voffB);
    PG8_WAIT_V(6); PG8_BAR;
    for (;;) {
        const bool has_next = S.next(ui + 1, nxt);
        const char* nA = has_next ? (const char*)g.A + (size_t)nxt.pm * tstepA + (size_t)(nxt.pn >> 1) * akoffb : cA; const char* nB = has_next ? (const char*)g.Bt + (size_t)nxt.pn * tstepB : cB;
        for (int t = 0; t < nt; t += 2) {
            const bool last = (t == nt - 2);
            const char* a1 = cA + (size_t)(t + 1) * kstep;
            const char* a2 = last ? nA : cA + (size_t)(t + 2) * kstep; const char* b2 = last ? nB : cB + (size_t)(t + 2) * kstep;
            const char* a3 = a2 + kstep; const char* b3 = b2 + kstep;
            PG8_LDB(B0, 0, 0); PG8_SCHED; PG8_LDA(At, 0, 0); PG8_STAGE(PG8_SA(1, 1), a1 + hstepA, voffA);
            PG8_WAIT_L(8); PG8_BAR; PG8_WAIT_L(0); PG8_MMA(0, 0, At, B0); PG8_BAR; PG8_SCHED;
            PG8_LDB(B1, 0, 1); PG8_STAGE(PG8_SB(0, 0), b2, voffB);
            PG8_BAR; PG8_WAIT_L(0); PG8_MMA(0, 1, At, B1); PG8_BAR;
            PG8_LDA(At, 0, 1); PG8_STAGE(PG8_SA(0, 0), a2, voffA);
            PG8_BAR; PG8_WAIT_L(0); PG8_MMA(1, 0, At, B0); PG8_BAR; PG8_SCHED;
            PG8_STAGE(PG8_SB(0, 1), b2 + hstepB, voffB);
            PG8_WAIT_V(6); PG8_BAR; PG8_MMA(1, 1, At, B1); PG8_BAR;
            PG8_LDB(B0, 1, 0); PG8_SCHED; PG8_LDA(At, 1, 0); PG8_STAGE(PG8_SA(0, 1), a2 + hstepA, voffA);
            PG8_WAIT_L(8); PG8_BAR; PG8_WAIT_L(0); PG8_MMA(0, 0, At, B0); PG8_BAR; PG8_SCHED;
            PG8_LDB(B1, 1, 1); PG8_STAGE(PG8_SB(1, 0), b3, voffB);
            PG8_BAR; PG8_WAIT_L(0); PG8_MMA(0, 1, At, B1); PG8_BAR;
            PG8_LDA(At, 1, 1); PG8_STAGE(PG8_SA(1, 0), a3, voffA);
            PG8_BAR; PG8_WAIT_L(0); PG8_MMA(1, 0, At, B0); PG8_BAR; PG8_SCHED;
            PG8_STAGE(PG8_SB(1, 1), b3 + hstepB, voffB);
            PG8_WAIT_V(6); PG8_BAR; PG8_MMA(1, 1, At, B1); PG8_BAR;
        }
        E(acc, cur, wr, wc, fr, fq);
        if (!has_next) break;
#pragma unroll
        for (int a = 0; a < 2; ++a)
#pragma unroll
            for (int b = 0; b < 2; ++b)
#pragma unroll
                for (int m = 0; m < 4; ++m)
#pragma unroll
                    for (int n = 0; n < 2; ++n) acc[a][b][m][n] = (f32x4){0.f, 0.f, 0.f, 0.f};
        cur = nxt; cA = nA; cB = nB; ++ui;
    }
    PG8_WAIT_V(0);
    if (wr == 0) PG8_BAR;
    PG8_BAR;
#undef PG8_SA
#undef PG8_SB
#undef PG8_STAGE
#undef PG8_LDA
#undef PG8_LDB
#undef PG8_MMA
#undef PG8_WAIT_V
#undef PG8_WAIT_L
#undef PG8_BAR
#undef PG8_SCHED
}
}

struct EP {
    bf16_t* o0; bf16_t* o1; const void* q2; void* q3; void* q4; const void* q5;
    int ld0, ld1, split, mode, type; float inv_dim;
};
#define EP_RS(p) ((const float*)(p).q2)
#define EP_SSQ0(p) ((float*)(p).q3)
#define EP_SSQ1(p) ((float*)(p).q4)
#define EP_B3(p) ((unsigned char*)(p).q2)
#define EP_FOUT(p) ((float*)(p).q4)
#define EP_XS(p) ((const bf16_t*)(p).q2)
#define EP_BA(p) ((const float*)(p).q3)
#define EP_BX(p) ((const float*)(p).q4)
#define EP_CL(p) ((const float*)(p).q5)
__device__ __forceinline__ void load_rstd(const EP& p, int row0, float (&rstd)[2][4]) {
#pragma unroll
    for (int ai = 0; ai < 2; ++ai)
#pragma unroll
        for (int m = 0; m < 4; ++m) rstd[ai][m] = __builtin_amdgcn_rsqf(EP_RS(p)[row0 + ai * 128 + m * 16] * p.inv_dim + EPS);
}
__device__ __forceinline__ u32x4 pack8(const f32x4 a, const f32x4 b) { u32x4 w; w.x = pk_bf16(a[0], a[1]); w.y = pk_bf16(a[2], a[3]); w.z = pk_bf16(b[0], b[1]); w.w = pk_bf16(b[2], b[3]); return w; }

struct EpiAll {
    static constexpr bool PERM = true;
    EP p;
    __device__ __forceinline__ void operator()(const f32x4 (&acc)[2][2][4][2], const pg8::Unit& u, int wr, int wc, int fr, int fq) const {
        const int row0 = u.pm * 256 + wr * 64 + fr;
        if (p.type == 0) {
            float rstd[2][4]; load_rstd(p, row0, rstd);
            if (u.pn < p.split) {
                const int col = u.pn * 128 + wc * 32 + fq * 8;
#pragma unroll
                for (int ai = 0; ai < 2; ++ai)
#pragma unroll
                    for (int m = 0; m < 4; ++m) {
                        const float r = rstd[ai][m];
                        f32x4 v[2];
#pragma unroll
                        for (int n = 0; n < 2; ++n) {
                            const f32x4 g = acc[ai][0][m][n] * r, uu = acc[ai][1][m][n] * r;
                            if (p.mode == 0) {
#pragma unroll
                                for (int j = 0; j < 4; ++j) v[n][j] = g[j] * fast_sigmoid(g[j]) * uu[j];
                            } else v[n] = g * uu;
                        }
                        *(u32x4*)(p.o0 + (size_t)(row0 + ai * 128 + m * 16) * p.ld0 + col) = pack8(v[0], v[1]);
                    }
            } else {
                const int col = (u.pn - p.split) * 256 + wc * 32 + fq * 8;
#pragma unroll
                for (int ai = 0; ai < 2; ++ai)
#pragma unroll
                    for (int m = 0; m < 4; ++m) {
                        const float r = rstd[ai][m];
#pragma unroll
                        for (int bj = 0; bj < 2; ++bj)
                            *(u32x4*)(p.o1 + (size_t)(row0 + ai * 128 + m * 16) * p.ld1 + col + bj * 128) = pack8(acc[ai][bj][m][0] * r, acc[ai][bj][m][1] * r);
                    }
            }
        } else if (p.type == 1) {
            float rstd[2][4]; load_rstd(p, row0, rstd);
            const bool second = u.pn >= p.split;
            bf16_t* ob = second ? p.o1 : p.o0; const int ld = second ? p.ld1 : p.ld0;
            const int col = (second ? u.pn - p.split : u.pn) * 256 + wc * 32 + fq * 8;
            const bool gelu = (p.mode == 1) && !second;
#pragma unroll
            for (int ai = 0; ai < 2; ++ai)
#pragma unroll
                for (int m = 0; m < 4; ++m) {
                    const float r = rstd[ai][m]; const int row = row0 + ai * 128 + m * 16;
                    float sq[2];
#pragma unroll
                    for (int bj = 0; bj < 2; ++bj) {
                        f32x4 v0 = acc[ai][bj][m][0] * r, v1 = acc[ai][bj][m][1] * r;
                        if (gelu) {
#pragma unroll
                            for (int j = 0; j < 4; ++j) {
                                const float a = v0[j], b = v1[j];
                                v0[j] = a * fast_sigmoid(1.5957691216f * (a + 0.044715f * a * a * a));
                                v1[j] = b * fast_sigmoid(1.5957691216f * (b + 0.044715f * b * b * b));
                            }
                        }
                        sq[bj] = (v0[0] * v0[0] + v0[1] * v0[1]) + (v0[2] * v0[2] + v0[3] * v0[3]) + (v1[0] * v1[0] + v1[1] * v1[1]) + (v1[2] * v1[2] + v1[3] * v1[3]);
                        *(u32x4*)(ob + (size_t)row * ld + col + bj * 128) = pack8(v0, v1);
                    }
                    if (p.mode == 2) {
                        float s = (u.pn == 2) ? sq[0] : sq[0] + sq[1];
                        s += __shfl_xor(s, 16); s += __shfl_xor(s, 32);
                        if (fq == 0) atomicAdd((u.pn == 0 ? EP_SSQ0(p) : EP_SSQ1(p)) + row, s);
                    }
                }
        } else if (p.type == 2) {
            const int col0 = u.pn * 256 + wc * 32 + 8 * fq;
#pragma unroll
            for (int ai = 0; ai < 2; ++ai) {
                u32x4 rh[4][2]; u32x2 rb[4][2];
#pragma unroll
                for (int m = 0; m < 4; ++m)
#pragma unroll
                    for (int bj = 0; bj < 2; ++bj) {
                        const size_t off = (size_t)(row0 + ai * 128 + m * 16) * DM + col0 + bj * 128;
                        rh[m][bj] = *(const u32x4*)(p.o0 + off); rb[m][bj] = *(const u32x2*)(EP_B3(p) + off);
                    }
                asm volatile("" ::: "memory");
#pragma unroll
                for (int m = 0; m < 4; ++m) {
                    const int row = row0 + ai * 128 + m * 16; const size_t off = (size_t)row * DM + col0;
                    float s = 0.f;
#pragma unroll
                    for (int bj = 0; bj < 2; ++bj) {
                        float o[8]; res_dec8(rh[m][bj], rb[m][bj], o);
#pragma unroll
                        for (int j = 0; j < 4; ++j) { o[j] += acc[ai][bj][m][0][j]; o[4 + j] += acc[ai][bj][m][1][j]; }
                        if (p.mode == 1) {
                            *(f32x4*)(EP_FOUT(p) + off + bj * 128) = (f32x4){o[0], o[1], o[2], o[3]}; *(f32x4*)(EP_FOUT(p) + off + bj * 128 + 4) = (f32x4){o[4], o[5], o[6], o[7]};
                        } else {
                            u32x4 hw; hw.x = res_hb2(o[0], o[1]); hw.y = res_hb2(o[2], o[3]); hw.z = res_hb2(o[4], o[5]); hw.w = res_hb2(o[6], o[7]);
                            u32x2 bw; bw.x = res_b4(o[0], o[1], o[2], o[3]); bw.y = res_b4(o[4], o[5], o[6], o[7]);
                            *(u32x4*)(p.o0 + off + bj * 128) = hw; *(u32x2*)(EP_B3(p) + off + bj * 128) = bw;
                            s += (o[0] * o[0] + o[1] * o[1]) + (o[2] * o[2] + o[3] * o[3]) + (o[4] * o[4] + o[5] * o[5]) + (o[6] * o[6] + o[7] * o[7]);
                        }
                    }
                    if (p.mode != 1) {
                        s += __shfl_xor(s, 16); s += __shfl_xor(s, 32);
                        if (fq == 0) atomicAdd(EP_SSQ0(p) + row, s);
                    }
                }
                asm volatile("" ::: "memory");
            }
        } else {
            const int col = u.pn * 128 + wc * 32 + fq * 8;
#pragma unroll
            for (int n = 0; n < 2; ++n) {
                const f32x4 ba = *(const f32x4*)(EP_BA(p) + col + 4 * n), bx = *(const f32x4*)(EP_BX(p) + col + 4 * n), cl = *(const f32x4*)(EP_CL(p) + col + 4 * n);
                u32x2 xw[2][4];
#pragma unroll
                for (int ai = 0; ai < 2; ++ai)
#pragma unroll
                    for (int m = 0; m < 4; ++m) xw[ai][m] = *(const u32x2*)(EP_XS(p) + (size_t)(row0 + ai * 128 + m * 16) * LW + col + 4 * n);
                asm volatile("" ::: "memory");
#pragma unroll
                for (int ai = 0; ai < 2; ++ai)
#pragma unroll
                    for (int m = 0; m < 4; ++m) {
                        const size_t off = (size_t)(row0 + ai * 128 + m * 16) * LW + col + 4 * n;
                        const float xv[4] = {bf_lo(xw[ai][m].x), bf_hi(xw[ai][m].x), bf_lo(xw[ai][m].y), bf_hi(xw[ai][m].y)};
                        f32x4 la, bb;
#pragma unroll
                        for (int j = 0; j < 4; ++j) {
                            const float r = fast_sigmoid(acc[ai][0][m][n][j] + ba[j]), ig = fast_sigmoid(acc[ai][1][m][n][j] + bx[j]);
                            const float l = r * cl[j];
                            const float a2 = __builtin_amdgcn_exp2f(2.0f * l);
                            la[j] = l; bb[j] = __builtin_amdgcn_sqrtf(fmaxf(1.0f - a2, 0.f)) * ig * xv[j];
                        }
                        u32x2 w0, w1; w0.x = pk_bf16(la[0], la[1]); w0.y = pk_bf16(la[2], la[3]); w1.x = pk_bf16(bb[0], bb[1]); w1.y = pk_bf16(bb[2], bb[3]);
                        *(u32x2*)(p.o0 + off) = w0;
                        *(u32x2*)(p.o1 + off) = w1;
                    }
                asm volatile("" ::: "memory");
            }
        }
    }
};

struct Job { const float* src; int K, ldsrc; bf16_t* dst; int ndst; const float* gain; int perm; };
__device__ __forceinline__ int src_col(int perm, int n0, int nsrc) {
    const int tile = n0 >> 8, r = n0 & 255;
    if (perm == 1) return r < 128 ? 128 * tile + r : DFF + 128 * tile + (r - 128);
    if (perm == 2) return tile < 8 ? (r < 128 ? 1024 + 128 * tile + r : 2048 + 128 * tile + (r - 128)) : (tile - 8) * 256 + r;
    if (perm == 3) return n0 < 256 ? 384 + n0 : (n0 < 640 ? n0 - 256 : (n0 == 640 ? 640 : -1));
    return n0 < nsrc ? n0 : -1;
}
__device__ __forceinline__ void get_job(KA ka, int j, Job& jb) {
    unsigned char* const ws = P_WS;
    const float* mixn = (const float*)P_IN(2); const float* ffnn = (const float*)P_IN(25);
        if (j < 2) { jb = Job{(const float*)P_IN(3) + (size_t)j * DM * 3072, DM, 3072, (bf16_t*)(ws + OFF_WCIN) + (size_t)j * 3072 * DM, 3072, mixn + (j == 0 ? 0 : 3) * DM, 2}; }
    else if (j < 4) { const int i = j - 2; jb = Job{(const float*)P_IN(5) + (size_t)i * DM * DM, DM, DM, (bf16_t*)(ws + OFF_WCOUT) + (size_t)i * DM * DM, DM, nullptr, 0}; }
    else if (j == 4) jb = Job{(const float*)P_IN(6), DM, 2 * LW, (bf16_t*)(ws + OFF_WLIN), 2 * LW, mixn + 1 * DM, 0};
    else if (j == 5) jb = Job{(const float*)P_IN(14), LW, DM, (bf16_t*)(ws + OFF_WLOUT), DM, nullptr, 0};
    else if (j == 6) jb = Job{(const float*)P_IN(15), DM, 704, (bf16_t*)(ws + OFF_WMD), 768, mixn + 2 * DM, 3};
    else if (j == 7) jb = Job{(const float*)P_IN(18), 384, 1536, (bf16_t*)(ws + OFF_WUQ), 1536, (const float*)P_IN(16), 0};
    else if (j == 8) jb = Job{(const float*)P_IN(19), 256, 2048, (bf16_t*)(ws + OFF_WUKV), 2048, (const float*)P_IN(17), 0};
    else if (j == 9) jb = Job{(const float*)P_IN(24), DM, DM, (bf16_t*)(ws + OFF_WO), DM, nullptr, 0};
    else if (j < 14) { const int i = j - 10; jb = Job{(const float*)P_IN(26) + (size_t)i * DM * 2 * DFF, DM, 2 * DFF, (bf16_t*)(ws + OFF_WGU) + (size_t)i * 2 * DFF * DM, 2 * DFF, ffnn + i * DM, 1}; }
    else { const int i = j - 14; jb = Job{(const float*)P_IN(27) + (size_t)i * DFF * DM, DFF, DM, (bf16_t*)(ws + OFF_WDN) + (size_t)i * DM * DFF, DM, nullptr, 0}; }
}
__device__ void phase0(KA ka, LAS unsigned char* lds) {
    unsigned char* const ws = P_WS;
    const int tid = otid(), G = ogrid(), bx = obid(), lane = tid & 63, wid = tid >> 6;
    { float* z = (float*)(ws + OFF_SSQ) + T; const int n = 10 * T; for (int i = bx * NTHREADS + tid; i < n; i += G * NTHREADS) z[i] = 0.f; }
    if (bx == 0) { unsigned* bw = (unsigned*)(ws + OFF_BAR); for (int i = tid; i < 3456; i += NTHREADS) bw[i] = 0u; }
    if (bx == 0) { const float* lam = (const float*)P_IN(13); float* cl = (float*)(ws + OFF_CL); for (int c = tid; c < LW; c += NTHREADS) cl[c] = -8.0f * 1.4426950408889634f * log1pf(expf(-lam[c])); }
    { bf16_t* wlg = (bf16_t*)(ws + OFF_WLG); const float* wa = (const float*)P_IN(9); const float* wx = (const float*)P_IN(11);
      for (int i = bx * NTHREADS + tid; i < 2560 * 256; i += G * NTHREADS) { const int k = i & 255, row = i >> 8, n = row >> 8, gsel = (row >> 7) & 1, e = row & 127;
          float v = 0.f; if ((k >> 7) == (n & 1)) v = (gsel ? wx : wa)[((size_t)n * 128 + (k & 127)) * 128 + e];
          wlg[i] = (bf16_t)(pk_bf16(v, 0.f) & 0xffffu); } }
    { const float* x = (const float*)P_IN(0); bf16_t* hb = (bf16_t*)(ws + OFF_HB); unsigned char* b3 = ws + OFF_B3; float* ssq = (float*)(ws + OFF_SSQ);
      for (int row = bx * 8 + wid; row < T; row += G * 8) { float s = 0.f;
#pragma unroll
          for (int i = 0; i < 4; ++i) { const size_t o = (size_t)row * DM + i * 256 + lane * 4; const f32x4 v = *(const f32x4*)(x + o); s += (v[0] * v[0] + v[1] * v[1]) + (v[2] * v[2] + v[3] * v[3]);
              u32x2 w; w.x = res_hb2(v[0], v[1]); w.y = res_hb2(v[2], v[3]); *(u32x2*)(hb + o) = w; *(unsigned*)(b3 + o) = res_b4(v[0], v[1], v[2], v[3]); }
          s = wave_sum(s); if (lane == 0) ssq[row] = s; } }
    LAS float* tile = (LAS float*)lds;
    int jstart[19]; { int acc_ = 0;
#pragma unroll
        for (int j = 0; j < 18; ++j) { Job jb; get_job(ka, j, jb); jstart[j] = acc_; acc_ += (jb.K / 64) * (jb.ndst / 256); } jstart[18] = acc_; }
    for (int t = bx; t < jstart[18]; t += G) {
        int j = 0;
#pragma unroll
        for (int q = 1; q < 18; ++q) j += (t >= jstart[q]) ? 1 : 0;
        Job jb; get_job(ka, j, jb);
        const int tl = t - jstart[j], tk = jb.K / 64, k0 = (tl % tk) * 64, n0 = (tl / tk) * 256;
        const int sc = src_col(jb.perm, n0 + (lane >> 4) * 64, jb.ldsrc);
        f32x4 v[8];
#pragma unroll
        for (int i = 0; i < 8; ++i) v[i] = sc >= 0 ? *(const f32x4*)(jb.src + (size_t)(k0 + wid * 8 + i) * jb.ldsrc + sc + (lane & 15) * 4) : (f32x4){0.f, 0.f, 0.f, 0.f};
        __syncthreads();
#pragma unroll
        for (int i = 0; i < 8; ++i) *(LAS f32x4*)(tile + (wid * 8 + i) * 260 + lane * 4) = v[i];
        __syncthreads();
#pragma unroll
        for (int r = 0; r < 4; ++r) {
            const int item = tid + 512 * r, n = item & 255, kc = (item >> 8) * 8; float x[8];
#pragma unroll
            for (int i = 0; i < 8; ++i) x[i] = tile[(kc + i) * 260 + n] * (jb.gain ? jb.gain[k0 + kc + i] : 1.0f);
            u32x4 w; w.x = pk_bf16(x[0], x[1]); w.y = pk_bf16(x[2], x[3]); w.z = pk_bf16(x[4], x[5]); w.w = pk_bf16(x[6], x[7]);
            *(u32x4*)(jb.dst + (size_t)(n0 + n) * jb.K + k0 + kc) = w;
        }
    }
    __syncthreads();
}

__device__ void conv3_phase(KA ka, const float* cw) {
    unsigned char* const ws = P_WS;
    const bf16_t* U = (const bf16_t*)(ws + OFF_U); const bf16_t* BG = (const bf16_t*)(ws + OFF_BG); bf16_t* Y = (bf16_t*)(ws + OFF_Y);
    const int nitem = (T / 16) * 128;
    const int gstride = ogrid() * NTHREADS;
    for (int id = obid() * NTHREADS + otid(); id < nitem; id += gstride) {
        const int cgp = id & 127, rc = id >> 7, c0 = cgp * 8, t0 = rc * 16;
        float w0[8], w1[8], w2[8], um2[8], um1[8];
#pragma unroll
        for (int j = 0; j < 8; ++j) { w0[j] = cw[c0 + j]; w1[j] = cw[DM + c0 + j]; w2[j] = cw[2 * DM + c0 + j]; um2[j] = 0.f; um1[j] = 0.f; }
        if ((t0 & (SEQ - 1)) != 0) {
            const u32x4 a = *(const u32x4*)(U + (size_t)(t0 - 2) * DM + c0), b = *(const u32x4*)(U + (size_t)(t0 - 1) * DM + c0);
            um2[0] = bf_lo(a.x); um2[1] = bf_hi(a.x); um2[2] = bf_lo(a.y); um2[3] = bf_hi(a.y); um2[4] = bf_lo(a.z); um2[5] = bf_hi(a.z); um2[6] = bf_lo(a.w); um2[7] = bf_hi(a.w);
            um1[0] = bf_lo(b.x); um1[1] = bf_hi(b.x); um1[2] = bf_lo(b.y); um1[3] = bf_hi(b.y); um1[4] = bf_lo(b.z); um1[5] = bf_hi(b.z); um1[6] = bf_lo(b.w); um1[7] = bf_hi(b.w);
        }
#pragma unroll 4
        for (int r = 0; r < 16; ++r) {
            const size_t off = (size_t)(t0 + r) * DM + c0;
            const u32x4 a = *(const u32x4*)(U + off), g = *(const u32x4*)(BG + off);
            const float uc[8] = {bf_lo(a.x), bf_hi(a.x), bf_lo(a.y), bf_hi(a.y), bf_lo(a.z), bf_hi(a.z), bf_lo(a.w), bf_hi(a.w)};
            const float gv[8] = {bf_lo(g.x), bf_hi(g.x), bf_lo(g.y), bf_hi(g.y), bf_lo(g.z), bf_hi(g.z), bf_lo(g.w), bf_hi(g.w)};
            float y[8];
#pragma unroll
            for (int j = 0; j < 8; ++j) { y[j] = gv[j] * (w0[j] * um2[j] + w1[j] * um1[j] + w2[j] * uc[j]); um2[j] = um1[j]; um1[j] = uc[j]; }
            u32x4 w; w.x = pk_bf16(y[0], y[1]); w.y = pk_bf16(y[2], y[3]); w.z = pk_bf16(y[4], y[5]); w.w = pk_bf16(y[6], y[7]);
            *(u32x4*)(Y + off) = w;
        }
    }
}
__device__ void conv4_phase(KA ka) {
    unsigned char* const ws = P_WS;
    const bf16_t* R = (const bf16_t*)(ws + OFF_RECB); bf16_t* XS = (bf16_t*)(ws + OFF_XS);
    const float* cw = (const float*)P_IN(7); const float* cb = (const float*)P_IN(8);
    const int nitem = (T / 16) * 160;
    const int gstride = ogrid() * NTHREADS;
    for (int id = obid() * NTHREADS + otid(); id < nitem; id += gstride) {
        const int cgp = id % 160, rc = id / 160, c0 = cgp * 8, t0 = rc * 16;
        float w0[8], w1[8], w2[8], w3[8], bs[8], x3[8], x2[8], x1[8];
#pragma unroll
        for (int j = 0; j < 8; ++j) { w0[j] = cw[c0 + j]; w1[j] = cw[LW + c0 + j]; w2[j] = cw[2 * LW + c0 + j]; w3[j] = cw[3 * LW + c0 + j]; bs[j] = cb[c0 + j]; x3[j] = 0.f; x2[j] = 0.f; x1[j] = 0.f; }
        if ((t0 & (SEQ - 1)) != 0) {
            const u32x4 a = *(const u32x4*)(R + (size_t)(t0 - 3) * LW + c0), b = *(const u32x4*)(R + (size_t)(t0 - 2) * LW + c0), c = *(const u32x4*)(R + (size_t)(t0 - 1) * LW + c0);
            x3[0] = bf_lo(a.x); x3[1] = bf_hi(a.x); x3[2] = bf_lo(a.y); x3[3] = bf_hi(a.y); x3[4] = bf_lo(a.z); x3[5] = bf_hi(a.z); x3[6] = bf_lo(a.w); x3[7] = bf_hi(a.w);
            x2[0] = bf_lo(b.x); x2[1] = bf_hi(b.x); x2[2] = bf_lo(b.y); x2[3] = bf_hi(b.y); x2[4] = bf_lo(b.z); x2[5] = bf_hi(b.z); x2[6] = bf_lo(b.w); x2[7] = bf_hi(b.w);
            x1[0] = bf_lo(c.x); x1[1] = bf_hi(c.x); x1[2] = bf_lo(c.y); x1[3] = bf_hi(c.y); x1[4] = bf_lo(c.z); x1[5] = bf_hi(c.z); x1[6] = bf_lo(c.w); x1[7] = bf_hi(c.w);
        }
#pragma unroll 4
        for (int r = 0; r < 16; ++r) {
            const size_t off = (size_t)(t0 + r) * LW + c0;
            const u32x4 a = *(const u32x4*)(R + off);
            const float xc[8] = {bf_lo(a.x), bf_hi(a.x), bf_lo(a.y), bf_hi(a.y), bf_lo(a.z), bf_hi(a.z), bf_lo(a.w), bf_hi(a.w)};
            float y[8];
#pragma unroll
            for (int j = 0; j < 8; ++j) { y[j] = bs[j] + w0[j] * x3[j] + w1[j] * x2[j] + w2[j] * x1[j] + w3[j] * xc[j]; x3[j] = x2[j]; x2[j] = x1[j]; x1[j] = xc[j]; }
            u32x4 w; w.x = pk_bf16(y[0], y[1]); w.y = pk_bf16(y[2], y[3]); w.z = pk_bf16(y[4], y[5]); w.w = pk_bf16(y[6], y[7]);
            *(u32x4*)(XS + off) = w;
        }
    }
}
__device__ __forceinline__ void unpack8(const u32x4 w, float (&v)[8]) { v[0] = bf_lo(w.x); v[1] = bf_hi(w.x); v[2] = bf_lo(w.y); v[3] = bf_hi(w.y); v[4] = bf_lo(w.z); v[5] = bf_hi(w.z); v[6] = bf_lo(w.w); v[7] = bf_hi(w.w); }
__device__ void scan1_phase(KA ka) {
    unsigned char* const ws = P_WS;
    const bf16_t* LA = (const bf16_t*)P_OUT; const bf16_t* BB = (const bf16_t*)(ws + OFF_RECB);
    float* CA = (float*)(ws + OFF_CARRY); float* CH = CA + NBATCH * 64 * LW;
    const int nitem = NBATCH * 64 * 160;
    const int gstride = ogrid() * NTHREADS;
    for (int id = obid() * NTHREADS + otid(); id < nitem; id += gstride) {
        const int c8 = id % 160, bj = id / 160;
        const size_t base = (size_t)bj * 64 * LW + c8 * 8;
        float s[8], h[8];
#pragma unroll
        for (int k = 0; k < 8; ++k) { s[k] = 0.f; h[k] = 0.f; }
#pragma unroll 8
        for (int t = 0; t < 64; ++t) {
            float l[8], b[8]; unpack8(*(const u32x4*)(LA + base + (size_t)t * LW), l); unpack8(*(const u32x4*)(BB + base + (size_t)t * LW), b);
#pragma unroll
            for (int k = 0; k < 8; ++k) { s[k] += l[k]; h[k] = __builtin_amdgcn_exp2f(l[k]) * h[k] + b[k]; }
        }
        float* ca = CA + (size_t)bj * LW + c8 * 8; float* ch = CH + (size_t)bj * LW + c8 * 8;
        *(f32x4*)ca = (f32x4){s[0], s[1], s[2], s[3]}; *(f32x4*)(ca + 4) = (f32x4){s[4], s[5], s[6], s[7]};
        *(f32x4*)ch = (f32x4){h[0], h[1], h[2], h[3]}; *(f32x4*)(ch + 4) = (f32x4){h[4], h[5], h[6], h[7]};
    }
}
__device__ void scan2_phase(KA ka) {
    unsigned char* const ws = P_WS;
    const bf16_t* LA = (const bf16_t*)P_OUT; const bf16_t* BB = (const bf16_t*)(ws + OFF_RECB); bf16_t* GT = (bf16_t*)(ws + OFF_GATE);
    const float* CA = (const float*)(ws + OFF_CARRY); const float* CH = CA + NBATCH * 64 * LW;
    const int nitem = NBATCH * 64 * 160;
    const int gstride = ogrid() * NTHREADS;
    for (int id = obid() * NTHREADS + otid(); id < nitem; id += gstride) {
        const int c8 = id % 160, bj = id / 160, j = bj & 63, b0 = bj - j;
        float h[8];
#pragma unroll
        for (int k = 0; k < 8; ++k) h[k] = 0.f;
        const float* ca = CA + (size_t)b0 * LW + c8 * 8; const float* ch = CH + (size_t)b0 * LW + c8 * 8;
#pragma unroll 8
        for (int jj = 0; jj < j; ++jj) {
            const f32x4 a0 = *(const f32x4*)(ca + (size_t)jj * LW), a1 = *(const f32x4*)(ca + (size_t)jj * LW + 4);
            const f32x4 h0 = *(const f32x4*)(ch + (size_t)jj * LW), h1 = *(const f32x4*)(ch + (size_t)jj * LW + 4);
#pragma unroll
            for (int k = 0; k < 4; ++k) { h[k] = __builtin_amdgcn_exp2f(a0[k]) * h[k] + h0[k]; h[4 + k] = __builtin_amdgcn_exp2f(a1[k]) * h[4 + k] + h1[k]; }
        }
        const size_t base = (size_t)bj * 64 * LW + c8 * 8;
#pragma unroll 8
        for (int t = 0; t < 64; ++t) {
            const size_t o = base + (size_t)t * LW;
            float l[8], b[8], g[8]; unpack8(*(const u32x4*)(LA + o), l); unpack8(*(const u32x4*)(BB + o), b); unpack8(*(const u32x4*)(GT + o), g);
#pragma unroll
            for (int k = 0; k < 8; ++k) { h[k] = __builtin_amdgcn_exp2f(l[k]) * h[k] + b[k]; g[k] *= h[k]; }
            u32x4 w; w.x = pk_bf16(g[0], g[1]); w.y = pk_bf16(g[2], g[3]); w.z = pk_bf16(g[4], g[5]); w.w = pk_bf16(g[6], g[7]);
            *(u32x4*)(GT + o) = w;
        }
    }
}
__device__ __forceinline__ float sum8(float v) { v += __shfl_xor(v, 1); v += __shfl_xor(v, 2); v += __shfl_xor(v, 4); return v; }
__device__ void prep_phase(KA ka) {
    unsigned char* const ws = P_WS;
    const int tid = otid(), lane = tid & 63, wid = tid >> 6, G = ogrid(), bx = obid();
    bf16_t* QB = (bf16_t*)(ws + OFF_QB); bf16_t* KVB = (bf16_t*)(ws + OFF_KVB); bf16_t* KR = (bf16_t*)(ws + OFF_KR); const bf16_t* CB = (const bf16_t*)(ws + OFF_CBUF);
    const int* pos = (const int*)P_IN(1);
    const float* qn = (const float*)P_IN(20); const float* qr = (const float*)P_IN(21); const float* kn = (const float*)P_IN(22); const float* kr = (const float*)P_IN(23);
    const float QS = 0.07216878364870322f * 1.4426950408889634f;
    const int h = lane >> 3, j = lane & 7;
    float qng[16], kng[16], qrg[8], krg[8], ifq[8];
#pragma unroll
    for (int e = 0; e < 16; ++e) { qng[e] = qn[16 * j + e] * QS; kng[e] = kn[16 * j + e]; }
#pragma unroll
    for (int e = 0; e < 8; ++e) { qrg[e] = qr[8 * j + e] * QS; krg[e] = kr[8 * j + e]; ifq[e] = exp2f(-(float)(8 * (j & 3) + e) * (13.287712379549449f / 32.0f)); }
    for (int t = bx * 8 + wid; t < T; t += G * 8) {
        bf16_t* qp = QB + (size_t)t * 1536 + h * 192; bf16_t* kp = KVB + (size_t)t * 2048 + h * 256;
        const u32x4 qa = *(const u32x4*)(qp + 16 * j), qb2 = *(const u32x4*)(qp + 16 * j + 8), qc = *(const u32x4*)(qp + 128 + 8 * j);
        const u32x4 kA = *(const u32x4*)(kp + 16 * j), kB = *(const u32x4*)(kp + 16 * j + 8);
        const u32x4 kc = *(const u32x4*)(CB + (size_t)t * 768 + 640 + 8 * j);
        const float fp = (float)pos[t];
        float cs[8], sn[8];
#pragma unroll
        for (int e = 0; e < 8; ++e) {
            const float ang = fp * ifq[e];
            const float nrev = rintf(ang * 0.15915494309189535f);
            float rr = fmaf(-nrev, 6.2831854820251465f, ang); rr = fmaf(-nrev, -1.7484556000744883e-07f, rr);
            sn[e] = __sinf(rr); cs[e] = __cosf(rr);
        }
        float q[16], k[16], xq[8], xk[8];
        unpack8(qa, *(float(*)[8])&q[0]); unpack8(qb2, *(float(*)[8])&q[8]); unpack8(kA, *(float(*)[8])&k[0]); unpack8(kB, *(float(*)[8])&k[8]); unpack8(qc, xq); unpack8(kc, xk);
        float sq = 0.f, sk = 0.f, sqr = 0.f, skr = 0.f;
#pragma unroll
        for (int e = 0; e < 16; ++e) { sq += q[e] * q[e]; sk += k[e] * k[e]; }
#pragma unroll
        for (int e = 0; e < 8; ++e) { sqr += xq[e] * xq[e]; skr += xk[e] * xk[e]; }
        sq = sum8(sq); sk = sum8(sk); sqr = sum8(sqr); skr = sum8(skr);
        const float rq = rsqrtf(sq * (1.0f / 128.0f) + EPS), rk = rsqrtf(sk * (1.0f / 128.0f) + EPS), rqr = rsqrtf(sqr * (1.0f / 64.0f) + EPS), rkr = rsqrtf(skr * (1.0f / 64.0f) + EPS);
#pragma unroll
        for (int e = 0; e < 16; ++e) { q[e] *= rq * qng[e]; k[e] *= rk * kng[e]; }
        float oq[8], ok[8];
#pragma unroll
        for (int e = 0; e < 8; ++e) {
            const float a = xq[e] * rqr * qrg[e], pa = __shfl_xor(a, 4);
            const float b = xk[e] * rkr * krg[e], pb = __shfl_xor(b, 4);
            oq[e] = j < 4 ? a * cs[e] - pa * sn[e] : a * cs[e] + pa * sn[e];
            ok[e] = j < 4 ? b * cs[e] - pb * sn[e] : b * cs[e] + pb * sn[e];
        }
        u32x4 w;
        w.x = pk_bf16(q[0], q[1]); w.y = pk_bf16(q[2], q[3]); w.z = pk_bf16(q[4], q[5]); w.w = pk_bf16(q[6], q[7]); *(u32x4*)(qp + 16 * j) = w;
        w.x = pk_bf16(q[8], q[9]); w.y = pk_bf16(q[10], q[11]); w.z = pk_bf16(q[12], q[13]); w.w = pk_bf16(q[14], q[15]); *(u32x4*)(qp + 16 * j + 8) = w;
        w.x = pk_bf16(oq[0], oq[1]); w.y = pk_bf16(oq[2], oq[3]); w.z = pk_bf16(oq[4], oq[5]); w.w = pk_bf16(oq[6], oq[7]); *(u32x4*)(qp + 128 + 8 * j) = w;
        w.x = pk_bf16(k[0], k[1]); w.y = pk_bf16(k[2], k[3]); w.z = pk_bf16(k[4], k[5]); w.w = pk_bf16(k[6], k[7]); *(u32x4*)(kp + 16 * j) = w;
        w.x = pk_bf16(k[8], k[9]); w.y = pk_bf16(k[10], k[11]); w.z = pk_bf16(k[12], k[13]); w.w = pk_bf16(k[14], k[15]); *(u32x4*)(kp + 16 * j + 8) = w;
        if (h == 0) { w.x = pk_bf16(ok[0], ok[1]); w.y = pk_bf16(ok[2], ok[3]); w.z = pk_bf16(ok[4], ok[5]); w.w = pk_bf16(ok[6], ok[7]); *(u32x4*)(KR + (size_t)t * 64 + 8 * j) = w; }
    }
}

constexpr int KP = 400, VP = 320, KBUF = 64 * KP, VBUF = 64 * VP;
__device__ __forceinline__ int crow(int r, int hi) { return (r & 3) + 8 * (r >> 2) + 4 * hi; }
__device__ void attn_phase(KA ka, LAS unsigned char* lds) {
    unsigned char* const ws = P_WS;
    const int tid = otid(), lane = tid & 63, w = __builtin_amdgcn_readfirstlane(tid >> 6), G = ogrid(), bx = obid();
    const bf16_t* QB = (const bf16_t*)(ws + OFF_QB); const bf16_t* KVB = (const bf16_t*)(ws + OFF_KVB); const bf16_t* KR = (const bf16_t*)(ws + OFF_KR); bf16_t* OB = (bf16_t*)(ws + OFF_OBUF);
    const int c = lane & 31, hi = lane >> 5;
    const int kn_key0 = tid >> 4, kn_ch = tid & 15;
    const int kr_key = tid >> 3, kr_ch = tid & 7;
    const unsigned kvoff = (unsigned)(kn_key0 * 4096 + kn_ch * 16), kroff = (unsigned)(kr_key * 128 + kr_ch * 16);
    const unsigned k_rd = (unsigned)(c * KP + hi * 16);
    const int g4 = lane >> 4, i16 = lane & 15, qq = i16 >> 2, pp = i16 & 3;
    const unsigned v_rd = (unsigned)((4 * hi + qq) * VP + (g4 & 1) * 32 + pp * 8);
    const int vcu = (G % 8 == 0) ? (bx % 8) * (G / 8) + bx / 8 : bx;
    for (int vw = vcu; vw < 256; vw += G) {
        const int bh = vw >> 2, sub = vw & 3, b = bh >> 3, h = bh & 7;
        for (int ui = 0; ui < 4; ++ui) {
            const int qb = ui == 0 ? 15 - sub : (ui == 1 ? 8 + sub : (ui == 2 ? 7 - sub : sub));
            const int q0 = qb * 256 + w * 32;
            const char* qbase = (const char*)(QB + ((size_t)b * SEQ + q0) * 1536 + h * 192);
            asm volatile("" : "+s"(qbase));
            const unsigned qoff = (unsigned)(c * 3072 + hi * 16);
            bf16x8 qf[12];
#pragma unroll
            for (int ks = 0; ks < 12; ++ks) qf[ks] = *(const bf16x8*)(qbase + qoff + ks * 32);
            f32x16 oacc[4];
#pragma unroll
            for (int i = 0; i < 4; ++i)
#pragma unroll
                for (int j = 0; j < 16; ++j) oacc[i][j] = 0.f;
            float mrun = -1e30f, lrun = 0.f;
            const int ntile = 4 * qb + 4, wlast = 4 * qb + (w >> 1);
            const char* kvbase = (const char*)(KVB + (size_t)b * SEQ * 2048 + h * 256);
            const char* krbase = (const char*)(KR + (size_t)b * SEQ * 64);
            asm volatile("" : "+s"(kvbase), "+s"(krbase));
            u32x4 sk0, sk1, skr, sv0, sv1;
#define ATT_LOADK(kt) do { const char* tb_ = kvbase + (size_t)(kt) * (64 * 4096); const char* tr_ = krbase + (size_t)(kt) * (64 * 128); \
                sk0 = *(const u32x4*)(tb_ + kvoff); sk1 = *(const u32x4*)(tb_ + 32 * 4096 + kvoff); skr = *(const u32x4*)(tr_ + kroff); } while (0)
#define ATT_LOADV(kt) do { const char* tb_ = kvbase + (size_t)(kt) * (64 * 4096) + 256; \
                sv0 = *(const u32x4*)(tb_ + kvoff); sv1 = *(const u32x4*)(tb_ + 32 * 4096 + kvoff); } while (0)
#define ATT_WRITEK(buf) do { LAS unsigned char* kb_ = lds + (buf) * KBUF; \
                *(LAS u32x4*)(kb_ + kn_key0 * KP + kn_ch * 16) = sk0; *(LAS u32x4*)(kb_ + (kn_key0 + 32) * KP + kn_ch * 16) = sk1; \
                *(LAS u32x4*)(kb_ + kr_key * KP + 256 + kr_ch * 16) = skr; } while (0)
#define ATT_WRITEV(buf) do { LAS unsigned char* vb_ = lds + 2 * KBUF + (buf) * VBUF; \
                *(LAS u32x4*)(vb_ + kn_key0 * VP + kn_ch * 16) = sv0; *(LAS u32x4*)(vb_ + (kn_key0 + 32) * VP + kn_ch * 16) = sv1; } while (0)
            __syncthreads();
            ATT_LOADK(0); ATT_LOADV(0); ATT_WRITEK(0); ATT_WRITEV(0);
            __syncthreads();
            for (int kt = 0; kt < ntile; ++kt) {
                const int buf = kt & 1;
                const bool more = kt + 1 < ntile, active = kt <= wlast;
                if (more) ATT_LOADK(kt + 1);
                f32x16 sacc[2];
                if (active) {
                    const LAS unsigned char* kb = lds + buf * KBUF + k_rd;
#pragma unroll
                    for (int kb2 = 0; kb2 < 2; ++kb2)
#pragma unroll
                        for (int j = 0; j < 16; ++j) sacc[kb2][j] = 0.f;
                    bf16x8 kf[2][4];
#define ATT_LDK(dst, g) do { _Pragma("unroll") for (int q_ = 0; q_ < 4; ++q_) dst[q_] = *(const LAS bf16x8*)(kb + ((g) / 3) * 32 * KP + (((g) % 3) * 4 + q_) * 32); } while (0)
                    ATT_LDK(kf[0], 0);
#pragma unroll
                    for (int g = 0; g < 6; ++g) {
                        if (g < 5) ATT_LDK(kf[(g + 1) & 1], g + 1);
                        __builtin_amdgcn_sched_barrier(0);
#pragma unroll
                        for (int q_ = 0; q_ < 4; ++q_) sacc[g / 3] = __builtin_amdgcn_mfma_f32_32x32x16_bf16(kf[g & 1][q_], qf[(g % 3) * 4 + q_], sacc[g / 3], 0, 0, 0);
                        __builtin_amdgcn_sched_barrier(0);
                    }
#undef ATT_LDK
                }
                if (more) { ATT_WRITEK(buf ^ 1); ATT_LOADV(kt + 1); }
                if (active) {
                    const LAS unsigned char* vb = lds + 2 * KBUF + buf * VBUF + v_rd;
                    bf16x8 vf[2][4];
#define ATT_LDV(dst, gg) do { _Pragma("unroll") for (int i_ = 0; i_ < 4; ++i_) { \
                        const s16x4 lo_ = __builtin_amdgcn_ds_read_tr16_b64_v4i16((LAS s16x4*)(vb + ((gg) * 16) * VP + i_ * 64)); \
                        const s16x4 hv_ = __builtin_amdgcn_ds_read_tr16_b64_v4i16((LAS s16x4*)(vb + ((gg) * 16 + 8) * VP + i_ * 64)); \
                        dst[i_] = __builtin_shufflevector(lo_, hv_, 0, 1, 2, 3, 4, 5, 6, 7); } } while (0)
                    ATT_LDV(vf[0], 0);
                    if (kt == wlast) {
                        const int qi = q0 + c - kt * 64;
#pragma unroll
                        for (int kb2 = 0; kb2 < 2; ++kb2)
#pragma unroll
                            for (int j = 0; j < 16; ++j) if (kb2 * 32 + crow(j, hi) > qi) sacc[kb2][j] = -INFINITY;
                    }
                    float mx = sacc[0][0];
#pragma unroll
                    for (int kb2 = 0; kb2 < 2; ++kb2)
#pragma unroll
                        for (int j = 0; j < 16; ++j) mx = fmaxf(mx, sacc[kb2][j]);
                    mx = fmaxf(mx, __shfl_xor(mx, 32));
                    const float mnew = fmaxf(mrun, mx), alpha = __builtin_amdgcn_exp2f(mrun - mnew);
                    mrun = mnew;
                    float ps = 0.f;
#pragma unroll
                    for (int kb2 = 0; kb2 < 2; ++kb2)
#pragma unroll
                        for (int j = 0; j < 16; ++j) { const float e = __builtin_amdgcn_exp2f(sacc[kb2][j] - mnew); sacc[kb2][j] = e; ps += e; }
                    lrun = lrun * alpha + ps;
#pragma unroll
                    for (int i = 0; i < 4; ++i)
#pragma unroll
                        for (int j = 0; j < 16; ++j) oacc[i][j] *= alpha;
                    bf16x8 pb[2][2];
#pragma unroll
                    for (int kb2 = 0; kb2 < 2; ++kb2)
#pragma unroll
                        for (int s2 = 0; s2 < 2; ++s2) {
                            u32x4 pw;
                            pw.x = pk_bf16(sacc[kb2][8 * s2 + 0], sacc[kb2][8 * s2 + 1]); pw.y = pk_bf16(sacc[kb2][8 * s2 + 2], sacc[kb2][8 * s2 + 3]);
                            pw.z = pk_bf16(sacc[kb2][8 * s2 + 4], sacc[kb2][8 * s2 + 5]); pw.w = pk_bf16(sacc[kb2][8 * s2 + 6], sacc[kb2][8 * s2 + 7]);
                            pb[kb2][s2] = __builtin_bit_cast(bf16x8, pw);
                        }
#pragma unroll
                    for (int gg = 0; gg < 4; ++gg) {
                        if (gg < 3) ATT_LDV(vf[(gg + 1) & 1], gg + 1);
                        __builtin_amdgcn_sched_barrier(0);
#pragma unroll
                        for (int i = 0; i < 4; ++i) oacc[i] = __builtin_amdgcn_mfma_f32_32x32x16_bf16(vf[gg & 1][i], pb[gg >> 1][gg & 1], oacc[i], 0, 0, 0);
                        __builtin_amdgcn_sched_barrier(0);
                    }
#undef ATT_LDV
                }
                if (more) ATT_WRITEV(buf ^ 1);
                __syncthreads();
            }
#undef ATT_LOADK
#undef ATT_LOADV
#undef ATT_WRITEK
#undef ATT_WRITEV
            const float ltot = lrun + __shfl_xor(lrun, 32), inv = 1.0f / ltot;
            char* obase = (char*)(OB + ((size_t)b * SEQ + q0) * DM + h * 128);
            asm volatile("" : "+s"(obase));
            const unsigned ooff = (unsigned)(c * 2048 + hi * 8);
#pragma unroll
            for (int i = 0; i < 4; ++i)
#pragma unroll
                for (int g = 0; g < 4; ++g) {
                    u32x2 wv; wv.x = pk_bf16(oacc[i][4 * g] * inv, oacc[i][4 * g + 1] * inv); wv.y = pk_bf16(oacc[i][4 * g + 2] * inv, oacc[i][4 * g + 3] * inv);
                    *(u32x2*)(obase + ooff + 64 * i + 16 * g) = wv;
                }
        }
    }
    __syncthreads();
}

#define XB_TMO      128
#define XB_XCNT(j)  (256  + 64 * (j))
#define XB_XSUB(j)  (1280 + 64 * (j))
#define XB_XGEN(j)  (2304 + 64 * (j))
#define XB_TOP      3328
#define XB_TOPGEN   3392
#define XCD_BAR_WORDS 3456
#define XB_SPIN_CAP (1u << 20)
__device__ __forceinline__ unsigned xb_ld(unsigned* p)              { return __hip_atomic_load(p, __ATOMIC_RELAXED, __HIP_MEMORY_SCOPE_AGENT); }
__device__ __forceinline__ unsigned xb_add(unsigned* p, unsigned v) { return __hip_atomic_fetch_add(p, v, __ATOMIC_RELAXED, __HIP_MEMORY_SCOPE_AGENT); }
__device__ __forceinline__ unsigned xb_xcc_id() { return (unsigned)__builtin_amdgcn_s_getreg((3 << 11) | 20) & 0xFu; }
#define XB_SPIN(cond, bar) do { unsigned _sp = 0; while (cond) { __builtin_amdgcn_s_sleep(1); \
    if ((++_sp & 255u) == 0u) { if (xb_ld(&(bar)[XB_TMO])) break; if (_sp > XB_SPIN_CAP) { atomicAdd(&(bar)[XB_TMO], 1u); break; } } } } while (0)
struct XcdBarrier { unsigned* bar; unsigned x; volatile LAS unsigned* st; };
__device__ __forceinline__ XcdBarrier xcd_barrier_post(unsigned* bar, volatile LAS unsigned* st) {
    XcdBarrier b; b.bar = bar; b.x = xb_xcc_id(); b.st = st;
    if (threadIdx.x == 0) (void)xb_add(&bar[XB_XCNT(b.x)], 1u);
    return b;
}
__device__ __forceinline__ void xcd_barrier_complete(unsigned* bar, unsigned x, unsigned& nloc, unsigned& nx) {
    const unsigned G = gridDim.x * gridDim.y * gridDim.z;
    unsigned sum, cnt, mine, sp = 0u;
    for (;;) {
        sum = 0u; cnt = 0u; mine = 0u;
#pragma unroll
        for (unsigned j = 0; j < 16; ++j) { const unsigned c = xb_ld(&bar[XB_XCNT(j)]); sum += c; cnt += (c > 0u) ? 1u : 0u; mine = (j == x) ? c : mine; }
        if (sum == G) break;
        __builtin_amdgcn_s_sleep(1);
        if ((++sp & 255u) == 0u) { if (xb_ld(&bar[XB_TMO])) break; if (sp > XB_SPIN_CAP) { atomicAdd(&bar[XB_TMO], 1u); break; } }
    }
    nloc = mine > 0u ? mine : 1u; nx = cnt > 0u ? cnt : 1u;
}
__device__ __forceinline__ void xcd_barrier(const XcdBarrier& b) {
    asm volatile("s_waitcnt vmcnt(0)" ::: "memory");
    __syncthreads();
    if (threadIdx.x == 0) {
        unsigned* bar = b.bar;
        __builtin_amdgcn_s_waitcnt(0);
        unsigned nloc = b.st[0], nx = b.st[1];
        if (nloc == 0u) { xcd_barrier_complete(bar, b.x, nloc, nx); b.st[0] = nloc; b.st[1] = nx; }
        const unsigned old = xb_add(&bar[XB_XSUB(b.x)], 1u);
        const unsigned gen = old / nloc;
        if (old + 1u == (gen + 1u) * nloc) {
            __builtin_amdgcn_fence(__ATOMIC_RELEASE, "agent");
            asm volatile("s_waitcnt vmcnt(0)" ::: "memory");
            const unsigned og = xb_add(&bar[XB_TOP], 1u);
            const unsigned tg = og / nx;
            if (og + 1u == (tg + 1u) * nx) xb_add(&bar[XB_TOPGEN], 1u);
            else XB_SPIN(xb_ld(&bar[XB_TOPGEN]) == tg, bar);
            __builtin_amdgcn_fence(__ATOMIC_ACQUIRE, "agent");
            xb_add(&bar[XB_XGEN(b.x)], 1u);
            asm volatile("s_waitcnt vmcnt(0)" ::: "memory");
        } else {
            XB_SPIN(xb_ld(&bar[XB_XGEN(b.x)]) == gen, bar);
            __builtin_amdgcn_fence(__ATOMIC_ACQUIRE, "agent");
            asm volatile("s_waitcnt vmcnt(0)" ::: "memory");
        }
    }
    __syncthreads();
}

enum { OP_CIN, OP_CONV3, OP_COUT, OP_GU, OP_DOWN, OP_LIN, OP_CONV4, OP_GATE, OP_SCAN1, OP_SCAN2, OP_LOUT, OP_MDOWN, OP_UQ, OP_UKV, OP_PREP, OP_ATTN, OP_WO };
enum { GT_NONE, GT_PAIR, GT_STORE, GT_RESID, GT_GATE };
__device__ const unsigned char g_prog[26][3] = {
    {OP_CIN, 0, 1}, {OP_CONV3, 0, 1}, {OP_COUT, 0, 1}, {OP_GU, 0, 1}, {OP_DOWN, 0, 1},
    {OP_LIN, 1, 1}, {OP_CONV4, 1, 1}, {OP_GATE, 1, 1}, {OP_SCAN1, 1, 1}, {OP_SCAN2, 1, 1}, {OP_LOUT, 1, 1}, {OP_GU, 1, 1}, {OP_DOWN, 1, 1},
    {OP_MDOWN, 2, 1}, {OP_UQ, 2, 0}, {OP_UKV, 2, 1}, {OP_PREP, 2, 1}, {OP_ATTN, 2, 1}, {OP_WO, 2, 1}, {OP_GU, 2, 1}, {OP_DOWN, 2, 1},
    {OP_CIN, 3, 1}, {OP_CONV3, 3, 1}, {OP_COUT, 3, 1}, {OP_GU, 3, 1}, {OP_DOWN, 3, 1}};

__global__ void __launch_bounds__(NTHREADS) mega_fwd(Params p) {
    extern __shared__ __attribute__((aligned(16))) unsigned char lds_raw[];
    LAS unsigned char* lds = (LAS unsigned char*)lds_raw;
    cg::grid_group grid = cg::this_grid();
    KA ka = (KA)__builtin_amdgcn_kernarg_segment_ptr();
    (void)p;
    volatile LAS unsigned* xst = (volatile LAS unsigned*)(lds + pg8::STAGE_BYTES);
    if (threadIdx.x < 4) xst[threadIdx.x] = 0u;
    __syncthreads();
    for (int i = 0; i < PROBE_P0; ++i) { phase0(ka, lds); grid.sync(); }
    phase0(ka, lds);
    grid.sync();
    (void)xcd_barrier_post((unsigned*)(P_WS + OFF_BAR), xst);
#define GRID_BAR() do { XcdBarrier xb_; xb_.bar = (unsigned*)(P_WS + OFF_BAR); xb_.x = xb_xcc_id(); xb_.st = (volatile LAS unsigned*)(lds + pg8::STAGE_BYTES); xcd_barrier(xb_); } while (0)
    for (int i = 0; i < PROBE_SYNCS; ++i) GRID_BAR();
    for (int st = 0, rep = 0; st < 26; ++st) {
        asm volatile("" : "+s"(ka));
        unsigned char* const ws = P_WS;
        float* const ssq = (float*)(ws + OFF_SSQ);
        bf16_t* const hb = (bf16_t*)(ws + OFF_HB);
        const int op = g_prog[st][0], L = g_prog[st][1], sync_after = g_prog[st][2];
        const int j = L / 3;
        int gt = GT_NONE; pg8::Gemm g{}; EP e{};
        switch (op) {
        case OP_CIN:
            gt = GT_PAIR; g = pg8::Gemm{hb, (const bf16_t*)(ws + OFF_WCIN) + (size_t)j * 3072 * DM, T, 3072, DM, DM, 0};
            e.o0 = (bf16_t*)(ws + OFF_U); e.ld0 = DM; e.o1 = (bf16_t*)(ws + OFF_BG); e.ld1 = DM; e.split = 8; e.mode = 1; e.q2 = ssq + (size_t)(2 * L) * T; e.inv_dim = 1.0f / DM; break;
        case OP_CONV3: conv3_phase(ka, (const float*)P_IN(4) + (size_t)j * 3 * DM); break;
        case OP_COUT:
            gt = GT_RESID; g = pg8::Gemm{(const bf16_t*)(ws + OFF_Y), (const bf16_t*)(ws + OFF_WCOUT) + (size_t)j * DM * DM, T, DM, DM, DM, 0};
            e.q2 = ws + OFF_B3; e.o0 = hb; e.q3 = ssq + (size_t)(2 * L + 1) * T; break;
        case OP_GU:
            gt = GT_PAIR; g = pg8::Gemm{hb, (const bf16_t*)(ws + OFF_WGU) + (size_t)L * 2 * DFF * DM, T, 2 * DFF, DM, DM, 0};
            e.o0 = (bf16_t*)(ws + OFF_ACT); e.ld0 = DFF; e.split = 1 << 20; e.mode = 0; e.q2 = ssq + (size_t)(2 * L + 1) * T; e.inv_dim = 1.0f / DM; break;
        case OP_DOWN:
            gt = GT_RESID; g = pg8::Gemm{(const bf16_t*)(ws + OFF_ACT), (const bf16_t*)(ws + OFF_WDN) + (size_t)L * DM * DFF, T, DM, DFF, DFF, 0};
            e.q2 = ws + OFF_B3; e.q4 = P_OUT; e.mode = (L == 3) ? 1 : 0; e.o0 = hb; e.q3 = ssq + (size_t)(L < 3 ? 2 * L + 2 : 10) * T; break;
        case OP_LIN:
            gt = GT_STORE; g = pg8::Gemm{hb, (const bf16_t*)(ws + OFF_WLIN), T, 2 * LW, DM, DM, 0};
            e.o0 = (bf16_t*)(ws + OFF_GATE); e.ld0 = LW; e.o1 = (bf16_t*)(ws + OFF_RECB); e.ld1 = LW; e.split = 5; e.mode = 1; e.q2 = ssq + (size_t)(2 * L) * T; e.inv_dim = 1.0f / DM; break;
        case OP_CONV4: conv4_phase(ka); break;
        case OP_GATE:
            gt = GT_GATE; g = pg8::Gemm{(const bf16_t*)(ws + OFF_XS), (const bf16_t*)(ws + OFF_WLG), T, 2 * LW, 256, LW, 256};
            e.o0 = (bf16_t*)P_OUT; e.o1 = (bf16_t*)(ws + OFF_RECB); e.q2 = (const bf16_t*)(ws + OFF_XS);
            e.q3 = (void*)P_IN(10); e.q4 = (void*)P_IN(12); e.q5 = (const float*)(ws + OFF_CL); break;
        case OP_SCAN1: scan1_phase(ka); break;
        case OP_SCAN2: scan2_phase(ka); break;
        case OP_LOUT:
            gt = GT_RESID; g = pg8::Gemm{(const bf16_t*)(ws + OFF_GATE), (const bf16_t*)(ws + OFF_WLOUT), T, DM, LW, LW, 0};
            e.q2 = ws + OFF_B3; e.o0 = hb; e.q3 = ssq + (size_t)(2 * L + 1) * T; break;
        case OP_MDOWN:
            gt = GT_STORE; g = pg8::Gemm{hb, (const bf16_t*)(ws + OFF_WMD), T, 768, DM, DM, 0};
            e.o0 = (bf16_t*)(ws + OFF_CBUF); e.ld0 = 768; e.split = 1 << 20; e.mode = 2; e.q2 = ssq + (size_t)(2 * L) * T; e.inv_dim = 1.0f / DM;
            e.q3 = ssq + (size_t)8 * T; e.q4 = ssq + (size_t)9 * T; break;
        case OP_UQ:
            gt = GT_STORE; g = pg8::Gemm{(const bf16_t*)(ws + OFF_CBUF) + 256, (const bf16_t*)(ws + OFF_WUQ), T, 1536, 384, 768, 0};
            e.o0 = (bf16_t*)(ws + OFF_QB); e.ld0 = 1536; e.split = 1 << 20; e.mode = 0; e.q2 = ssq + (size_t)9 * T; e.inv_dim = 1.0f / 384.0f; break;
        case OP_UKV:
            gt = GT_STORE; g = pg8::Gemm{(const bf16_t*)(ws + OFF_CBUF), (const bf16_t*)(ws + OFF_WUKV), T, 2048, 256, 768, 0};
            e.o0 = (bf16_t*)(ws + OFF_KVB); e.ld0 = 2048; e.split = 1 << 20; e.mode = 0; e.q2 = ssq + (size_t)8 * T; e.inv_dim = 1.0f / 256.0f; break;
        case OP_PREP: prep_phase(ka); break;
        case OP_ATTN: attn_phase(ka, lds); break;
        case OP_WO:
            gt = GT_RESID; g = pg8::Gemm{(const bf16_t*)(ws + OFF_OBUF), (const bf16_t*)(ws + OFF_WO), T, DM, DM, DM, 0};
            e.q2 = ws + OFF_B3; e.o0 = hb; e.q3 = ssq + (size_t)(2 * L + 1) * T; break;
        default: break;
        }
        if (gt == GT_RESID && ((PROBE_MASK >> op) & 1u) && rep == 0) {
            e.mode = 1; e.q4 = ws + OFF_R + 192 * MiB; }
        if (gt != GT_NONE) {
            pg8::StaticOrder S; S.init(g.M, g.N, ogrid(), obid());
            e.type = gt - 1;
            EpiAll E{e}; pg8::gemm_phase<EpiAll>(lds, g, S, E);
        }
        if (sync_after) GRID_BAR();
        if (((PROBE_MASK >> op) & 1u) && rep == 0) { if (!sync_after) GRID_BAR(); rep = 1; --st; } else rep = 0;
    }
}

constexpr int LDS_BYTES = pg8::STAGE_BYTES + 64;

extern "C" void kernel_launch(void* const* d_in, const int* in_sizes, int n_in, void* d_out, int out_size, void* d_ws, size_t ws_size, hipStream_t stream) {
    static int grid_blocks = 0;
    if (grid_blocks == 0) {
        if (n_in != 28 || ws_size < WS_NEED) { fprintf(stderr, "kernel_launch: unexpected inputs (n_in %d, ws %zu, need %zu)\n", n_in, ws_size, (size_t)WS_NEED); grid_blocks = -1; return; }
        int dev = 0, cus = 0, per_cu = 0;
        hipGetDevice(&dev);
        hipDeviceGetAttribute(&cus, hipDeviceAttributeMultiprocessorCount, dev);
        hipFuncSetAttribute((const void*)mega_fwd, hipFuncAttributeMaxDynamicSharedMemorySize, LDS_BYTES);
        hipOccupancyMaxActiveBlocksPerMultiprocessor(&per_cu, (const void*)mega_fwd, NTHREADS, LDS_BYTES);
        if (per_cu < 1) { fprintf(stderr, "kernel_launch: occupancy query returned %d\n", per_cu); per_cu = 1; }
        grid_blocks = cus;
        (void)hipGetLastError();
    }
    if (grid_blocks < 0) return;
    Params p{};
    for (int i = 0; i < 28; ++i) p.in[i] = d_in[i];
    p.out = (float*)d_out; p.ws = (unsigned char*)d_ws;
    void* args[] = {&p};
    hipError_t e = hipLaunchCooperativeKernel((const void*)mega_fwd, dim3(grid_blocks), dim3(NTHREADS), args, LDS_BYTES, stream);
    if (e != hipSuccess) fprintf(stderr, "cooperative launch failed: %s (grid %d)\n", hipGetErrorString(e), grid_blocks);
}
```

```cpp
#include <hip/hip_runtime.h>
#include <hip/hip_cooperative_groups.h>
#include <cstdio>
namespace cg = cooperative_groups;

#define LAS __attribute__((address_space(3)))
typedef unsigned short bf16_t;
typedef short bf16x8 __attribute__((ext_vector_type(8)));
typedef short s16x4 __attribute__((ext_vector_type(4)));
typedef float f32x2 __attribute__((ext_vector_type(2)));
typedef float f32x4 __attribute__((ext_vector_type(4)));
typedef float f32x16 __attribute__((ext_vector_type(16)));
typedef unsigned u32x2 __attribute__((ext_vector_type(2)));
typedef unsigned u32x4 __attribute__((ext_vector_type(4)));
typedef __bf16 bf2_t __attribute__((ext_vector_type(2)));

#define PROBE_MASK 0x0u
#define PROBE_CLK 0
#define PROBE_SYNCS 0
#define PROBE_P0 0
constexpr int T = 32768, DM = 1024, SEQ = 4096, NBATCH = 8, DFF = 2816, LW = 1280;
constexpr int NTHREADS = 512;
constexpr float EPS = 1e-6f;
constexpr size_t MiB = 1ull << 20;
constexpr size_t OFF_WCIN = 0;
constexpr size_t OFF_WCOUT = 12 * MiB;
constexpr size_t OFF_WLIN = 16 * MiB;
constexpr size_t OFF_WLG = 21 * MiB;
constexpr size_t OFF_WLOUT = 22 * MiB + MiB / 4;
constexpr size_t OFF_WMD = 24 * MiB + 3 * MiB / 4;
constexpr size_t OFF_WUQ = 26 * MiB + MiB / 4;
constexpr size_t OFF_WUKV = 27 * MiB + 3 * MiB / 8;
constexpr size_t OFF_WO = 28 * MiB + 3 * MiB / 8;
constexpr size_t OFF_WGU = 31 * MiB;
constexpr size_t OFF_WDN = 75 * MiB;
constexpr size_t OFF_HB = 97 * MiB;
constexpr size_t OFF_SSQ = 161 * MiB;
constexpr size_t OFF_CL = OFF_SSQ + 11ull * T * 4;
constexpr size_t OFF_BAR = OFF_CL + 8192;
constexpr size_t OFF_B3 = 163 * MiB;
constexpr size_t OFF_R = 195 * MiB;
constexpr size_t OFF_ACT = OFF_R;
constexpr size_t OFF_U = OFF_R, OFF_BG = OFF_R + 64 * MiB, OFF_Y = OFF_R + 128 * MiB;
constexpr size_t OFF_GATE = OFF_R, OFF_RECB = OFF_R + 80 * MiB, OFF_XS = OFF_R + 160 * MiB, OFF_CARRY = OFF_R + 240 * MiB;
constexpr size_t OFF_CBUF = OFF_R, OFF_OBUF = OFF_R, OFF_QB = OFF_R + 64 * MiB, OFF_KVB = OFF_R + 160 * MiB, OFF_KR = OFF_R + 288 * MiB;
constexpr size_t WS_NEED = OFF_R + 316 * MiB;

struct Params { const void* in[28]; float* out; unsigned char* ws; };
typedef const void* kptr_t;
typedef const __attribute__((address_space(4))) kptr_t* KA;
#define P_IN(i) (ka[(i)])
#define P_OUT ((float*)ka[28])
#define P_WS ((unsigned char*)ka[29])

__device__ __forceinline__ unsigned pk_bf16(float lo, float hi) { bf2_t v = __builtin_convertvector((f32x2){lo, hi}, bf2_t); return __builtin_bit_cast(unsigned, v); }
__device__ __forceinline__ float bf_lo(unsigned w) { return __uint_as_float(w << 16); }
__device__ __forceinline__ float bf_hi(unsigned w) { return __uint_as_float(w & 0xffff0000u); }
__device__ __forceinline__ float bf1(bf16_t b) { return __uint_as_float(((unsigned)b) << 16); }
__device__ __forceinline__ float wave_sum(float v) {
#pragma unroll
    for (int o = 32; o >= 1; o >>= 1) v += __shfl_xor(v, o);
    return v;
}
__device__ __forceinline__ float res_dec_lo(unsigned hw, unsigned nw, int k) { return __uint_as_float(((hw << 16) | 0x800u) + ((unsigned)__builtin_amdgcn_sbfe((int)nw, 4 * k, 4) << 12)); }
__device__ __forceinline__ float res_dec_hi(unsigned hw, unsigned nw, int k) { return __uint_as_float(((hw & 0xffff0000u) | 0x800u) + ((unsigned)__builtin_amdgcn_sbfe((int)nw, 4 * k, 4) << 12)); }
__device__ __forceinline__ void res_dec8(const u32x4 h, const unsigned n, float (&v)[8]) {
    v[0] = res_dec_lo(h.x, n, 0); v[1] = res_dec_hi(h.x, n, 1); v[2] = res_dec_lo(h.y, n, 2); v[3] = res_dec_hi(h.y, n, 3);
    v[4] = res_dec_lo(h.z, n, 4); v[5] = res_dec_hi(h.z, n, 5); v[6] = res_dec_lo(h.w, n, 6); v[7] = res_dec_hi(h.w, n, 7);
}
__device__ __forceinline__ unsigned res_hb2(float a, float b) { return __builtin_amdgcn_perm(__float_as_uint(b) + 0x8000u, __float_as_uint(a) + 0x8000u, 0x07060302u); }
__device__ __forceinline__ unsigned res_nib(float a, int k) { return ((__float_as_uint(a) >> 12) & 0xfu) << (4 * k); }
__device__ __forceinline__ unsigned res_n4(float a, float b, float c, float d) { return res_nib(a, 0) | res_nib(b, 1) | res_nib(c, 2) | res_nib(d, 3); }
__device__ __forceinline__ unsigned res_n8(const float (&o)[8]) { return res_n4(o[0], o[1], o[2], o[3]) | (res_n4(o[4], o[5], o[6], o[7]) << 16); }
__device__ __forceinline__ int otid(int wv) { int l; asm volatile("v_mbcnt_lo_u32_b32 %0, -1, 0\n\tv_mbcnt_hi_u32_b32 %0, -1, %0" : "=v"(l)); return wv * 64 + l; }
__device__ __forceinline__ int obid() { int t = blockIdx.x; asm volatile("" : "+s"(t)); return t; }
__device__ __forceinline__ int ogrid() { int t = gridDim.x; asm volatile("" : "+s"(t)); return t; }
__device__ __forceinline__ float fast_sigmoid(float x) { return __builtin_amdgcn_rcpf(1.0f + __expf(-x)); }

namespace pg8 {
constexpr int BM = 256, BK = 64, HALF = 128, HTB = HALF * BK * 2, STAGE_BYTES = 8 * HTB, NXCD = 8, WGM = 8;
__device__ __forceinline__ int lds_byte(int r, int c) { const int st = (r >> 4) * 2 + (c >> 5), rr = r & 15, cc = c & 31, ob = rr * 64 + cc * 2; return st * 1024 + (ob ^ (((ob >> 9) & 1) << 5)); }
__device__ __forceinline__ void stage_rc(int b, int& R, int& C) { const int st = b / 1024, sb = b % 1024, swz = sb ^ (((sb >> 9) & 1) << 5); R = (st >> 1) * 16 + swz / 64; C = (st & 1) * 32 + (swz % 64) / 2; }
__device__ __forceinline__ int perm32(int rho) { const int n = rho >> 4, i = rho & 15; return 8 * (i >> 2) + 4 * n + (i & 3); }
struct Unit { int pm, pn; };
struct Gemm { const bf16_t* A; const bf16_t* Bt; int M, N, K, lda, akoff; };
struct StaticOrder {
    int nM, nN, nwg, G, c;
    __device__ void init(int M, int N, int G_, int c_) { nM = M / BM; nN = N / BM; nwg = nM * nN; G = G_; c = c_; }
    __device__ bool next(int i, Unit& u) const {
        const long L = (long)i * G + c; if (L >= nwg) return false;
        int wgid = (int)L; { const int q = nwg / NXCD, r = nwg % NXCD, xcd = wgid % NXCD, off = wgid / NXCD; wgid = (xcd < r ? xcd * (q + 1) : r * (q + 1) + (xcd - r) * q) + off; }
        const int nig = WGM * nN, gid = wgid / nig, fm = gid * WGM, gsz = (nM - fm) < WGM ? (nM - fm) : WGM;
        u.pm = fm + ((wgid % nig) % gsz); u.pn = (wgid % nig) / gsz; return true;
    }
};

template <class Epi>
__device__ __forceinline__ void gemm_phase(LAS unsigned char* lds, const Gemm g, const StaticOrder& S, const Epi& E, const int wv) {
    const int tid = otid(wv), wid = __builtin_amdgcn_readfirstlane(tid >> 6), lane = tid & 63, wr = wid >> 2, wc = wid & 3, fr = lane & 15, fq = lane >> 4;
    const int K = g.K, nt = K / BK, lda = g.lda;
    unsigned voffA[2], voffB[2];
#pragma unroll
    for (int i = 0; i < 2; ++i) { int R, C; stage_rc(tid * 16 + i * 8192, R, C); const int Rb = Epi::PERM ? ((R & ~31) + perm32(R & 31)) : R;
        voffA[i] = (unsigned)(R * lda + C) * 2u; voffB[i] = (unsigned)(Rb * K + C) * 2u; }
    const size_t kstep = (size_t)(BK * 2);
    const size_t hstepA = (size_t)HALF * lda * 2, hstepB = (size_t)HALF * K * 2;
    const size_t tstepA = g.akoff < 0 ? 0 : 2 * hstepA, tstepB = g.akoff < 0 ? 0 : 2 * hstepB;
    const size_t akoffb = g.akoff < 0 ? 0 : (size_t)g.akoff * 2;
    const unsigned ldsw = (unsigned)wid * 1024u;
    const int aoff = lds_byte(wr * 64 + fr, fq * 8), boff = lds_byte(wc * 32 + fr, fq * 8);
#define PG8_SA(b, h) (((b) * 2 + (h)) * HTB)
#define PG8_SB(b, h) ((4 + (b) * 2 + (h)) * HTB)
#define PG8_STAGE(bufoff, gbase, voff) do { _Pragma("unroll") for (int _i = 0; _i < 2; ++_i) \
        __builtin_amdgcn_global_load_lds((const unsigned*)((const char*)(gbase) + (voff)[_i]), (LAS unsigned*)(lds + (bufoff) + ldsw + _i * 8192), 16, 0, 0); } while (0)
#define PG8_LDA(dst, b, h) do { _Pragma("unroll") for (int m = 0; m < 4; ++m) _Pragma("unroll") for (int k = 0; k < 2; ++k) dst[m][k] = *(const LAS bf16x8*)(lds + PG8_SA(b, h) + aoff + m * 2048 + k * 1024); } while (0)
#define PG8_LDB(dst, b, h) do { _Pragma("unroll") for (int n = 0; n < 2; ++n) _Pragma("unroll") for (int k = 0; k < 2; ++k) dst[n][k] = *(const LAS bf16x8*)(lds + PG8_SB(b, h) + boff + n * 2048 + k * 1024); } while (0)
#define PG8_MMA(ai, bj, At, Bt) do { __builtin_amdgcn_s_setprio(1); _Pragma("unroll") for (int m = 0; m < 4; ++m) _Pragma("unroll") for (int n = 0; n < 2; ++n) _Pragma("unroll") for (int k = 0; k < 2; ++k) \
        acc[ai][bj][m][n] = __builtin_amdgcn_mfma_f32_16x16x32_bf16(Bt[n][k], At[m][k], acc[ai][bj][m][n], 0, 0, 0); __builtin_amdgcn_s_setprio(0); } while (0)
#define PG8_WAIT_V(n) asm volatile("s_waitcnt vmcnt(" #n ")" ::: "memory")
#define PG8_WAIT_L(n) asm volatile("s_waitcnt lgkmcnt(" #n ")" ::: "memory")
#define PG8_BAR __builtin_amdgcn_s_barrier()
#define PG8_SCHED __builtin_amdgcn_sched_barrier(0)
    Unit cur, nxt; int ui = 0;
    if (!S.next(0, cur)) return;
    f32x4 acc[2][2][4][2];
#pragma unroll
    for (int a = 0; a < 2; ++a)
#pragma unroll
        for (int b = 0; b < 2; ++b)
#pragma unroll
            for (int m = 0; m < 4; ++m)
#pragma unroll
                for (int n = 0; n < 2; ++n) acc[a][b][m][n] = (f32x4){0.f, 0.f, 0.f, 0.f};
    bf16x8 At[4][2], B0[2][2], B1[2][2];
    const char* cA = (const char*)g.A + (size_t)cur.pm * tstepA + (size_t)cur.pn * akoffb; const char* cB = (const char*)g.Bt + (size_t)cur.pn * tstepB;
    PG8_STAGE(PG8_SB(0, 0), cB, voffB); PG8_STAGE(PG8_SA(0, 0), cA, voffA); PG8_STAGE(PG8_SB(0, 1), cB + hstepB, voffB); PG8_STAGE(PG8_SA(0, 1), cA + hstepA, voffA);
    if (wr == 1) PG8_BAR;
    PG8_WAIT_V(4); PG8_BAR;
    PG8_STAGE(PG8_SB(1, 0), cB + kstep, voffB); PG8_STAGE(PG8_SA(1, 0), cA + kstep, voffA); PG8_STAGE(PG8_SB(1, 1), cB + hstepB + kstep, voffB);
    PG8_WAIT_V(6); PG8_BAR;
    for (;;) {
        const bool has_next = S.next(ui + 1, nxt);
        const char* nA = has_next ? (const char*)g.A + (size_t)nxt.pm * tstepA + (size_t)nxt.pn * akoffb : cA; const char* nB = has_next ? (const char*)g.Bt + (size_t)nxt.pn * tstepB : cB;
        for (int t = 0; t < nt; t += 2) {
            const bool last = (t == nt - 2);
            const char* a1 = cA + (size_t)(t + 1) * kstep;
            const char* a2 = last ? nA : cA + (size_t)(t + 2) * kstep; const char* b2 = last ? nB : cB + (size_t)(t + 2) * kstep;
            const char* a3 = a2 + kstep; const char* b3 = b2 + kstep;
            if (last && E.wants_rstd() && wid < 4)
                __builtin_amdgcn_global_load_lds((const unsigned*)(E.rs_ptr() + cur.pm * 256 + tid), (LAS unsigned*)(lds + STAGE_BYTES + 64 + wid * 256), 4, 0, 0);
            PG8_LDB(B0, 0, 0); PG8_SCHED; PG8_LDA(At, 0, 0); PG8_STAGE(PG8_SA(1, 1), a1 + hstepA, voffA);
            PG8_WAIT_L(8); PG8_BAR; PG8_WAIT_L(0); PG8_MMA(0, 0, At, B0); PG8_BAR; PG8_SCHED;
            PG8_LDB(B1, 0, 1); PG8_STAGE(PG8_SB(0, 0), b2, voffB);
            PG8_BAR; PG8_WAIT_L(0); PG8_MMA(0, 1, At, B1); PG8_BAR;
            PG8_LDA(At, 0, 1); PG8_STAGE(PG8_SA(0, 0), a2, voffA);
            PG8_BAR; PG8_WAIT_L(0); PG8_MMA(1, 0, At, B0); PG8_BAR; PG8_SCHED;
            PG8_STAGE(PG8_SB(0, 1), b2 + hstepB, voffB);
            PG8_WAIT_V(6); PG8_BAR; PG8_MMA(1, 1, At, B1); PG8_BAR;
            PG8_LDB(B0, 1, 0); PG8_SCHED; PG8_LDA(At, 1, 0); PG8_STAGE(PG8_SA(0, 1), a2 + hstepA, voffA);
            PG8_WAIT_L(8); PG8_BAR; PG8_WAIT_L(0); PG8_MMA(0, 0, At, B0); PG8_BAR; PG8_SCHED;
            PG8_LDB(B1, 1, 1); PG8_STAGE(PG8_SB(1, 0), b3, voffB);
            PG8_BAR; PG8_WAIT_L(0); PG8_MMA(0, 1, At, B1); PG8_BAR;
            PG8_LDA(At, 1, 1); PG8_STAGE(PG8_SA(1, 0), a3, voffA);
            PG8_BAR; PG8_WAIT_L(0); PG8_MMA(1, 0, At, B0); PG8_BAR; PG8_SCHED;
            PG8_STAGE(PG8_SB(1, 1), b3 + hstepB, voffB);
            PG8_WAIT_V(6); PG8_BAR; PG8_MMA(1, 1, At, B1); PG8_BAR;
        }
        { int t2 = tid; asm volatile("" : "+v"(t2));
          const int l2 = t2 & 63; E(acc, cur, wr, wc, l2 & 15, l2 >> 4); }
        if (!has_next) break;
#pragma unroll
        for (int a = 0; a < 2; ++a)
#pragma unroll
            for (int b = 0; b < 2; ++b)
#pragma unroll
                for (int m = 0; m < 4; ++m)
#pragma unroll
                    for (int n = 0; n < 2; ++n) acc[a][b][m][n] = (f32x4){0.f, 0.f, 0.f, 0.f};
        cur = nxt; cA = nA; cB = nB; ++ui;
    }
    PG8_WAIT_V(0);
    if (wr == 0) PG8_BAR;
    PG8_BAR;
#undef PG8_SA
#undef PG8_SB
#undef PG8_STAGE
#undef PG8_LDA
#undef PG8_LDB
#undef PG8_MMA
#undef PG8_WAIT_V
#undef PG8_WAIT_L
#undef PG8_BAR
#undef PG8_SCHED
}
}

struct EP {
    bf16_t* o0; bf16_t* o1; const void* q2; void* q3; void* q4; const void* q5;
    int ld0, ld1, split, mode, type; float inv_dim;
};
#define EP_RS(p) ((const float*)(p).q2)
#define EP_SSQ0(p) ((float*)(p).q3)
#define EP_SSQ1(p) ((float*)(p).q4)
#define EP_B3(p) ((unsigned char*)(p).q2)
#define EP_FOUT(p) ((float*)(p).q4)
#define EP_XS(p) ((const bf16_t*)(p).q2)
#define EP_BA(p) ((const float*)(p).q3)
#define EP_BX(p) ((const float*)(p).q4)
#define EP_CL(p) ((const float*)(p).q5)
__device__ __forceinline__ void load_rstd(const EP& p, int row0, float (&rstd)[2][4]) {
#pragma unroll
    for (int ai = 0; ai < 2; ++ai)
#pragma unroll
        for (int m = 0; m < 4; ++m) rstd[ai][m] = __builtin_amdgcn_rsqf(EP_RS(p)[row0 + ai * 128 + m * 16] * p.inv_dim + EPS);
}
__device__ __forceinline__ u32x4 pack8(const f32x4 a, const f32x4 b) { u32x4 w; w.x = pk_bf16(a[0], a[1]); w.y = pk_bf16(a[2], a[3]); w.z = pk_bf16(b[0], b[1]); w.w = pk_bf16(b[2], b[3]); return w; }

struct EpiAll {
    static constexpr bool PERM = true;
    EP p; LAS const float* rl;
    __device__ __forceinline__ bool wants_rstd() const { return p.type < 2; }
    __device__ __forceinline__ const float* rs_ptr() const { return EP_RS(p); }
    __device__ __forceinline__ void lds_rstd(int wr, int fr, float (&rstd)[2][4]) const {
#pragma unroll
        for (int ai = 0; ai < 2; ++ai)
#pragma unroll
            for (int m = 0; m < 4; ++m) rstd[ai][m] = __builtin_amdgcn_rsqf(rl[wr * 64 + fr + ai * 128 + m * 16] * p.inv_dim + EPS);
    }
    __device__ __forceinline__ void operator()(f32x4 (&acc)[2][2][4][2], const pg8::Unit& u, int wr, int wc, int fr, int fq) const {
        const int row0 = u.pm * 256 + wr * 64 + fr;
        if (p.mode == 99) return;
        if (p.type == 0) {
            float rstd[2][4]; lds_rstd(wr, fr, rstd);
            if (u.pn < p.split) {
                const int col = u.pn * 128 + wc * 32 + fq * 8;
#pragma unroll
                for (int ai = 0; ai < 2; ++ai)
#pragma unroll
                    for (int m = 0; m < 4; ++m) {
                        const float r = rstd[ai][m];
                        f32x4 v[2];
#pragma unroll
                        for (int n = 0; n < 2; ++n) {
                            const f32x4 g = acc[ai][0][m][n] * r, uu = acc[ai][1][m][n] * r;
                            if (p.mode == 0) {
#pragma unroll
                                for (int j = 0; j < 4; ++j) v[n][j] = g[j] * fast_sigmoid(g[j]) * uu[j];
                            } else v[n] = g * uu;
                        }
                        *(u32x4*)(p.o0 + (size_t)(row0 + ai * 128 + m * 16) * p.ld0 + col) = pack8(v[0], v[1]);
                    }
            } else {
                const int col = (u.pn - p.split) * 256 + wc * 32 + fq * 8;
#pragma unroll
                for (int ai = 0; ai < 2; ++ai)
#pragma unroll
                    for (int m = 0; m < 4; ++m) {
                        const float r = rstd[ai][m];
#pragma unroll
                        for (int bj = 0; bj < 2; ++bj)
                            *(u32x4*)(p.o1 + (size_t)(row0 + ai * 128 + m * 16) * p.ld1 + col + bj * 128) = pack8(acc[ai][bj][m][0] * r, acc[ai][bj][m][1] * r);
                    }
            }
        } else if (p.type == 1 && p.mode == 3) {
            float rstd[2][4]; lds_rstd(wr, fr, rstd);
            const int col = u.pn * 256 + wc * 32 + fq * 8;
            LAS float* P = (LAS float*)(rl + 256);
#pragma unroll
            for (int ai = 0; ai < 2; ++ai)
#pragma unroll
                for (int m = 0; m < 4; ++m) {
                    const float r = rstd[ai][m]; const int rl_ = ai * 128 + wr * 64 + m * 16 + fr;
                    *(u32x4*)(p.o0 + (size_t)(u.pm * 256 + rl_) * p.ld0 + col + 128) = pack8(acc[ai][1][m][0] * r, acc[ai][1][m][1] * r);
                    const f32x4 v0 = acc[ai][0][m][0] * r, v1 = acc[ai][0][m][1] * r;
                    float sq = (v0[0] * v0[0] + v0[1] * v0[1]) + (v0[2] * v0[2] + v0[3] * v0[3]) + (v1[0] * v1[0] + v1[1] * v1[1]) + (v1[2] * v1[2] + v1[3] * v1[3]);
                    sq += __shfl_xor(sq, 16); sq += __shfl_xor(sq, 32);
                    if (fq == 0) P[rl_ * 4 + wc] = sq;
                }
            asm volatile("s_waitcnt lgkmcnt(0)" ::: "memory"); __builtin_amdgcn_s_barrier(); asm volatile("" ::: "memory");
            const f32x4 g0 = *(const f32x4*)(EP_CL(p) + wc * 32 + fq * 8), g1 = *(const f32x4*)(EP_CL(p) + wc * 32 + fq * 8 + 4);
#pragma unroll
            for (int ai = 0; ai < 2; ++ai)
#pragma unroll
                for (int m = 0; m < 4; ++m) {
                    const int rl_ = ai * 128 + wr * 64 + m * 16 + fr;
                    const f32x4 pp = *(LAS f32x4*)(P + rl_ * 4);
                    const float rk = __builtin_amdgcn_rsqf(((pp[0] + pp[1]) + (pp[2] + pp[3])) * (1.0f / 128.0f) + EPS) * rstd[ai][m];
                    *(u32x4*)(p.o0 + (size_t)(u.pm * 256 + rl_) * p.ld0 + col) = pack8(acc[ai][0][m][0] * rk * g0, acc[ai][0][m][1] * rk * g1);
                }
        } else if (p.type == 1) {
            float rstd[2][4]; lds_rstd(wr, fr, rstd);
            const bool second = u.pn >= p.split;
            bf16_t* ob = second ? p.o1 : p.o0; const int ld = second ? p.ld1 : p.ld0;
            const int col = (second ? u.pn - p.split : u.pn) * 256 + wc * 32 + fq * 8;
            const bool gelu = (p.mode == 1) && !second;
#pragma unroll
            for (int ai = 0; ai < 2; ++ai)
#pragma unroll
                for (int m = 0; m < 4; ++m) {
                    const float r = rstd[ai][m]; const int row = row0 + ai * 128 + m * 16;
                    float sq[2];
#pragma unroll
                    for (int bj = 0; bj < 2; ++bj) {
                        f32x4 v0 = acc[ai][bj][m][0] * r, v1 = acc[ai][bj][m][1] * r;
                        if (gelu) {
#pragma unroll
                            for (int j = 0; j < 4; ++j) {
                                const float a = v0[j], b = v1[j];
                                v0[j] = a * fast_sigmoid(1.5957691216f * (a + 0.044715f * a * a * a));
                                v1[j] = b * fast_sigmoid(1.5957691216f * (b + 0.044715f * b * b * b));
                            }
                        }
                        sq[bj] = (v0[0] * v0[0] + v0[1] * v0[1]) + (v0[2] * v0[2] + v0[3] * v0[3]) + (v1[0] * v1[0] + v1[1] * v1[1]) + (v1[2] * v1[2] + v1[3] * v1[3]);
                        *(u32x4*)(ob + (size_t)row * ld + col + bj * 128) = pack8(v0, v1);
                    }
                    if (p.mode == 2) {
                        float s = (u.pn == 2) ? sq[0] : sq[0] + sq[1];
                        s += __shfl_xor(s, 16); s += __shfl_xor(s, 32);
                        if (fq == 0) atomicAdd((u.pn == 0 ? EP_SSQ0(p) : EP_SSQ1(p)) + row, s);
                    }
                }
        } else if (p.type == 2) {
            const int col0 = u.pn * 256 + wc * 32 + 8 * fq;
#pragma unroll
            for (int ai = 0; ai < 2; ++ai) {
                u32x4 rh[4][2]; unsigned rb[4][2];
#pragma unroll
                for (int m = 0; m < 4; ++m)
#pragma unroll
                    for (int bj = 0; bj < 2; ++bj) {
                        const size_t off = (size_t)(row0 + ai * 128 + m * 16) * DM + col0 + bj * 128;
                        rh[m][bj] = *(const u32x4*)(p.o0 + off); rb[m][bj] = *(const unsigned*)(EP_B3(p) + (off >> 1));
                    }
                asm volatile("" ::: "memory");
#pragma unroll
                for (int m = 0; m < 4; ++m) {
                    const int row = row0 + ai * 128 + m * 16; const size_t off = (size_t)row * DM + col0;
                    float s = 0.f;
#pragma unroll
                    for (int bj = 0; bj < 2; ++bj) {
                        float o[8]; res_dec8(rh[m][bj], rb[m][bj], o);
#pragma unroll
                        for (int j = 0; j < 4; ++j) { o[j] += acc[ai][bj][m][0][j]; o[4 + j] += acc[ai][bj][m][1][j]; }
                        if (p.mode == 1) {
                            *(f32x4*)(EP_FOUT(p) + off + bj * 128) = (f32x4){o[0], o[1], o[2], o[3]}; *(f32x4*)(EP_FOUT(p) + off + bj * 128 + 4) = (f32x4){o[4], o[5], o[6], o[7]};
                        } else {
                            u32x4 hw; hw.x = res_hb2(o[0], o[1]); hw.y = res_hb2(o[2], o[3]); hw.z = res_hb2(o[4], o[5]); hw.w = res_hb2(o[6], o[7]);
                            *(u32x4*)(p.o0 + off + bj * 128) = hw; *(unsigned*)(EP_B3(p) + ((off + bj * 128) >> 1)) = res_n8(o);
                            s += (o[0] * o[0] + o[1] * o[1]) + (o[2] * o[2] + o[3] * o[3]) + (o[4] * o[4] + o[5] * o[5]) + (o[6] * o[6] + o[7] * o[7]);
                        }
                    }
                    if (p.mode != 1) {
                        s += __shfl_xor(s, 16); s += __shfl_xor(s, 32);
                        if (fq == 0) atomicAdd(EP_SSQ0(p) + row, s);
                    }
                }
                asm volatile("" ::: "memory");
            }
        } else {
            const int col = u.pn * 128 + wc * 32 + fq * 8;
#pragma unroll
            for (int n = 0; n < 2; ++n) {
                const f32x4 ba = *(const f32x4*)(EP_BA(p) + col + 4 * n), bx = *(const f32x4*)(EP_BX(p) + col + 4 * n), cl = *(const f32x4*)(EP_CL(p) + col + 4 * n);
                u32x2 xw[2][4];
#pragma unroll
                for (int ai = 0; ai < 2; ++ai)
#pragma unroll
                    for (int m = 0; m < 4; ++m) xw[ai][m] = *(const u32x2*)(EP_XS(p) + (size_t)(row0 + ai * 128 + m * 16) * LW + col + 4 * n);
                asm volatile("" ::: "memory");
#pragma unroll
                for (int ai = 0; ai < 2; ++ai)
#pragma unroll
                    for (int m = 0; m < 4; ++m) {
                        const size_t off = (size_t)(row0 + ai * 128 + m * 16) * LW + col + 4 * n;
                        const float xv[4] = {bf_lo(xw[ai][m].x), bf_hi(xw[ai][m].x), bf_lo(xw[ai][m].y), bf_hi(xw[ai][m].y)};
                        f32x4 la, bb;
#pragma unroll
                        for (int j = 0; j < 4; ++j) {
                            const float r = fast_sigmoid(acc[ai][0][m][n][j] + ba[j]), ig = fast_sigmoid(acc[ai][1][m][n][j] + bx[j]);
                            const float l = r * cl[j];
                            const float a2 = __builtin_amdgcn_exp2f(2.0f * l);
                            la[j] = l; bb[j] = __builtin_amdgcn_sqrtf(fmaxf(1.0f - a2, 0.f)) * ig * xv[j];
                        }
                        u32x2 w0, w1; w0.x = pk_bf16(la[0], la[1]); w0.y = pk_bf16(la[2], la[3]); w1.x = pk_bf16(bb[0], bb[1]); w1.y = pk_bf16(bb[2], bb[3]);
                        *(u32x2*)(p.o0 + off) = w0;
                        *(u32x2*)(p.o1 + off) = w1;
                    }
                asm volatile("" ::: "memory");
            }
        }
    }
};

struct Job { const float* src; int K, ldsrc; bf16_t* dst; int ndst; const float* gain; int perm; };
__device__ __forceinline__ int src_col(int perm, int n0, int nsrc) {
    const int tile = n0 >> 8, r = n0 & 255;
    if (perm == 1) return r < 128 ? 128 * tile + r : DFF + 128 * tile + (r - 128);
    if (perm == 2) return tile < 8 ? (r < 128 ? 1024 + 128 * tile + r : 2048 + 128 * tile + (r - 128)) : (tile - 8) * 256 + r;
    if (perm == 3) return n0 < 256 ? 384 + n0 : (n0 < 640 ? n0 - 256 : (n0 == 640 ? 640 : -1));
    return n0 < nsrc ? n0 : -1;
}
__device__ __forceinline__ void get_job(KA ka, int j, Job& jb) {
    unsigned char* const ws = P_WS;
    const float* mixn = (const float*)P_IN(2); const float* ffnn = (const float*)P_IN(25);
        if (j < 2) { jb = Job{(const float*)P_IN(3) + (size_t)j * DM * 3072, DM, 3072, (bf16_t*)(ws + OFF_WCIN) + (size_t)j * 3072 * DM, 3072, mixn + (j == 0 ? 0 : 3) * DM, 2}; }
    else if (j < 4) { const int i = j - 2; jb = Job{(const float*)P_IN(5) + (size_t)i * DM * DM, DM, DM, (bf16_t*)(ws + OFF_WCOUT) + (size_t)i * DM * DM, DM, nullptr, 0}; }
    else if (j == 4) jb = Job{(const float*)P_IN(6), DM, 2 * LW, (bf16_t*)(ws + OFF_WLIN), 2 * LW, mixn + 1 * DM, 0};
    else if (j == 5) jb = Job{(const float*)P_IN(14), LW, DM, (bf16_t*)(ws + OFF_WLOUT), DM, nullptr, 0};
    else if (j == 6) jb = Job{(const float*)P_IN(15), DM, 704, (bf16_t*)(ws + OFF_WMD), 768, mixn + 2 * DM, 3};
    else if (j == 7) jb = Job{(const float*)P_IN(18), 384, 1536, (bf16_t*)(ws + OFF_WUQ), 1536, (const float*)P_IN(16), 0};
    else if (j == 8) jb = Job{(const float*)P_IN(19), 256, 2048, (bf16_t*)(ws + OFF_WUKV), 2048, (const float*)P_IN(17), 0};
    else if (j == 9) jb = Job{(const float*)P_IN(24), DM, DM, (bf16_t*)(ws + OFF_WO), DM, nullptr, 0};
    else if (j < 14) { const int i = j - 10; jb = Job{(const float*)P_IN(26) + (size_t)i * DM * 2 * DFF, DM, 2 * DFF, (bf16_t*)(ws + OFF_WGU) + (size_t)i * 2 * DFF * DM, 2 * DFF, ffnn + i * DM, 1}; }
    else { const int i = j - 14; jb = Job{(const float*)P_IN(27) + (size_t)i * DFF * DM, DFF, DM, (bf16_t*)(ws + OFF_WDN) + (size_t)i * DM * DFF, DM, nullptr, 0}; }
}
__device__ void phase0(KA ka, LAS unsigned char* lds, const int wv) {
    unsigned char* const ws = P_WS;
    const int tid = otid(wv), G = ogrid(), bx = obid(), lane = tid & 63, wid = tid >> 6;
    { float* z = (float*)(ws + OFF_SSQ) + T; const int n = 10 * T; for (int i = bx * NTHREADS + tid; i < n; i += G * NTHREADS) z[i] = 0.f; }
    if (bx == 0) { const float* lam = (const float*)P_IN(13); float* cl = (float*)(ws + OFF_CL); for (int c = tid; c < LW; c += NTHREADS) cl[c] = -8.0f * 1.4426950408889634f * log1pf(expf(-lam[c])); }
    { bf16_t* wlg = (bf16_t*)(ws + OFF_WLG); const float* wa = (const float*)P_IN(9); const float* wx = (const float*)P_IN(11);
      for (int i = bx * NTHREADS + tid; i < 2560 * 128; i += G * NTHREADS) { const int k = i & 127, row = i >> 7, n = row >> 8, gsel = (row >> 7) & 1, e = row & 127;
          const float v = (gsel ? wx : wa)[((size_t)n * 128 + k) * 128 + e];
          wlg[i] = (bf16_t)(pk_bf16(v, 0.f) & 0xffffu); } }
    { const float* x = (const float*)P_IN(0); bf16_t* hb = (bf16_t*)(ws + OFF_HB); unsigned char* b3 = ws + OFF_B3; float* ssq = (float*)(ws + OFF_SSQ);
      for (int row = bx * 8 + wid; row < T; row += G * 8) { float s = 0.f;
#pragma unroll
          for (int i = 0; i < 4; ++i) { const size_t o = (size_t)row * DM + i * 256 + lane * 4; const f32x4 v = *(const f32x4*)(x + o); s += (v[0] * v[0] + v[1] * v[1]) + (v[2] * v[2] + v[3] * v[3]);
              u32x2 w; w.x = res_hb2(v[0], v[1]); w.y = res_hb2(v[2], v[3]); *(u32x2*)(hb + o) = w; *(unsigned short*)(b3 + (o >> 1)) = (unsigned short)res_n4(v[0], v[1], v[2], v[3]); }
          s = wave_sum(s); if (lane == 0) ssq[row] = s; } }
    LAS float* tile = (LAS float*)lds;
    int jstart[19]; { int acc_ = 0;
#pragma unroll
        for (int j = 0; j < 18; ++j) { Job jb; get_job(ka, j, jb); jstart[j] = acc_; acc_ += (jb.K / 64) * (jb.ndst / 256); } jstart[18] = acc_; }
    for (int t = bx; t < jstart[18]; t += G) {
        int j = 0;
#pragma unroll
        for (int q = 1; q < 18; ++q) j += (t >= jstart[q]) ? 1 : 0;
        Job jb; get_job(ka, j, jb);
        const int tl = t - jstart[j], tk = jb.K / 64, k0 = (tl % tk) * 64, n0 = (tl / tk) * 256;
        const int sc = src_col(jb.perm, n0 + (lane >> 4) * 64, jb.ldsrc);
        f32x4 v[8];
#pragma unroll
        for (int i = 0; i < 8; ++i) v[i] = sc >= 0 ? *(const f32x4*)(jb.src + (size_t)(k0 + wid * 8 + i) * jb.ldsrc + sc + (lane & 15) * 4) : (f32x4){0.f, 0.f, 0.f, 0.f};
        __syncthreads();
#pragma unroll
        for (int i = 0; i < 8; ++i) *(LAS f32x4*)(tile + (wid * 8 + i) * 260 + ((lane * 4) ^ (wid << 2))) = v[i];
        __syncthreads();
#pragma unroll
        for (int r = 0; r < 4; ++r) {
            const int item = tid + 512 * r, n = item >> 3, kci = item & 7, kc = kci * 8; float x[8];
#pragma unroll
            for (int i = 0; i < 8; ++i) x[i] = tile[(kc + i) * 260 + (n ^ (kci << 2))] * (jb.gain ? jb.gain[k0 + kc + i] : 1.0f);
            u32x4 w; w.x = pk_bf16(x[0], x[1]); w.y = pk_bf16(x[2], x[3]); w.z = pk_bf16(x[4], x[5]); w.w = pk_bf16(x[6], x[7]);
            *(u32x4*)(jb.dst + (size_t)(n0 + n) * jb.K + k0 + kc) = w;
        }
    }
    __syncthreads();
}

__device__ void conv3_phase(KA ka, const float* cw, const int wv) {
    unsigned char* const ws = P_WS;
    const bf16_t* U = (const bf16_t*)(ws + OFF_U); const bf16_t* BG = (const bf16_t*)(ws + OFF_BG); bf16_t* Y = (bf16_t*)(ws + OFF_Y);
    const int nitem = (T / 16) * 128;
    const int gstride = ogrid() * NTHREADS;
    for (int id = obid() * NTHREADS + otid(wv); id < nitem; id += gstride) {
        const int cgp = id & 127, rc = id >> 7, c0 = cgp * 8, t0 = rc * 16;
        float w0[8], w1[8], w2[8], um2[8], um1[8];
#pragma unroll
        for (int j = 0; j < 8; ++j) { w0[j] = cw[c0 + j]; w1[j] = cw[DM + c0 + j]; w2[j] = cw[2 * DM + c0 + j]; um2[j] = 0.f; um1[j] = 0.f; }
        if ((t0 & (SEQ - 1)) != 0) {
            const u32x4 a = *(const u32x4*)(U + (size_t)(t0 - 2) * DM + c0), b = *(const u32x4*)(U + (size_t)(t0 - 1) * DM + c0);
            um2[0] = bf_lo(a.x); um2[1] = bf_hi(a.x); um2[2] = bf_lo(a.y); um2[3] = bf_hi(a.y); um2[4] = bf_lo(a.z); um2[5] = bf_hi(a.z); um2[6] = bf_lo(a.w); um2[7] = bf_hi(a.w);
            um1[0] = bf_lo(b.x); um1[1] = bf_hi(b.x); um1[2] = bf_lo(b.y); um1[3] = bf_hi(b.y); um1[4] = bf_lo(b.z); um1[5] = bf_hi(b.z); um1[6] = bf_lo(b.w); um1[7] = bf_hi(b.w);
        }
#pragma unroll 4
        for (int r = 0; r < 16; ++r) {
            const size_t off = (size_t)(t0 + r) * DM + c0;
            const u32x4 a = *(const u32x4*)(U + off), g = *(const u32x4*)(BG + off);
            const float uc[8] = {bf_lo(a.x), bf_hi(a.x), bf_lo(a.y), bf_hi(a.y), bf_lo(a.z), bf_hi(a.z), bf_lo(a.w), bf_hi(a.w)};
            const float gv[8] = {bf_lo(g.x), bf_hi(g.x), bf_lo(g.y), bf_hi(g.y), bf_lo(g.z), bf_hi(g.z), bf_lo(g.w), bf_hi(g.w)};
            float y[8];
#pragma unroll
            for (int j = 0; j < 8; ++j) { y[j] = gv[j] * (w0[j] * um2[j] + w1[j] * um1[j] + w2[j] * uc[j]); um2[j] = um1[j]; um1[j] = uc[j]; }
            u32x4 w; w.x = pk_bf16(y[0], y[1]); w.y = pk_bf16(y[2], y[3]); w.z = pk_bf16(y[4], y[5]); w.w = pk_bf16(y[6], y[7]);
            *(u32x4*)(Y + off) = w;
        }
    }
}
__device__ void conv4_phase(KA ka, const int wv) {
    unsigned char* const ws = P_WS;
    const bf16_t* R = (const bf16_t*)(ws + OFF_RECB); bf16_t* XS = (bf16_t*)(ws + OFF_XS);
    const float* cw = (const float*)P_IN(7); const float* cb = (const float*)P_IN(8);
    const int nitem = (T / 16) * 160;
    const int gstride = ogrid() * NTHREADS;
    for (int id = obid() * NTHREADS + otid(wv); id < nitem; id += gstride) {
        const int cgp = id % 160, rc = id / 160, c0 = cgp * 8, t0 = rc * 16;
        float w0[8], w1[8], w2[8], w3[8], bs[8], x3[8], x2[8], x1[8];
#pragma unroll
        for (int j = 0; j < 8; ++j) { w0[j] = cw[c0 + j]; w1[j] = cw[LW + c0 + j]; w2[j] = cw[2 * LW + c0 + j]; w3[j] = cw[3 * LW + c0 + j]; bs[j] = cb[c0 + j]; x3[j] = 0.f; x2[j] = 0.f; x1[j] = 0.f; }
        if ((t0 & (SEQ - 1)) != 0) {
            const u32x4 a = *(const u32x4*)(R + (size_t)(t0 - 3) * LW + c0), b = *(const u32x4*)(R + (size_t)(t0 - 2) * LW + c0), c = *(const u32x4*)(R + (size_t)(t0 - 1) * LW + c0);
            x3[0] = bf_lo(a.x); x3[1] = bf_hi(a.x); x3[2] = bf_lo(a.y); x3[3] = bf_hi(a.y); x3[4] = bf_lo(a.z); x3[5] = bf_hi(a.z); x3[6] = bf_lo(a.w); x3[7] = bf_hi(a.w);
            x2[0] = bf_lo(b.x); x2[1] = bf_hi(b.x); x2[2] = bf_lo(b.y); x2[3] = bf_hi(b.y); x2[4] = bf_lo(b.z); x2[5] = bf_hi(b.z); x2[6] = bf_lo(b.w); x2[7] = bf_hi(b.w);
            x1[0] = bf_lo(c.x); x1[1] = bf_hi(c.x); x1[2] = bf_lo(c.y); x1[3] = bf_hi(c.y); x1[4] = bf_lo(c.z); x1[5] = bf_hi(c.z); x1[6] = bf_lo(c.w); x1[7] = bf_hi(c.w);
        }
#pragma unroll 4
        for (int r = 0; r < 16; ++r) {
            const size_t off = (size_t)(t0 + r) * LW + c0;
            const u32x4 a = *(const u32x4*)(R + off);
            const float xc[8] = {bf_lo(a.x), bf_hi(a.x), bf_lo(a.y), bf_hi(a.y), bf_lo(a.z), bf_hi(a.z), bf_lo(a.w), bf_hi(a.w)};
            float y[8];
#pragma unroll
            for (int j = 0; j < 8; ++j) { y[j] = bs[j] + w0[j] * x3[j] + w1[j] * x2[j] + w2[j] * x1[j] + w3[j] * xc[j]; x3[j] = x2[j]; x2[j] = x1[j]; x1[j] = xc[j]; }
            u32x4 w; w.x = pk_bf16(y[0], y[1]); w.y = pk_bf16(y[2], y[3]); w.z = pk_bf16(y[4], y[5]); w.w = pk_bf16(y[6], y[7]);
            *(u32x4*)(XS + off) = w;
        }
    }
}
__device__ __forceinline__ void unpack8(const u32x4 w, float (&v)[8]) { v[0] = bf_lo(w.x); v[1] = bf_hi(w.x); v[2] = bf_lo(w.y); v[3] = bf_hi(w.y); v[4] = bf_lo(w.z); v[5] = bf_hi(w.z); v[6] = bf_lo(w.w); v[7] = bf_hi(w.w); }
__device__ void scan1_phase(KA ka, const int wv) {
    unsigned char* const ws = P_WS;
    const bf16_t* LA = (const bf16_t*)P_OUT; const bf16_t* BB = (const bf16_t*)(ws + OFF_RECB);
    float* CA = (float*)(ws + OFF_CARRY); float* CH = CA + NBATCH * 64 * LW;
    const int nitem = NBATCH * 64 * 160;
    const int gstride = ogrid() * NTHREADS;
    for (int id = obid() * NTHREADS + otid(wv); id < nitem; id += gstride) {
        const int c8 = id % 160, bj = id / 160;
        const size_t base = (size_t)bj * 64 * LW + c8 * 8;
        float s[8], h[8];
#pragma unroll
        for (int k = 0; k < 8; ++k) { s[k] = 0.f; h[k] = 0.f; }
#pragma unroll 8
        for (int t = 0; t < 64; ++t) {
            float l[8], b[8]; unpack8(*(const u32x4*)(LA + base + (size_t)t * LW), l); unpack8(*(const u32x4*)(BB + base + (size_t)t * LW), b);
#pragma unroll
            for (int k = 0; k < 8; ++k) { s[k] += l[k]; h[k] = __builtin_amdgcn_exp2f(l[k]) * h[k] + b[k]; }
        }
        float* ca = CA + (size_t)bj * LW + c8 * 8; float* ch = CH + (size_t)bj * LW + c8 * 8;
        *(f32x4*)ca = (f32x4){s[0], s[1], s[2], s[3]}; *(f32x4*)(ca + 4) = (f32x4){s[4], s[5], s[6], s[7]};
        *(f32x4*)ch = (f32x4){h[0], h[1], h[2], h[3]}; *(f32x4*)(ch + 4) = (f32x4){h[4], h[5], h[6], h[7]};
    }
}
__device__ void scan2_phase(KA ka, const int wv) {
    unsigned char* const ws = P_WS;
    const bf16_t* LA = (const bf16_t*)P_OUT; const bf16_t* BB = (const bf16_t*)(ws + OFF_RECB); bf16_t* GT = (bf16_t*)(ws + OFF_GATE);
    const float* CA = (const float*)(ws + OFF_CARRY); const float* CH = CA + NBATCH * 64 * LW;
    const int nitem = NBATCH * 64 * 160;
    const int gstride = ogrid() * NTHREADS;
    for (int id = obid() * NTHREADS + otid(wv); id < nitem; id += gstride) {
        const int c8 = id % 160, bj = id / 160, j = bj & 63, b0 = bj - j;
        float h[8];
#pragma unroll
        for (int k = 0; k < 8; ++k) h[k] = 0.f;
        const float* ca = CA + (size_t)b0 * LW + c8 * 8; const float* ch = CH + (size_t)b0 * LW + c8 * 8;
#pragma unroll 8
        for (int jj = 0; jj < j; ++jj) {
            const f32x4 a0 = *(const f32x4*)(ca + (size_t)jj * LW), a1 = *(const f32x4*)(ca + (size_t)jj * LW + 4);
            const f32x4 h0 = *(const f32x4*)(ch + (size_t)jj * LW), h1 = *(const f32x4*)(ch + (size_t)jj * LW + 4);
#pragma unroll
            for (int k = 0; k < 4; ++k) { h[k] = __builtin_amdgcn_exp2f(a0[k]) * h[k] + h0[k]; h[4 + k] = __builtin_amdgcn_exp2f(a1[k]) * h[4 + k] + h1[k]; }
        }
        const size_t base = (size_t)bj * 64 * LW + c8 * 8;
#pragma unroll 8
        for (int t = 0; t < 64; ++t) {
            const size_t o = base + (size_t)t * LW;
            float l[8], b[8], g[8]; unpack8(*(const u32x4*)(LA + o), l); unpack8(*(const u32x4*)(BB + o), b); unpack8(*(const u32x4*)(GT + o), g);
#pragma unroll
            for (int k = 0; k < 8; ++k) { h[k] = __builtin_amdgcn_exp2f(l[k]) * h[k] + b[k]; g[k] *= h[k]; }
            u32x4 w; w.x = pk_bf16(g[0], g[1]); w.y = pk_bf16(g[2], g[3]); w.z = pk_bf16(g[4], g[5]); w.w = pk_bf16(g[6], g[7]);
            *(u32x4*)(GT + o) = w;
        }
    }
}
__device__ __forceinline__ float sum8(float v) { v += __shfl_xor(v, 1); v += __shfl_xor(v, 2); v += __shfl_xor(v, 4); return v; }
__device__ void krope_phase(KA ka, const int wv) {
    unsigned char* const ws = P_WS;
    const int tid = otid(wv), lane = tid & 63, wid = tid >> 6, G = ogrid(), bx = obid();
    bf16_t* KR = (bf16_t*)(ws + OFF_KR); const bf16_t* CB = (const bf16_t*)(ws + OFF_CBUF);
    const int* pos = (const int*)P_IN(1); const float* kr = (const float*)P_IN(23);
    const int j = lane & 7;
    float krg[8], ifq[8];
#pragma unroll
    for (int e = 0; e < 8; ++e) { krg[e] = kr[8 * j + e]; ifq[e] = exp2f(-(float)(8 * (j & 3) + e) * (13.287712379549449f / 32.0f)); }
    for (int t = (bx * 8 + wid) * 8 + (lane >> 3); t < T; t += G * 64) {
        const u32x4 kc = *(const u32x4*)(CB + (size_t)t * 768 + 640 + 8 * j);
        const float fp = (float)pos[t];
        float xk[8]; unpack8(kc, xk);
        float skr = 0.f;
#pragma unroll
        for (int e = 0; e < 8; ++e) skr += xk[e] * xk[e];
        skr = sum8(skr);
        const float rkr = rsqrtf(skr * (1.0f / 64.0f) + EPS);
        float ok[8];
#pragma unroll
        for (int e = 0; e < 8; ++e) {
            const float ang = fp * ifq[e];
            const float nrev = rintf(ang * 0.15915494309189535f);
            float rr = fmaf(-nrev, 6.2831854820251465f, ang); rr = fmaf(-nrev, -1.7484556000744883e-07f, rr);
            const float sn = __sinf(rr), cs = __cosf(rr);
            const float b = xk[e] * rkr * krg[e], pb = __shfl_xor(b, 4);
            ok[e] = j < 4 ? b * cs - pb * sn : b * cs + pb * sn;
        }
        u32x4 w; w.x = pk_bf16(ok[0], ok[1]); w.y = pk_bf16(ok[2], ok[3]); w.z = pk_bf16(ok[4], ok[5]); w.w = pk_bf16(ok[6], ok[7]);
        *(u32x4*)(KR + (size_t)t * 64 + 8 * j) = w;
    }
}

constexpr int KP = 400, VP = 320, KBUF = 64 * KP, VBUF = 64 * VP;
constexpr float THR_DEFER = 6.0f;
__device__ __forceinline__ int crow(int r, int hi) { return (r & 3) + 8 * (r >> 2) + 4 * hi; }
__device__ __forceinline__ float vmax3_first(float a, float b, float c) { float r; asm volatile("s_nop 7\n\ts_nop 7\n\ts_nop 3\n\tv_max3_f32 %0, %1, %2, %3" : "=v"(r) : "v"(a), "v"(b), "v"(c)); return r; }
__device__ __forceinline__ float vmax3(float a, float b, float c) { float r; asm("v_max3_f32 %0, %1, %2, %3" : "=v"(r) : "v"(a), "v"(b), "v"(c)); return r; }
__device__ void attn_phase(KA ka, LAS unsigned char* lds, const int wv) {
    unsigned char* const ws = P_WS;
    const int tid = otid(wv), lane = tid & 63, w = __builtin_amdgcn_readfirstlane(tid >> 6), G = ogrid(), bx = obid();
    const bf16_t* QB = (const bf16_t*)(ws + OFF_QB); const bf16_t* KVB = (const bf16_t*)(ws + OFF_KVB); const bf16_t* KR = (const bf16_t*)(ws + OFF_KR); bf16_t* OB = (bf16_t*)(ws + OFF_OBUF);
    const int c = lane & 31, hi = lane >> 5;
    const int kn_key0 = tid >> 4, kn_ch = tid & 15;
    const int kr_key = tid >> 3, kr_ch = tid & 7;
    const unsigned kvoff = (unsigned)(kn_key0 * 4096 + kn_ch * 16), kroff = (unsigned)(kr_key * 128 + kr_ch * 16);
    const unsigned k_rd = (unsigned)(c * KP + hi * 16);
    const int g4 = lane >> 4, i16 = lane & 15, qq = i16 >> 2, pp = i16 & 3;
    const unsigned v_rd = (unsigned)((4 * hi + qq) * VP + (g4 & 1) * 32 + pp * 8);
    const int vcu = (G % 8 == 0) ? (bx % 8) * (G / 8) + bx / 8 : bx;
    for (int vw = vcu; vw < 256; vw += G) {
        const int bh = vw >> 2, sub = vw & 3, b = bh >> 3, h = bh & 7;
        for (int ui = 0; ui < 4; ++ui) {
            const int qb = ui == 0 ? 15 - sub : (ui == 1 ? 8 + sub : (ui == 2 ? 7 - sub : sub));
            const int q0 = qb * 256 + w * 32;
            const char* kvbase = (const char*)(KVB + (size_t)b * SEQ * 2048 + h * 256);
            const char* krbase = (const char*)(KR + (size_t)b * SEQ * 64);
            asm volatile("" : "+s"(kvbase), "+s"(krbase));
            u32x4 sk0, sk1, skr, sv0, sv1;
#define ATT_LOADK(kt) do { const char* tb_ = kvbase + (size_t)(kt) * (64 * 4096); const char* tr_ = krbase + (size_t)(kt) * (64 * 128); \
                sk0 = *(const u32x4*)(tb_ + kvoff); sk1 = *(const u32x4*)(tb_ + 32 * 4096 + kvoff); skr = *(const u32x4*)(tr_ + kroff); } while (0)
#define ATT_LOADV(kt) do { const char* tb_ = kvbase + (size_t)(kt) * (64 * 4096) + 256; \
                sv0 = *(const u32x4*)(tb_ + kvoff); sv1 = *(const u32x4*)(tb_ + 32 * 4096 + kvoff); } while (0)
#define ATT_WRITEK(buf) do { LAS unsigned char* kb_ = lds + (buf) * KBUF; \
                *(LAS u32x4*)(kb_ + kn_key0 * KP + kn_ch * 16) = sk0; *(LAS u32x4*)(kb_ + (kn_key0 + 32) * KP + kn_ch * 16) = sk1; \
                *(LAS u32x4*)(kb_ + kr_key * KP + 256 + kr_ch * 16) = skr; } while (0)
#define ATT_WRITEV(buf) do { LAS unsigned char* vb_ = lds + 2 * KBUF + (buf) * VBUF; \
                *(LAS u32x4*)(vb_ + kn_key0 * VP + kn_ch * 16) = sv0; *(LAS u32x4*)(vb_ + (kn_key0 + 32) * VP + kn_ch * 16) = sv1; } while (0)
            ATT_LOADK(0); ATT_LOADV(0);
            const char* qbase = (const char*)(QB + ((size_t)b * SEQ + q0) * 1536 + h * 192);
            asm volatile("" : "+s"(qbase));
            const unsigned qoff = (unsigned)(c * 3072 + hi * 16);
            bf16x8 qf[12];
            {
                float ssn = 0.f, ssr = 0.f;
#pragma unroll
                for (int ks = 0; ks < 12; ++ks) {
                    const u32x4 w = *(const u32x4*)(qbase + qoff + ks * 32);
                    qf[ks] = __builtin_bit_cast(bf16x8, w);
                    float v[8]; unpack8(w, v);
                    float t = 0.f;
#pragma unroll
                    for (int j = 0; j < 8; ++j) t += v[j] * v[j];
                    if (ks < 8) ssn += t; else ssr += t;
                }
                ssn += __shfl_xor(ssn, 32); ssr += __shfl_xor(ssr, 32);
                const float QS = 0.07216878364870322f * 1.4426950408889634f;
                const float rn = __builtin_amdgcn_rsqf(ssn * (1.0f / 128.0f) + EPS) * QS, rr = __builtin_amdgcn_rsqf(ssr * (1.0f / 64.0f) + EPS) * QS;
                const float* qng = (const float*)P_IN(20) + hi * 8; const float* qrg = (const float*)P_IN(21) + hi * 8;
#pragma unroll
                for (int ks = 0; ks < 8; ++ks) {
                    float v[8]; unpack8(__builtin_bit_cast(u32x4, qf[ks]), v);
                    const f32x4 g0 = *(const f32x4*)(qng + ks * 16), g1 = *(const f32x4*)(qng + ks * 16 + 4);
                    u32x4 w; w.x = pk_bf16(v[0] * rn * g0[0], v[1] * rn * g0[1]); w.y = pk_bf16(v[2] * rn * g0[2], v[3] * rn * g0[3]);
                    w.z = pk_bf16(v[4] * rn * g1[0], v[5] * rn * g1[1]); w.w = pk_bf16(v[6] * rn * g1[2], v[7] * rn * g1[3]);
                    qf[ks] = __builtin_bit_cast(bf16x8, w);
                    asm volatile("" ::: "memory");
                }
                const float fpos = (float)((const int*)P_IN(1))[(size_t)b * SEQ + q0 + c];
                int hi2 = hi; asm volatile("" : "+v"(hi2));
#pragma unroll
                for (int kk = 0; kk < 2; ++kk) {
                    float a1[8], a2[8], o1[8], o2[8]; unpack8(__builtin_bit_cast(u32x4, qf[8 + kk]), a1); unpack8(__builtin_bit_cast(u32x4, qf[10 + kk]), a2);
#pragma unroll
                    for (int j = 0; j < 8; ++j) {
                        const int i = 16 * kk + 8 * hi2 + j;
                        const float ex = -(float)i * (13.287712379549449f / 32.0f);
                        const float ang = fpos * __builtin_amdgcn_exp2f(ex);
                        const float nrev = rintf(ang * 0.15915494309189535f);
                        float red = fmaf(-nrev, 6.2831854820251465f, ang); red = fmaf(-nrev, -1.7484556000744883e-07f, red);
                        const float sn = __sinf(red), cs = __cosf(red);
                        const float t1 = a1[j] * rr * qrg[16 * kk + j], t2 = a2[j] * rr * qrg[32 + 16 * kk + j];
                        o1[j] = t1 * cs - t2 * sn; o2[j] = t2 * cs + t1 * sn;
                    }
                    u32x4 w; w.x = pk_bf16(o1[0], o1[1]); w.y = pk_bf16(o1[2], o1[3]); w.z = pk_bf16(o1[4], o1[5]); w.w = pk_bf16(o1[6], o1[7]);
                    qf[8 + kk] = __builtin_bit_cast(bf16x8, w);
                    w.x = pk_bf16(o2[0], o2[1]); w.y = pk_bf16(o2[2], o2[3]); w.z = pk_bf16(o2[4], o2[5]); w.w = pk_bf16(o2[6], o2[7]);
                    qf[10 + kk] = __builtin_bit_cast(bf16x8, w);
                    asm volatile("" ::: "memory");
                }
            }
            f32x16 oacc[4];
#pragma unroll
            for (int i = 0; i < 4; ++i)
#pragma unroll
                for (int j = 0; j < 16; ++j) oacc[i][j] = 0.f;
            float mrun = 0.f, lrun = 0.f;
            const int ntile = 4 * qb + 4, wlast = 4 * qb + (w >> 1);
            __syncthreads();
            ATT_WRITEK(0); ATT_WRITEV(0);
            __syncthreads();
            for (int kt = 0; kt < ntile; ++kt) {
                const int buf = kt & 1;
                const bool more = kt + 1 < ntile, active = kt <= wlast;
                if (more) ATT_LOADK(kt + 1);
                f32x16 sacc[2];
                if (active) {
                    const LAS unsigned char* kb = lds + buf * KBUF + k_rd;
#pragma unroll
                    for (int kb2 = 0; kb2 < 2; ++kb2)
#pragma unroll
                        for (int j = 0; j < 16; ++j) sacc[kb2][j] = -mrun;
                    bf16x8 kf[2][4];
#define ATT_LDK(dst, g) do { _Pragma("unroll") for (int q_ = 0; q_ < 4; ++q_) dst[q_] = *(const LAS bf16x8*)(kb + ((g) / 3) * 32 * KP + (((g) % 3) * 4 + q_) * 32); } while (0)
                    ATT_LDK(kf[0], 0);
#pragma unroll
                    for (int g = 0; g < 6; ++g) {
                        if (g < 5) ATT_LDK(kf[(g + 1) & 1], g + 1);
                        __builtin_amdgcn_sched_barrier(0);
#pragma unroll
                        for (int q_ = 0; q_ < 4; ++q_) sacc[g / 3] = __builtin_amdgcn_mfma_f32_32x32x16_bf16(kf[g & 1][q_], qf[(g % 3) * 4 + q_], sacc[g / 3], 0, 0, 0);
                        __builtin_amdgcn_sched_barrier(0);
                    }
#undef ATT_LDK
                }
                if (more) { ATT_WRITEK(buf ^ 1); ATT_LOADV(kt + 1); }
                if (active) {
                    const LAS unsigned char* vb = lds + 2 * KBUF + buf * VBUF + v_rd;
                    bf16x8 vf[2][4];
#define ATT_LDV(dst, gg) do { _Pragma("unroll") for (int i_ = 0; i_ < 4; ++i_) { \
                        const s16x4 lo_ = __builtin_amdgcn_ds_read_tr16_b64_v4i16((LAS s16x4*)(vb + ((gg) * 16) * VP + i_ * 64)); \
                        const s16x4 hv_ = __builtin_amdgcn_ds_read_tr16_b64_v4i16((LAS s16x4*)(vb + ((gg) * 16 + 8) * VP + i_ * 64)); \
                        dst[i_] = __builtin_shufflevector(lo_, hv_, 0, 1, 2, 3, 4, 5, 6, 7); } } while (0)
                    ATT_LDV(vf[0], 0);
                    if (kt == wlast) {
                        const int qi = q0 + c - kt * 64;
#pragma unroll
                        for (int kb2 = 0; kb2 < 2; ++kb2)
#pragma unroll
                            for (int j = 0; j < 16; ++j) if (kb2 * 32 + crow(j, hi) > qi) sacc[kb2][j] = -INFINITY;
                    }
                    float mx = vmax3_first(sacc[0][0], sacc[0][1], sacc[0][2]);
#pragma unroll
                    for (int j = 3; j < 15; j += 2) mx = vmax3(mx, sacc[0][j], sacc[0][j + 1]);
                    mx = vmax3(mx, sacc[0][15], sacc[1][0]);
#pragma unroll
                    for (int j = 1; j < 15; j += 2) mx = vmax3(mx, sacc[1][j], sacc[1][j + 1]);
                    {
                        const float m1 = fmaxf(mx, sacc[1][15]);
                        const auto sw = __builtin_amdgcn_permlane32_swap(__float_as_uint(m1), __float_as_uint(m1), false, false);
                        mx = fmaxf(__uint_as_float(sw[0]), __uint_as_float(sw[1]));
                    }
                    const bool first = (kt == 0);
                    const bool move = first || __builtin_amdgcn_ballot_w64(mx > THR_DEFER) != 0ull;
                    const float d = move ? (first ? mx : fmaxf(mx, 0.f)) : 0.f;
                    f32x2 ps2 = (f32x2){0.f, 0.f}; const f32x2 d2 = (f32x2){d, d};
#pragma unroll
                    for (int kb2 = 0; kb2 < 2; ++kb2)
#pragma unroll
                        for (int j = 0; j < 16; j += 2) {
                            const f32x2 t = (f32x2){sacc[kb2][j], sacc[kb2][j + 1]} - d2;
                            const f32x2 e = (f32x2){__builtin_amdgcn_exp2f(t.x), __builtin_amdgcn_exp2f(t.y)};
                            sacc[kb2][j] = e.x; sacc[kb2][j + 1] = e.y; ps2 += e;
                        }
                    const float ps = ps2.x + ps2.y;
                    if (move) {
                        const float alpha = first ? 0.f : __builtin_amdgcn_exp2f(-d);
                        mrun += d; lrun *= alpha;
#pragma unroll
                        for (int i = 0; i < 4; ++i)
#pragma unroll
                            for (int j = 0; j < 16; ++j) oacc[i][j] *= alpha;
                    }
                    lrun += ps;
                    bf16x8 pb[2][2];
#pragma unroll
                    for (int kb2 = 0; kb2 < 2; ++kb2)
#pragma unroll
                        for (int s2 = 0; s2 < 2; ++s2) {
                            u32x4 pw;
                            pw.x = pk_bf16(sacc[kb2][8 * s2 + 0], sacc[kb2][8 * s2 + 1]); pw.y = pk_bf16(sacc[kb2][8 * s2 + 2], sacc[kb2][8 * s2 + 3]);
                            pw.z = pk_bf16(sacc[kb2][8 * s2 + 4], sacc[kb2][8 * s2 + 5]); pw.w = pk_bf16(sacc[kb2][8 * s2 + 6], sacc[kb2][8 * s2 + 7]);
                            pb[kb2][s2] = __builtin_bit_cast(bf16x8, pw);
                        }
#pragma unroll
                    for (int gg = 0; gg < 4; ++gg) {
                        if (gg < 3) ATT_LDV(vf[(gg + 1) & 1], gg + 1);
                        __builtin_amdgcn_sched_barrier(0);
#pragma unroll
                        for (int i = 0; i < 4; ++i) oacc[i] = __builtin_amdgcn_mfma_f32_32x32x16_bf16(vf[gg & 1][i], pb[gg >> 1][gg & 1], oacc[i], 0, 0, 0);
                        __builtin_amdgcn_sched_barrier(0);
                    }
#undef ATT_LDV
                }
                if (more) ATT_WRITEV(buf ^ 1);
                __syncthreads();
            }
#undef ATT_LOADK
#undef ATT_LOADV
#undef ATT_WRITEK
#undef ATT_WRITEV
            const float ltot = lrun + __shfl_xor(lrun, 32), inv = 1.0f / ltot;
            char* obase = (char*)(OB + ((size_t)b * SEQ + q0) * DM + h * 128);
            asm volatile("" : "+s"(obase));
            const unsigned ooff = (unsigned)(c * 2048 + hi * 8);
#pragma unroll
            for (int i = 0; i < 4; ++i)
#pragma unroll
                for (int g = 0; g < 4; ++g) {
                    u32x2 wv; wv.x = pk_bf16(oacc[i][4 * g] * inv, oacc[i][4 * g + 1] * inv); wv.y = pk_bf16(oacc[i][4 * g + 2] * inv, oacc[i][4 * g + 3] * inv);
                    *(u32x2*)(obase + ooff + 64 * i + 16 * g) = wv;
                }
        }
    }
    __syncthreads();
}

#define XB_TMO      128
#define XB_XCNT(j)  (256  + 64 * (j))
#define XB_XSUB(j)  (1280 + 64 * (j))
#define XB_XGEN(j)  (2304 + 64 * (j))
#define XB_TOP      3328
#define XB_TOPGEN   3392
#define XCD_BAR_WORDS 3456
#define XB_SPIN_CAP (1u << 20)
__device__ __forceinline__ unsigned xb_ld(unsigned* p)              { return __hip_atomic_load(p, __ATOMIC_RELAXED, __HIP_MEMORY_SCOPE_AGENT); }
__device__ __forceinline__ unsigned xb_add(unsigned* p, unsigned v) { return __hip_atomic_fetch_add(p, v, __ATOMIC_RELAXED, __HIP_MEMORY_SCOPE_AGENT); }
__device__ __forceinline__ unsigned xb_xcc_id() { return (unsigned)__builtin_amdgcn_s_getreg((3 << 11) | 20) & 0xFu; }
#define XB_SPIN(cond, bar) do { unsigned _sp = 0; while (cond) { __builtin_amdgcn_s_sleep(1); \
    if ((++_sp & 255u) == 0u) { if (xb_ld(&(bar)[XB_TMO])) break; if (_sp > XB_SPIN_CAP) { atomicAdd(&(bar)[XB_TMO], 1u); break; } } } } while (0)
struct XcdBarrier { unsigned* bar; unsigned x; volatile LAS unsigned* st; };
__device__ __forceinline__ XcdBarrier xcd_barrier_post(unsigned* bar, volatile LAS unsigned* st, const int wv) {
    XcdBarrier b; b.bar = bar; b.x = xb_xcc_id(); b.st = st;
    if (otid(wv) == 0) (void)xb_add(&bar[XB_XCNT(b.x)], 1u);
    return b;
}
__device__ __forceinline__ void xcd_barrier_complete(unsigned* bar, unsigned x, unsigned& nloc, unsigned& nx) {
    const unsigned G = gridDim.x * gridDim.y * gridDim.z;
    unsigned sum, cnt, mine, sp = 0u;
    for (;;) {
        sum = 0u; cnt = 0u; mine = 0u;
#pragma unroll
        for (unsigned j = 0; j < 16; ++j) { const unsigned c = xb_ld(&bar[XB_XCNT(j)]); sum += c; cnt += (c > 0u) ? 1u : 0u; mine = (j == x) ? c : mine; }
        if (sum == G) break;
        __builtin_amdgcn_s_sleep(1);
        if ((++sp & 255u) == 0u) { if (xb_ld(&bar[XB_TMO])) break; if (sp > XB_SPIN_CAP) { atomicAdd(&bar[XB_TMO], 1u); break; } }
    }
    nloc = mine > 0u ? mine : 1u; nx = cnt > 0u ? cnt : 1u;
}
__device__ __forceinline__ void xcd_barrier(const XcdBarrier& b, const int wv) {
    asm volatile("s_waitcnt vmcnt(0)" ::: "memory");
    __syncthreads();
    if (otid(wv) == 0) {
        unsigned* bar = b.bar;
        __builtin_amdgcn_s_waitcnt(0);
        unsigned nloc = b.st[0], nx = b.st[1];
        if (nloc == 0u) { xcd_barrier_complete(bar, b.x, nloc, nx); b.st[0] = nloc; b.st[1] = nx; }
        const unsigned old = xb_add(&bar[XB_XSUB(b.x)], 1u);
        const unsigned gen = old / nloc;
        if (old + 1u == (gen + 1u) * nloc) {
            __builtin_amdgcn_fence(__ATOMIC_RELEASE, "agent");
            asm volatile("s_waitcnt vmcnt(0)" ::: "memory");
            const unsigned og = xb_add(&bar[XB_TOP], 1u);
            const unsigned tg = og / nx;
            if (og + 1u == (tg + 1u) * nx) xb_add(&bar[XB_TOPGEN], 1u);
            else XB_SPIN(xb_ld(&bar[XB_TOPGEN]) == tg, bar);
            __builtin_amdgcn_fence(__ATOMIC_ACQUIRE, "agent");
            xb_add(&bar[XB_XGEN(b.x)], 1u);
            asm volatile("s_waitcnt vmcnt(0)" ::: "memory");
        } else {
            XB_SPIN(xb_ld(&bar[XB_XGEN(b.x)]) == gen, bar);
            __builtin_amdgcn_fence(__ATOMIC_ACQUIRE, "agent");
            asm volatile("s_waitcnt vmcnt(0)" ::: "memory");
        }
    }
    __syncthreads();
}

enum { OP_CIN, OP_CONV3, OP_COUT, OP_GU, OP_DOWN, OP_LIN, OP_CONV4, OP_GATE, OP_SCAN1, OP_SCAN2, OP_LOUT, OP_MDOWN, OP_UQ, OP_UKV, OP_PREP, OP_ATTN, OP_WO };
enum { GT_NONE, GT_PAIR, GT_STORE, GT_RESID, GT_GATE };
__device__ const unsigned char g_prog[25][3] = {
    {OP_CIN, 0, 1}, {OP_CONV3, 0, 1}, {OP_COUT, 0, 1}, {OP_GU, 0, 1}, {OP_DOWN, 0, 1},
    {OP_LIN, 1, 1}, {OP_CONV4, 1, 1}, {OP_GATE, 1, 1}, {OP_SCAN1, 1, 1}, {OP_SCAN2, 1, 1}, {OP_LOUT, 1, 1}, {OP_GU, 1, 1}, {OP_DOWN, 1, 1},
    {OP_MDOWN, 2, 1}, {OP_UQ, 2, 0}, {OP_UKV, 2, 1}, {OP_ATTN, 2, 1}, {OP_WO, 2, 1}, {OP_GU, 2, 1}, {OP_DOWN, 2, 1},
    {OP_CIN, 3, 1}, {OP_CONV3, 3, 1}, {OP_COUT, 3, 1}, {OP_GU, 3, 1}, {OP_DOWN, 3, 1}};

__global__ void __launch_bounds__(NTHREADS) mega_fwd(Params p) {
    extern __shared__ __attribute__((aligned(16))) unsigned char lds_raw[];
    LAS unsigned char* lds = (LAS unsigned char*)lds_raw;
    cg::grid_group grid = cg::this_grid();
    KA ka = (KA)__builtin_amdgcn_kernarg_segment_ptr();
    (void)p;
    volatile LAS unsigned* xst = (volatile LAS unsigned*)(lds + pg8::STAGE_BYTES);
    const int wv = __builtin_amdgcn_readfirstlane((int)(threadIdx.x >> 6));
    { const int t0 = otid(wv); if (t0 < 4) xst[t0] = 0u; }
    __syncthreads();
    (void)xcd_barrier_post((unsigned*)(P_WS + OFF_BAR), xst, wv);
    if (P_OUT == nullptr) grid.sync();
#define GRID_BAR() do { XcdBarrier xb_; xb_.bar = (unsigned*)(P_WS + OFF_BAR); xb_.x = xb_xcc_id(); xb_.st = (volatile LAS unsigned*)(lds + pg8::STAGE_BYTES); xcd_barrier(xb_, wv); } while (0)
    for (int i = 0; i < PROBE_P0; ++i) { phase0(ka, lds, wv); GRID_BAR(); }
    phase0(ka, lds, wv);
    GRID_BAR();
    for (int i = 0; i < PROBE_SYNCS; ++i) GRID_BAR();
    for (int st = 0, rep = 0; st < 25; ++st) {
        asm volatile("" : "+s"(ka));
        unsigned char* const ws = P_WS;
        float* const ssq = (float*)(ws + OFF_SSQ);
        bf16_t* const hb = (bf16_t*)(ws + OFF_HB);
        const int op = g_prog[st][0], L = g_prog[st][1], sync_after = g_prog[st][2];
        const int j = L / 3;
        int gt = GT_NONE; pg8::Gemm g{}; EP e{};
        switch (op) {
        case OP_CIN:
            gt = GT_PAIR; g = pg8::Gemm{hb, (const bf16_t*)(ws + OFF_WCIN) + (size_t)j * 3072 * DM, T, 3072, DM, DM, 0};
            e.o0 = (bf16_t*)(ws + OFF_U); e.ld0 = DM; e.o1 = (bf16_t*)(ws + OFF_BG); e.ld1 = DM; e.split = 8; e.mode = 1; e.q2 = ssq + (size_t)(2 * L) * T; e.inv_dim = 1.0f / DM; break;
        case OP_CONV3: conv3_phase(ka, (const float*)P_IN(4) + (size_t)j * 3 * DM, wv); break;
        case OP_COUT:
            gt = GT_RESID; g = pg8::Gemm{(const bf16_t*)(ws + OFF_Y), (const bf16_t*)(ws + OFF_WCOUT) + (size_t)j * DM * DM, T, DM, DM, DM, 0};
            e.q2 = ws + OFF_B3; e.o0 = hb; e.q3 = ssq + (size_t)(2 * L + 1) * T; break;
        case OP_GU:
            gt = GT_PAIR; g = pg8::Gemm{hb, (const bf16_t*)(ws + OFF_WGU) + (size_t)L * 2 * DFF * DM, T, 2 * DFF, DM, DM, 0};
            e.o0 = (bf16_t*)(ws + OFF_ACT); e.ld0 = DFF; e.split = 1 << 20; e.mode = 0; e.q2 = ssq + (size_t)(2 * L + 1) * T; e.inv_dim = 1.0f / DM; break;
        case OP_DOWN:
            gt = GT_RESID; g = pg8::Gemm{(const bf16_t*)(ws + OFF_ACT), (const bf16_t*)(ws + OFF_WDN) + (size_t)L * DM * DFF, T, DM, DFF, DFF, 0};
            e.q2 = ws + OFF_B3; e.q4 = P_OUT; e.mode = (L == 3) ? 1 : 0; e.o0 = hb; e.q3 = ssq + (size_t)(L < 3 ? 2 * L + 2 : 10) * T; break;
        case OP_LIN:
            gt = GT_STORE; g = pg8::Gemm{hb, (const bf16_t*)(ws + OFF_WLIN), T, 2 * LW, DM, DM, 0};
            e.o0 = (bf16_t*)(ws + OFF_GATE); e.ld0 = LW; e.o1 = (bf16_t*)(ws + OFF_RECB); e.ld1 = LW; e.split = 5; e.mode = 1; e.q2 = ssq + (size_t)(2 * L) * T; e.inv_dim = 1.0f / DM; break;
        case OP_CONV4: conv4_phase(ka, wv); break;
        case OP_GATE:
            gt = GT_GATE; g = pg8::Gemm{(const bf16_t*)(ws + OFF_XS), (const bf16_t*)(ws + OFF_WLG), T, 2 * LW, 128, LW, 128};
            e.o0 = (bf16_t*)P_OUT; e.o1 = (bf16_t*)(ws + OFF_RECB); e.q2 = (const bf16_t*)(ws + OFF_XS);
            e.q3 = (void*)P_IN(10); e.q4 = (void*)P_IN(12); e.q5 = (const float*)(ws + OFF_CL); break;
        case OP_SCAN1: scan1_phase(ka, wv); break;
        case OP_SCAN2: scan2_phase(ka, wv); break;
        case OP_LOUT:
            gt = GT_RESID; g = pg8::Gemm{(const bf16_t*)(ws + OFF_GATE), (const bf16_t*)(ws + OFF_WLOUT), T, DM, LW, LW, 0};
            e.q2 = ws + OFF_B3; e.o0 = hb; e.q3 = ssq + (size_t)(2 * L + 1) * T; break;
        case OP_MDOWN:
            gt = GT_STORE; g = pg8::Gemm{hb, (const bf16_t*)(ws + OFF_WMD), T, 768, DM, DM, 0};
            e.o0 = (bf16_t*)(ws + OFF_CBUF); e.ld0 = 768; e.split = 1 << 20; e.mode = 2; e.q2 = ssq + (size_t)(2 * L) * T; e.inv_dim = 1.0f / DM;
            e.q3 = ssq + (size_t)8 * T; e.q4 = ssq + (size_t)9 * T; break;
        case OP_UQ:
            krope_phase(ka, wv);
            gt = GT_STORE; g = pg8::Gemm{(const bf16_t*)(ws + OFF_CBUF) + 256, (const bf16_t*)(ws + OFF_WUQ), T, 1536, 384, 768, 0};
            e.o0 = (bf16_t*)(ws + OFF_QB); e.ld0 = 1536; e.split = 1 << 20; e.mode = 0; e.q2 = ssq + (size_t)9 * T; e.inv_dim = 1.0f / 384.0f; break;
        case OP_UKV:
            gt = GT_STORE; g = pg8::Gemm{(const bf16_t*)(ws + OFF_CBUF), (const bf16_t*)(ws + OFF_WUKV), T, 2048, 256, 768, 0};
            e.o0 = (bf16_t*)(ws + OFF_KVB); e.ld0 = 2048; e.split = 1 << 20; e.mode = 3; e.q2 = ssq + (size_t)8 * T; e.inv_dim = 1.0f / 256.0f; e.q5 = P_IN(22); break;
        case OP_ATTN: attn_phase(ka, lds, wv); break;
        case OP_WO:
            gt = GT_RESID; g = pg8::Gemm{(const bf16_t*)(ws + OFF_OBUF), (const bf16_t*)(ws + OFF_WO), T, DM, DM, DM, 0};
            e.q2 = ws + OFF_B3; e.o0 = hb; e.q3 = ssq + (size_t)(2 * L + 1) * T; break;
        default: break;
        }
        if (gt == GT_PAIR && ((PROBE_MASK >> op) & 1u) && rep == 0) { e.mode = 99; g.akoff = -1; }
        if (gt == GT_RESID && ((PROBE_MASK >> op) & 1u) && rep == 0) {
            e.mode = 1; e.q4 = ws + OFF_R + 192 * MiB; }
        if (gt != GT_NONE) {
            pg8::StaticOrder S; S.init(g.M, g.N, ogrid(), obid());
            e.type = gt - 1;
#if PROBE_CLK
            unsigned long long c0_ = 0, r0_ = 0; const bool clk_ = (st == 11);
            if (clk_) { c0_ = clock64(); r0_ = wall_clock64(); }
#endif
            EpiAll E{e, (LAS const float*)(lds + pg8::STAGE_BYTES + 64)}; pg8::gemm_phase<EpiAll>(lds, g, S, E, wv);
#if PROBE_CLK
            if (clk_ && blockIdx.x == 0 && otid(wv) == 0) {
                const unsigned long long c1_ = clock64(), r1_ = wall_clock64();
                const unsigned long long mhz = (c1_ - c0_) * 100ull / (r1_ - r0_);
                while (wall_clock64() - r1_ < mhz * 100ull) __builtin_amdgcn_s_sleep(8);
            }
#endif
        }
        if (sync_after) GRID_BAR();
        if (((PROBE_MASK >> op) & 1u) && rep == 0) { if (!sync_after) GRID_BAR(); rep = 1; --st; } else rep = 0;
    }
}

constexpr int LDS_BYTES = pg8::STAGE_BYTES + 64 + 1024 + 4096;

extern "C" void kernel_launch(void* const* d_in, const int* in_sizes, int n_in, void* d_out, int out_size, void* d_ws, size_t ws_size, hipStream_t stream) {
    static int grid_blocks = 0;
    if (grid_blocks == 0) {
        if (n_in != 28 || ws_size < WS_NEED) { fprintf(stderr, "kernel_launch: unexpected inputs (n_in %d, ws %zu, need %zu)\n", n_in, ws_size, (size_t)WS_NEED); grid_blocks = -1; return; }
        int dev = 0, cus = 0, per_cu = 0;
        hipGetDevice(&dev);
        hipDeviceGetAttribute(&cus, hipDeviceAttributeMultiprocessorCount, dev);
        hipFuncSetAttribute((const void*)mega_fwd, hipFuncAttributeMaxDynamicSharedMemorySize, LDS_BYTES);
        hipOccupancyMaxActiveBlocksPerMultiprocessor(&per_cu, (const void*)mega_fwd, NTHREADS, LDS_BYTES);
        if (per_cu < 1) { fprintf(stderr, "kernel_launch: occupancy query returned %d\n", per_cu); per_cu = 1; }
        grid_blocks = cus;
        (void)hipGetLastError();
    }
    if (grid_blocks < 0) return;
    Params p{};
    for (int i = 0; i < 28; ++i) p.in[i] = d_in[i];
    p.out = (float*)d_out; p.ws = (unsigned char*)d_ws;
    (void)hipMemsetAsync((unsigned char*)d_ws + OFF_BAR, 0, XCD_BAR_WORDS * sizeof(unsigned), stream);
    void* args[] = {&p};
    hipError_t e = hipLaunchCooperativeKernel((const void*)mega_fwd, dim3(grid_blocks), dim3(NTHREADS), args, LDS_BYTES, stream);
    if (e != hipSuccess) fprintf(stderr, "cooperative launch failed: %s (grid %d)\n", hipGetErrorString(e), grid_blocks);
}
```

```cpp
#include <hip/hip_runtime.h>
#include <hip/hip_cooperative_groups.h>
#include <cstdio>
namespace cg = cooperative_groups;

#define LAS __attribute__((address_space(3)))
typedef unsigned short bf16_t;
typedef short bf16x8 __attribute__((ext_vector_type(8)));
typedef short s16x4 __attribute__((ext_vector_type(4)));
typedef float f32x2 __attribute__((ext_vector_type(2)));
typedef float f32x4 __attribute__((ext_vector_type(4)));
typedef float f32x16 __attribute__((ext_vector_type(16)));
typedef unsigned u32x2 __attribute__((ext_vector_type(2)));
typedef unsigned u32x4 __attribute__((ext_vector_type(4)));
typedef __bf16 bf2_t __attribute__((ext_vector_type(2)));

#define PROBE_MASK 0x0u
#define PROBE_CLK 0
#define PROBE_SYNCS 0
#define PROBE_P0 0
constexpr int T = 32768, DM = 1024, SEQ = 4096, NBATCH = 8, DFF = 2816, LW = 1280;
constexpr int NTHREADS = 512;
constexpr float EPS = 1e-6f;
constexpr size_t MiB = 1ull << 20;
constexpr size_t OFF_WCIN = 0;
constexpr size_t OFF_WCOUT = 12 * MiB;
constexpr size_t OFF_WLIN = 16 * MiB;
constexpr size_t OFF_WLG = 21 * MiB;
constexpr size_t OFF_WLOUT = 22 * MiB + MiB / 4;
constexpr size_t OFF_WMD = 24 * MiB + 3 * MiB / 4;
constexpr size_t OFF_WUQ = 26 * MiB + MiB / 4;
constexpr size_t OFF_WUKV = 27 * MiB + 3 * MiB / 8;
constexpr size_t OFF_WO = 28 * MiB + 3 * MiB / 8;
constexpr size_t OFF_WGU = 31 * MiB;
constexpr size_t OFF_WDN = 75 * MiB;
constexpr size_t OFF_HB = 97 * MiB;
constexpr size_t OFF_SSQ = 161 * MiB;
constexpr size_t OFF_CL = OFF_SSQ + 11ull * T * 4;
constexpr size_t OFF_BAR = OFF_CL + 8192;
constexpr size_t OFF_B3 = 163 * MiB;
constexpr size_t OFF_R = 195 * MiB;
constexpr size_t OFF_ACT = OFF_R;
constexpr size_t OFF_U = OFF_R, OFF_BG = OFF_R + 64 * MiB, OFF_Y = OFF_R + 128 * MiB;
constexpr size_t OFF_GATE = OFF_R, OFF_RECB = OFF_R + 80 * MiB, OFF_XS = OFF_R + 160 * MiB, OFF_CARRY = OFF_R + 240 * MiB;
constexpr size_t OFF_CBUF = OFF_R, OFF_OBUF = OFF_R, OFF_QB = OFF_R + 64 * MiB, OFF_KVB = OFF_R + 160 * MiB, OFF_KR = OFF_R + 288 * MiB;
constexpr size_t WS_NEED = OFF_R + 316 * MiB;

struct Params { const void* in[28]; float* out; unsigned char* ws; };
typedef const void* kptr_t;
typedef const __attribute__((address_space(4))) kptr_t* KA;
#define P_IN(i) (ka[(i)])
#define P_OUT ((float*)ka[28])
#define P_WS ((unsigned char*)ka[29])

__device__ __forceinline__ unsigned pk_bf16(float lo, float hi) { bf2_t v = __builtin_convertvector((f32x2){lo, hi}, bf2_t); return __builtin_bit_cast(unsigned, v); }
__device__ __forceinline__ float bf_lo(unsigned w) { return __uint_as_float(w << 16); }
__device__ __forceinline__ float bf_hi(unsigned w) { return __uint_as_float(w & 0xffff0000u); }
__device__ __forceinline__ float bf1(bf16_t b) { return __uint_as_float(((unsigned)b) << 16); }
__device__ __forceinline__ float wave_sum(float v) {
#pragma unroll
    for (int o = 32; o >= 1; o >>= 1) v += __shfl_xor(v, o);
    return v;
}
__device__ __forceinline__ float res_dec_lo(unsigned hw, unsigned nw, int k) { return __uint_as_float(((hw << 16) | 0x800u) + ((unsigned)__builtin_amdgcn_sbfe((int)nw, 4 * k, 4) << 12)); }
__device__ __forceinline__ float res_dec_hi(unsigned hw, unsigned nw, int k) { return __uint_as_float(((hw & 0xffff0000u) | 0x800u) + ((unsigned)__builtin_amdgcn_sbfe((int)nw, 4 * k, 4) << 12)); }
__device__ __forceinline__ void res_dec8(const u32x4 h, const unsigned n, float (&v)[8]) {
    v[0] = res_dec_lo(h.x, n, 0); v[1] = res_dec_hi(h.x, n, 1); v[2] = res_dec_lo(h.y, n, 2); v[3] = res_dec_hi(h.y, n, 3);
    v[4] = res_dec_lo(h.z, n, 4); v[5] = res_dec_hi(h.z, n, 5); v[6] = res_dec_lo(h.w, n, 6); v[7] = res_dec_hi(h.w, n, 7);
}
__device__ __forceinline__ unsigned res_hb2(float a, float b) { return __builtin_amdgcn_perm(__float_as_uint(b) + 0x8000u, __float_as_uint(a) + 0x8000u, 0x07060302u); }
__device__ __forceinline__ unsigned res_nib(float a, int k) { return ((__float_as_uint(a) >> 12) & 0xfu) << (4 * k); }
__device__ __forceinline__ unsigned res_n4(float a, float b, float c, float d) { return res_nib(a, 0) | res_nib(b, 1) | res_nib(c, 2) | res_nib(d, 3); }
__device__ __forceinline__ unsigned res_n8(const float (&o)[8]) { return res_n4(o[0], o[1], o[2], o[3]) | (res_n4(o[4], o[5], o[6], o[7]) << 16); }
__device__ __forceinline__ int otid(int wv) { int l; asm volatile("v_mbcnt_lo_u32_b32 %0, -1, 0\n\tv_mbcnt_hi_u32_b32 %0, -1, %0" : "=v"(l)); return wv * 64 + l; }
__device__ __forceinline__ int obid() { int t = blockIdx.x; asm volatile("" : "+s"(t)); return t; }
__device__ __forceinline__ int ogrid() { int t = gridDim.x; asm volatile("" : "+s"(t)); return t; }
__device__ __forceinline__ float fast_sigmoid(float x) { return __builtin_amdgcn_rcpf(1.0f + __expf(-x)); }

namespace pg8 {
constexpr int BM = 256, BK = 64, HALF = 128, HTB = HALF * BK * 2, STAGE_BYTES = 8 * HTB, NXCD = 8, WGM = 8;
__device__ __forceinline__ int lds_byte(int r, int c) { const int st = (r >> 4) * 2 + (c >> 5), rr = r & 15, cc = c & 31, ob = rr * 64 + cc * 2; return st * 1024 + (ob ^ (((ob >> 9) & 1) << 5)); }
__device__ __forceinline__ void stage_rc(int b, int& R, int& C) { const int st = b / 1024, sb = b % 1024, swz = sb ^ (((sb >> 9) & 1) << 5); R = (st >> 1) * 16 + swz / 64; C = (st & 1) * 32 + (swz % 64) / 2; }
__device__ __forceinline__ int perm32(int rho) { const int n = rho >> 4, i = rho & 15; return 8 * (i >> 2) + 4 * n + (i & 3); }
struct Unit { int pm, pn; };
struct Gemm { const bf16_t* A; const bf16_t* Bt; int M, N, K, lda, akoff; };
struct StaticOrder {
    int nM, nN, nwg, G, c;
    __device__ void init(int M, int N, int G_, int c_) { nM = M / BM; nN = N / BM; nwg = nM * nN; G = G_; c = c_; }
    __device__ bool next(int i, Unit& u) const {
        const long L = (long)i * G + c; if (L >= nwg) return false;
        int wgid = (int)L; { const int q = nwg / NXCD, r = nwg % NXCD, xcd = wgid % NXCD, off = wgid / NXCD; wgid = (xcd < r ? xcd * (q + 1) : r * (q + 1) + (xcd - r) * q) + off; }
        const int nig = WGM * nN, gid = wgid / nig, fm = gid * WGM, gsz = (nM - fm) < WGM ? (nM - fm) : WGM;
        u.pm = fm + ((wgid % nig) % gsz); u.pn = (wgid % nig) / gsz; return true;
    }
};

template <class Epi>
__device__ __forceinline__ void gemm_phase(LAS unsigned char* lds, const Gemm g, const StaticOrder& S, const Epi& E, const int wv) {
    const int tid = otid(wv), wid = __builtin_amdgcn_readfirstlane(tid >> 6), lane = tid & 63, wr = wid >> 2, wc = wid & 3, fr = lane & 15, fq = lane >> 4;
    const int K = g.K, nt = K / BK, lda = g.lda;
    unsigned voffA[2], voffB[2];
#pragma unroll
    for (int i = 0; i < 2; ++i) { int R, C; stage_rc(tid * 16 + i * 8192, R, C); const int Rb = Epi::PERM ? ((R & ~31) + perm32(R & 31)) : R;
        voffA[i] = (unsigned)(R * lda + C) * 2u; voffB[i] = (unsigned)(Rb * K + C) * 2u; }
    const size_t kstep = (size_t)(BK * 2);
    const size_t hstepA = (size_t)HALF * lda * 2, hstepB = (size_t)HALF * K * 2;
    const size_t tstepA = g.akoff < 0 ? 0 : 2 * hstepA, tstepB = g.akoff < 0 ? 0 : 2 * hstepB;
    const size_t akoffb = g.akoff < 0 ? 0 : (size_t)g.akoff * 2;
    const unsigned ldsw = (unsigned)wid * 1024u;
    const int aoff = lds_byte(wr * 64 + fr, fq * 8), boff = lds_byte(wc * 32 + fr, fq * 8);
#define PG8_SA(b, h) (((b) * 2 + (h)) * HTB)
#define PG8_SB(b, h) ((4 + (b) * 2 + (h)) * HTB)
#define PG8_STAGE(bufoff, gbase, voff) do { _Pragma("unroll") for (int _i = 0; _i < 2; ++_i) \
        __builtin_amdgcn_global_load_lds((const unsigned*)((const char*)(gbase) + (voff)[_i]), (LAS unsigned*)(lds + (bufoff) + ldsw + _i * 8192), 16, 0, 0); } while (0)
#define PG8_LDA(dst, b, h) do { _Pragma("unroll") for (int m = 0; m < 4; ++m) _Pragma("unroll") for (int k = 0; k < 2; ++k) dst[m][k] = *(const LAS bf16x8*)(lds + PG8_SA(b, h) + aoff + m * 2048 + k * 1024); } while (0)
#define PG8_LDB(dst, b, h) do { _Pragma("unroll") for (int n = 0; n < 2; ++n) _Pragma("unroll") for (int k = 0; k < 2; ++k) dst[n][k] = *(const LAS bf16x8*)(lds + PG8_SB(b, h) + boff + n * 2048 + k * 1024); } while (0)
#define PG8_MMA(ai, bj, At, Bt) do { __builtin_amdgcn_s_setprio(1); _Pragma("unroll") for (int m = 0; m < 4; ++m) _Pragma("unroll") for (int n = 0; n < 2; ++n) _Pragma("unroll") for (int k = 0; k < 2; ++k) \
        acc[ai][bj][m][n] = __builtin_amdgcn_mfma_f32_16x16x32_bf16(Bt[n][k], At[m][k], acc[ai][bj][m][n], 0, 0, 0); __builtin_amdgcn_s_setprio(0); } while (0)
#define PG8_WAIT_V(n) asm volatile("s_waitcnt vmcnt(" #n ")" ::: "memory")
#define PG8_WAIT_L(n) asm volatile("s_waitcnt lgkmcnt(" #n ")" ::: "memory")
#define PG8_BAR __builtin_amdgcn_s_barrier()
#define PG8_SCHED __builtin_amdgcn_sched_barrier(0)
    Unit cur, nxt; int ui = 0;
    if (!S.next(0, cur)) return;
    f32x4 acc[2][2][4][2];
#pragma unroll
    for (int a = 0; a < 2; ++a)
#pragma unroll
        for (int b = 0; b < 2; ++b)
#pragma unroll
            for (int m = 0; m < 4; ++m)
#pragma unroll
                for (int n = 0; n < 2; ++n) acc[a][b][m][n] = (f32x4){0.f, 0.f, 0.f, 0.f};
    bf16x8 At[4][2], B0[2][2], B1[2][2];
    const char* cA = (const char*)g.A + (size_t)cur.pm * tstepA + (size_t)cur.pn * akoffb; const char* cB = (const char*)g.Bt + (size_t)cur.pn * tstepB;
    PG8_STAGE(PG8_SB(0, 0), cB, voffB); PG8_STAGE(PG8_SA(0, 0), cA, voffA); PG8_STAGE(PG8_SB(0, 1), cB + hstepB, voffB); PG8_STAGE(PG8_SA(0, 1), cA + hstepA, voffA);
    if (wr == 1) PG8_BAR;
    PG8_WAIT_V(4); PG8_BAR;
    PG8_STAGE(PG8_SB(1, 0), cB + kstep, voffB); PG8_STAGE(PG8_SA(1, 0), cA + kstep, voffA); PG8_STAGE(PG8_SB(1, 1), cB + hstepB + kstep, voffB);
    PG8_WAIT_V(6); PG8_BAR;
    for (;;) {
        const bool has_next = S.next(ui + 1, nxt);
        const char* nA = has_next ? (const char*)g.A + (size_t)nxt.pm * tstepA + (size_t)nxt.pn * akoffb : cA; const char* nB = has_next ? (const char*)g.Bt + (size_t)nxt.pn * tstepB : cB;
        for (int t = 0; t < nt; t += 2) {
            const bool last = (t == nt - 2);
            const char* a1 = cA + (size_t)(t + 1) * kstep;
            const char* a2 = last ? nA : cA + (size_t)(t + 2) * kstep; const char* b2 = last ? nB : cB + (size_t)(t + 2) * kstep;
            const char* a3 = a2 + kstep; const char* b3 = b2 + kstep;
            if (last && E.wants_rstd() && wid < 4)
                __builtin_amdgcn_global_load_lds((const unsigned*)(E.rs_ptr() + cur.pm * 256 + tid), (LAS unsigned*)(lds + STAGE_BYTES + 64 + wid * 256), 4, 0, 0);
            PG8_LDB(B0, 0, 0); PG8_SCHED; PG8_LDA(At, 0, 0); PG8_STAGE(PG8_SA(1, 1), a1 + hstepA, voffA);
            PG8_WAIT_L(8); PG8_BAR; PG8_WAIT_L(0); PG8_MMA(0, 0, At, B0); PG8_BAR; PG8_SCHED;
            PG8_LDB(B1, 0, 1); PG8_STAGE(PG8_SB(0, 0), b2, voffB);
            PG8_BAR; PG8_WAIT_L(0); PG8_MMA(0, 1, At, B1); PG8_BAR;
            PG8_LDA(At, 0, 1); PG8_STAGE(PG8_SA(0, 0), a2, voffA);
            PG8_BAR; PG8_WAIT_L(0); PG8_MMA(1, 0, At, B0); PG8_BAR; PG8_SCHED;
            PG8_STAGE(PG8_SB(0, 1), b2 + hstepB, voffB);
            PG8_WAIT_V(6); PG8_BAR; PG8_MMA(1, 1, At, B1); PG8_BAR;
            PG8_LDB(B0, 1, 0); PG8_SCHED; PG8_LDA(At, 1, 0); PG8_STAGE(PG8_SA(0, 1), a2 + hstepA, voffA);
            PG8_WAIT_L(8); PG8_BAR; PG8_WAIT_L(0); PG8_MMA(0, 0, At, B0); PG8_BAR; PG8_SCHED;
            PG8_LDB(B1, 1, 1); PG8_STAGE(PG8_SB(1, 0), b3, voffB);
            PG8_BAR; PG8_WAIT_L(0); PG8_MMA(0, 1, At, B1); PG8_BAR;
            PG8_LDA(At, 1, 1); PG8_STAGE(PG8_SA(1, 0), a3, voffA);
            PG8_BAR; PG8_WAIT_L(0); PG8_MMA(1, 0, At, B0); PG8_BAR; PG8_SCHED;
            PG8_STAGE(PG8_SB(1, 1), b3 + hstepB, voffB);
            PG8_WAIT_V(6); PG8_BAR; PG8_MMA(1, 1, At, B1); PG8_BAR;
        }
        { int t2 = tid; asm volatile("" : "+v"(t2));
          const int l2 = t2 & 63; E(acc, cur, wr, wc, l2 & 15, l2 >> 4); }
        if (!has_next) break;
#pragma unroll
        for (int a = 0; a < 2; ++a)
#pragma unroll
            for (int b = 0; b < 2; ++b)
#pragma unroll
                for (int m = 0; m < 4; ++m)
#pragma unroll
                    for (int n = 0; n < 2; ++n) acc[a][b][m][n] = (f32x4){0.f, 0.f, 0.f, 0.f};
        cur = nxt; cA = nA; cB = nB; ++ui;
    }
    PG8_WAIT_V(0);
    if (wr == 0) PG8_BAR;
    PG8_BAR;
#undef PG8_SA
#undef PG8_SB
#undef PG8_STAGE
#undef PG8_LDA
#undef PG8_LDB
#undef PG8_MMA
#undef PG8_WAIT_V
#undef PG8_WAIT_L
#undef PG8_BAR
#undef PG8_SCHED
}
}

struct EP {
    bf16_t* o0; bf16_t* o1; const void* q2; void* q3; void* q4; const void* q5;
    int ld0, ld1, split, mode, type; float inv_dim;
};
#define EP_RS(p) ((const float*)(p).q2)
#define EP_SSQ0(p) ((float*)(p).q3)
#define EP_SSQ1(p) ((float*)(p).q4)
#define EP_B3(p) ((unsigned char*)(p).q2)
#define EP_FOUT(p) ((float*)(p).q4)
#define EP_XS(p) ((const bf16_t*)(p).q2)
#define EP_BA(p) ((const float*)(p).q3)
#define EP_BX(p) ((const float*)(p).q4)
#define EP_CL(p) ((const float*)(p).q5)
__device__ __forceinline__ void load_rstd(const EP& p, int row0, float (&rstd)[2][4]) {
#pragma unroll
    for (int ai = 0; ai < 2; ++ai)
#pragma unroll
        for (int m = 0; m < 4; ++m) rstd[ai][m] = __builtin_amdgcn_rsqf(EP_RS(p)[row0 + ai * 128 + m * 16] * p.inv_dim + EPS);
}
__device__ __forceinline__ u32x4 pack8(const f32x4 a, const f32x4 b) { u32x4 w; w.x = pk_bf16(a[0], a[1]); w.y = pk_bf16(a[2], a[3]); w.z = pk_bf16(b[0], b[1]); w.w = pk_bf16(b[2], b[3]); return w; }

struct EpiAll {
    static constexpr bool PERM = true;
    EP p; LAS const float* rl;
    __device__ __forceinline__ bool wants_rstd() const { return p.type < 2; }
    __device__ __forceinline__ const float* rs_ptr() const { return EP_RS(p); }
    __device__ __forceinline__ void lds_rstd(int wr, int fr, float (&rstd)[2][4]) const {
#pragma unroll
        for (int ai = 0; ai < 2; ++ai)
#pragma unroll
            for (int m = 0; m < 4; ++m) rstd[ai][m] = __builtin_amdgcn_rsqf(rl[wr * 64 + fr + ai * 128 + m * 16] * p.inv_dim + EPS);
    }
    __device__ __forceinline__ void operator()(f32x4 (&acc)[2][2][4][2], const pg8::Unit& u, int wr, int wc, int fr, int fq) const {
        const int row0 = u.pm * 256 + wr * 64 + fr;
        if (p.mode == 99) return;
        if (p.type == 0) {
            float rstd[2][4]; lds_rstd(wr, fr, rstd);
            if (u.pn < p.split) {
                const int col = u.pn * 128 + wc * 32 + fq * 8;
#pragma unroll
                for (int ai = 0; ai < 2; ++ai)
#pragma unroll
                    for (int m = 0; m < 4; ++m) {
                        const float r = rstd[ai][m];
                        f32x4 v[2];
#pragma unroll
                        for (int n = 0; n < 2; ++n) {
                            const f32x4 g = acc[ai][0][m][n] * r, uu = acc[ai][1][m][n] * r;
                            if (p.mode == 0) {
#pragma unroll
                                for (int j = 0; j < 4; ++j) v[n][j] = g[j] * fast_sigmoid(g[j]) * uu[j];
                            } else v[n] = g * uu;
                        }
                        *(u32x4*)(p.o0 + (size_t)(row0 + ai * 128 + m * 16) * p.ld0 + col) = pack8(v[0], v[1]);
                    }
            } else {
                const int col = (u.pn - p.split) * 256 + wc * 32 + fq * 8;
#pragma unroll
                for (int ai = 0; ai < 2; ++ai)
#pragma unroll
                    for (int m = 0; m < 4; ++m) {
                        const float r = rstd[ai][m];
#pragma unroll
                        for (int bj = 0; bj < 2; ++bj)
                            *(u32x4*)(p.o1 + (size_t)(row0 + ai * 128 + m * 16) * p.ld1 + col + bj * 128) = pack8(acc[ai][bj][m][0] * r, acc[ai][bj][m][1] * r);
                    }
            }
        } else if (p.type == 1 && p.mode == 3) {
            float rstd[2][4]; lds_rstd(wr, fr, rstd);
            const int col = u.pn * 256 + wc * 32 + fq * 8;
            LAS float* P = (LAS float*)(rl + 256);
#pragma unroll
            for (int ai = 0; ai < 2; ++ai)
#pragma unroll
                for (int m = 0; m < 4; ++m) {
                    const float r = rstd[ai][m]; const int rl_ = ai * 128 + wr * 64 + m * 16 + fr;
                    *(u32x4*)(p.o0 + (size_t)(u.pm * 256 + rl_) * p.ld0 + col + 128) = pack8(acc[ai][1][m][0] * r, acc[ai][1][m][1] * r);
                    const f32x4 v0 = acc[ai][0][m][0] * r, v1 = acc[ai][0][m][1] * r;
                    float sq = (v0[0] * v0[0] + v0[1] * v0[1]) + (v0[2] * v0[2] + v0[3] * v0[3]) + (v1[0] * v1[0] + v1[1] * v1[1]) + (v1[2] * v1[2] + v1[3] * v1[3]);
                    sq += __shfl_xor(sq, 16); sq += __shfl_xor(sq, 32);
                    if (fq == 0) P[rl_ * 4 + wc] = sq;
                }
            asm volatile("s_waitcnt lgkmcnt(0)" ::: "memory"); __builtin_amdgcn_s_barrier(); asm volatile("" ::: "memory");
            const f32x4 g0 = *(const f32x4*)(EP_CL(p) + wc * 32 + fq * 8), g1 = *(const f32x4*)(EP_CL(p) + wc * 32 + fq * 8 + 4);
#pragma unroll
            for (int ai = 0; ai < 2; ++ai)
#pragma unroll
                for (int m = 0; m < 4; ++m) {
                    const int rl_ = ai * 128 + wr * 64 + m * 16 + fr;
                    const f32x4 pp = *(LAS f32x4*)(P + rl_ * 4);
                    const float rk = __builtin_amdgcn_rsqf(((pp[0] + pp[1]) + (pp[2] + pp[3])) * (1.0f / 128.0f) + EPS) * rstd[ai][m];
                    *(u32x4*)(p.o0 + (size_t)(u.pm * 256 + rl_) * p.ld0 + col) = pack8(acc[ai][0][m][0] * rk * g0, acc[ai][0][m][1] * rk * g1);
                }
        } else if (p.type == 1) {
            float rstd[2][4]; lds_rstd(wr, fr, rstd);
            const bool second = u.pn >= p.split;
            bf16_t* ob = second ? p.o1 : p.o0; const int ld = second ? p.ld1 : p.ld0;
            const int col = (second ? u.pn - p.split : u.pn) * 256 + wc * 32 + fq * 8;
            const bool gelu = (p.mode == 1) && !second;
#pragma unroll
            for (int ai = 0; ai < 2; ++ai)
#pragma unroll
                for (int m = 0; m < 4; ++m) {
                    const float r = rstd[ai][m]; const int row = row0 + ai * 128 + m * 16;
                    float sq[2];
#pragma unroll
                    for (int bj = 0; bj < 2; ++bj) {
                        f32x4 v0 = acc[ai][bj][m][0] * r, v1 = acc[ai][bj][m][1] * r;
                        if (gelu) {
#pragma unroll
                            for (int j = 0; j < 4; ++j) {
                                const float a = v0[j], b = v1[j];
                                v0[j] = a * fast_sigmoid(1.5957691216f * (a + 0.044715f * a * a * a));
                                v1[j] = b * fast_sigmoid(1.5957691216f * (b + 0.044715f * b * b * b));
                            }
                        }
                        sq[bj] = (v0[0] * v0[0] + v0[1] * v0[1]) + (v0[2] * v0[2] + v0[3] * v0[3]) + (v1[0] * v1[0] + v1[1] * v1[1]) + (v1[2] * v1[2] + v1[3] * v1[3]);
                        *(u32x4*)(ob + (size_t)row * ld + col + bj * 128) = pack8(v0, v1);
                    }
                    if (p.mode == 2) {
                        float s = (u.pn == 2) ? sq[0] : sq[0] + sq[1];
                        s += __shfl_xor(s, 16); s += __shfl_xor(s, 32);
                        if (fq == 0) atomicAdd((u.pn == 0 ? EP_SSQ0(p) : EP_SSQ1(p)) + row, s);
                    }
                }
        } else if (p.type == 2) {
            const int col0 = u.pn * 256 + wc * 32 + 8 * fq;
#pragma unroll
            for (int ai = 0; ai < 2; ++ai) {
                u32x4 rh[4][2]; unsigned rb[4][2];
#pragma unroll
                for (int m = 0; m < 4; ++m)
#pragma unroll
                    for (int bj = 0; bj < 2; ++bj) {
                        const size_t off = (size_t)(row0 + ai * 128 + m * 16) * DM + col0 + bj * 128;
                        rh[m][bj] = *(const u32x4*)(p.o0 + off); rb[m][bj] = *(const unsigned*)(EP_B3(p) + (off >> 1));
                    }
                asm volatile("" ::: "memory");
#pragma unroll
                for (int m = 0; m < 4; ++m) {
                    const int row = row0 + ai * 128 + m * 16; const size_t off = (size_t)row * DM + col0;
                    float s = 0.f;
#pragma unroll
                    for (int bj = 0; bj < 2; ++bj) {
                        float o[8]; res_dec8(rh[m][bj], rb[m][bj], o);
#pragma unroll
                        for (int j = 0; j < 4; ++j) { o[j] += acc[ai][bj][m][0][j]; o[4 + j] += acc[ai][bj][m][1][j]; }
                        if (p.mode == 1) {
                            *(f32x4*)(EP_FOUT(p) + off + bj * 128) = (f32x4){o[0], o[1], o[2], o[3]}; *(f32x4*)(EP_FOUT(p) + off + bj * 128 + 4) = (f32x4){o[4], o[5], o[6], o[7]};
                        } else {
                            u32x4 hw; hw.x = res_hb2(o[0], o[1]); hw.y = res_hb2(o[2], o[3]); hw.z = res_hb2(o[4], o[5]); hw.w = res_hb2(o[6], o[7]);
                            *(u32x4*)(p.o0 + off + bj * 128) = hw; *(unsigned*)(EP_B3(p) + ((off + bj * 128) >> 1)) = res_n8(o);
                            s += (o[0] * o[0] + o[1] * o[1]) + (o[2] * o[2] + o[3] * o[3]) + (o[4] * o[4] + o[5] * o[5]) + (o[6] * o[6] + o[7] * o[7]);
                        }
                    }
                    if (p.mode != 1) {
                        s += __shfl_xor(s, 16); s += __shfl_xor(s, 32);
                        if (fq == 0) atomicAdd(EP_SSQ0(p) + row, s);
                    }
                }
                asm volatile("" ::: "memory");
            }
        } else {
            const int col = u.pn * 128 + wc * 32 + fq * 8;
#pragma unroll
            for (int n = 0; n < 2; ++n) {
                const f32x4 ba = *(const f32x4*)(EP_BA(p) + col + 4 * n), bx = *(const f32x4*)(EP_BX(p) + col + 4 * n), cl = *(const f32x4*)(EP_CL(p) + col + 4 * n);
                u32x2 xw[2][4];
#pragma unroll
                for (int ai = 0; ai < 2; ++ai)
#pragma unroll
                    for (int m = 0; m < 4; ++m) xw[ai][m] = *(const u32x2*)(EP_XS(p) + (size_t)(row0 + ai * 128 + m * 16) * LW + col + 4 * n);
                asm volatile("" ::: "memory");
#pragma unroll
                for (int ai = 0; ai < 2; ++ai)
#pragma unroll
                    for (int m = 0; m < 4; ++m) {
                        const size_t off = (size_t)(row0 + ai * 128 + m * 16) * LW + col + 4 * n;
                        const float xv[4] = {bf_lo(xw[ai][m].x), bf_hi(xw[ai][m].x), bf_lo(xw[ai][m].y), bf_hi(xw[ai][m].y)};
                        f32x4 la, bb;
#pragma unroll
                        for (int j = 0; j < 4; ++j) {
                            const float r = fast_sigmoid(acc[ai][0][m][n][j] + ba[j]), ig = fast_sigmoid(acc[ai][1][m][n][j] + bx[j]);
                            const float l = r * cl[j];
                            const float a2 = __builtin_amdgcn_exp2f(2.0f * l);
                            la[j] = l; bb[j] = __builtin_amdgcn_sqrtf(fmaxf(1.0f - a2, 0.f)) * ig * xv[j];
                        }
                        u32x2 w0, w1; w0.x = pk_bf16(la[0], la[1]); w0.y = pk_bf16(la[2], la[3]); w1.x = pk_bf16(bb[0], bb[1]); w1.y = pk_bf16(bb[2], bb[3]);
                        *(u32x2*)(p.o0 + off) = w0;
                        *(u32x2*)(p.o1 + off) = w1;
                    }
                asm volatile("" ::: "memory");
            }
        }
    }
};

struct Job { const float* src; int K, ldsrc; bf16_t* dst; int ndst; const float* gain; int perm; };
__device__ __forceinline__ int src_col(int perm, int n0, int nsrc) {
    const int tile = n0 >> 8, r = n0 & 255;
    if (perm == 1) return r < 128 ? 128 * tile + r : DFF + 128 * tile + (r - 128);
    if (perm == 2) return tile < 8 ? (r < 128 ? 1024 + 128 * tile + r : 2048 + 128 * tile + (r - 128)) : (tile - 8) * 256 + r;
    if (perm == 3) return n0 < 256 ? 384 + n0 : (n0 < 640 ? n0 - 256 : (n0 == 640 ? 640 : -1));
    return n0 < nsrc ? n0 : -1;
}
__device__ __forceinline__ void get_job(KA ka, int j, Job& jb) {
    unsigned char* const ws = P_WS;
    const float* mixn = (const float*)P_IN(2); const float* ffnn = (const float*)P_IN(25);
        if (j < 2) { jb = Job{(const float*)P_IN(3) + (size_t)j * DM * 3072, DM, 3072, (bf16_t*)(ws + OFF_WCIN) + (size_t)j * 3072 * DM, 3072, mixn + (j == 0 ? 0 : 3) * DM, 2}; }
    else if (j < 4) { const int i = j - 2; jb = Job{(const float*)P_IN(5) + (size_t)i * DM * DM, DM, DM, (bf16_t*)(ws + OFF_WCOUT) + (size_t)i * DM * DM, DM, nullptr, 0}; }
    else if (j == 4) jb = Job{(const float*)P_IN(6), DM, 2 * LW, (bf16_t*)(ws + OFF_WLIN), 2 * LW, mixn + 1 * DM, 0};
    else if (j == 5) jb = Job{(const float*)P_IN(14), LW, DM, (bf16_t*)(ws + OFF_WLOUT), DM, nullptr, 0};
    else if (j == 6) jb = Job{(const float*)P_IN(15), DM, 704, (bf16_t*)(ws + OFF_WMD), 768, mixn + 2 * DM, 3};
    else if (j == 7) jb = Job{(const float*)P_IN(18), 384, 1536, (bf16_t*)(ws + OFF_WUQ), 1536, (const float*)P_IN(16), 0};
    else if (j == 8) jb = Job{(const float*)P_IN(19), 256, 2048, (bf16_t*)(ws + OFF_WUKV), 2048, (const float*)P_IN(17), 0};
    else if (j == 9) jb = Job{(const float*)P_IN(24), DM, DM, (bf16_t*)(ws + OFF_WO), DM, nullptr, 0};
    else if (j < 14) { const int i = j - 10; jb = Job{(const float*)P_IN(26) + (size_t)i * DM * 2 * DFF, DM, 2 * DFF, (bf16_t*)(ws + OFF_WGU) + (size_t)i * 2 * DFF * DM, 2 * DFF, ffnn + i * DM, 1}; }
    else { const int i = j - 14; jb = Job{(const float*)P_IN(27) + (size_t)i * DFF * DM, DFF, DM, (bf16_t*)(ws + OFF_WDN) + (size_t)i * DM * DFF, DM, nullptr, 0}; }
}
__device__ void phase0(KA ka, LAS unsigned char* lds, const int wv) {
    unsigned char* const ws = P_WS;
    const int tid = otid(wv), G = ogrid(), bx = obid(), lane = tid & 63, wid = tid >> 6;
    { float* z = (float*)(ws + OFF_SSQ) + T; const int n = 10 * T; for (int i = bx * NTHREADS + tid; i < n; i += G * NTHREADS) z[i] = 0.f; }
    if (bx == 0) { const float* lam = (const float*)P_IN(13); float* cl = (float*)(ws + OFF_CL); for (int c = tid; c < LW; c += NTHREADS) cl[c] = -8.0f * 1.4426950408889634f * log1pf(expf(-lam[c])); }
    { bf16_t* wlg = (bf16_t*)(ws + OFF_WLG); const float* wa = (const float*)P_IN(9); const float* wx = (const float*)P_IN(11);
      for (int i = bx * NTHREADS + tid; i < 2560 * 128; i += G * NTHREADS) { const int k = i & 127, row = i >> 7, n = row >> 8, gsel = (row >> 7) & 1, e = row & 127;
          const float v = (gsel ? wx : wa)[((size_t)n * 128 + k) * 128 + e];
          wlg[i] = (bf16_t)(pk_bf16(v, 0.f) & 0xffffu); } }
    { const float* x = (const float*)P_IN(0); bf16_t* hb = (bf16_t*)(ws + OFF_HB); unsigned char* b3 = ws + OFF_B3; float* ssq = (float*)(ws + OFF_SSQ);
      for (int row0 = bx * 8 + wid; row0 < T; row0 += G * 32) {
          f32x4 v[4][4];
#pragma unroll
          for (int r = 0; r < 4; ++r)
#pragma unroll
              for (int i = 0; i < 4; ++i) v[r][i] = *(const f32x4*)(x + (size_t)(row0 + r * G * 8) * DM + i * 256 + lane * 4);
#pragma unroll
          for (int r = 0; r < 4; ++r) { const int row = row0 + r * G * 8; float s = 0.f;
#pragma unroll
              for (int i = 0; i < 4; ++i) { const size_t o = (size_t)row * DM + i * 256 + lane * 4; const f32x4 q = v[r][i]; s += (q[0] * q[0] + q[1] * q[1]) + (q[2] * q[2] + q[3] * q[3]);
                  u32x2 w; w.x = res_hb2(q[0], q[1]); w.y = res_hb2(q[2], q[3]); *(u32x2*)(hb + o) = w; *(unsigned short*)(b3 + (o >> 1)) = (unsigned short)res_n4(q[0], q[1], q[2], q[3]); }
              s = wave_sum(s); if (lane == 0) ssq[row] = s; } } }
    LAS float* tile = (LAS float*)lds;
    int jstart[19]; { int acc_ = 0;
#pragma unroll
        for (int j = 0; j < 18; ++j) { Job jb; get_job(ka, j, jb); jstart[j] = acc_; acc_ += (jb.K / 64) * (jb.ndst / 256); } jstart[18] = acc_; }
    for (int t = bx; t < jstart[18]; t += G) {
        int j = 0;
#pragma unroll
        for (int q = 1; q < 18; ++q) j += (t >= jstart[q]) ? 1 : 0;
        Job jb; get_job(ka, j, jb);
        const int tl = t - jstart[j], tk = jb.K / 64, k0 = (tl % tk) * 64, n0 = (tl / tk) * 256;
        const int sc = src_col(jb.perm, n0 + (lane >> 4) * 64, jb.ldsrc);
        f32x4 v[8];
#pragma unroll
        for (int i = 0; i < 8; ++i) v[i] = sc >= 0 ? *(const f32x4*)(jb.src + (size_t)(k0 + wid * 8 + i) * jb.ldsrc + sc + (lane & 15) * 4) : (f32x4){0.f, 0.f, 0.f, 0.f};
        __syncthreads();
#pragma unroll
        for (int i = 0; i < 8; ++i) *(LAS f32x4*)(tile + (wid * 8 + i) * 260 + ((lane * 4) ^ (wid << 2))) = v[i];
        __syncthreads();
#pragma unroll
        for (int r = 0; r < 4; ++r) {
            const int item = tid + 512 * r, n = item >> 3, kci = item & 7, kc = kci * 8; float x[8];
#pragma unroll
            for (int i = 0; i < 8; ++i) x[i] = tile[(kc + i) * 260 + (n ^ (kci << 2))] * (jb.gain ? jb.gain[k0 + kc + i] : 1.0f);
            u32x4 w; w.x = pk_bf16(x[0], x[1]); w.y = pk_bf16(x[2], x[3]); w.z = pk_bf16(x[4], x[5]); w.w = pk_bf16(x[6], x[7]);
            *(u32x4*)(jb.dst + (size_t)(n0 + n) * jb.K + k0 + kc) = w;
        }
    }
    __syncthreads();
}

__device__ void conv3_phase(KA ka, const float* cw, const int wv) {
    unsigned char* const ws = P_WS;
    const bf16_t* U = (const bf16_t*)(ws + OFF_U); const bf16_t* BG = (const bf16_t*)(ws + OFF_BG); bf16_t* Y = (bf16_t*)(ws + OFF_Y);
    const int nitem = (T / 16) * 128;
    const int gstride = ogrid() * NTHREADS;
    for (int id = obid() * NTHREADS + otid(wv); id < nitem; id += gstride) {
        const int cgp = id & 127, rc = id >> 7, c0 = cgp * 8, t0 = rc * 16;
        float w0[8], w1[8], w2[8], um2[8], um1[8];
#pragma unroll
        for (int j = 0; j < 8; ++j) { w0[j] = cw[c0 + j]; w1[j] = cw[DM + c0 + j]; w2[j] = cw[2 * DM + c0 + j]; um2[j] = 0.f; um1[j] = 0.f; }
        if ((t0 & (SEQ - 1)) != 0) {
            const u32x4 a = *(const u32x4*)(U + (size_t)(t0 - 2) * DM + c0), b = *(const u32x4*)(U + (size_t)(t0 - 1) * DM + c0);
            um2[0] = bf_lo(a.x); um2[1] = bf_hi(a.x); um2[2] = bf_lo(a.y); um2[3] = bf_hi(a.y); um2[4] = bf_lo(a.z); um2[5] = bf_hi(a.z); um2[6] = bf_lo(a.w); um2[7] = bf_hi(a.w);
            um1[0] = bf_lo(b.x); um1[1] = bf_hi(b.x); um1[2] = bf_lo(b.y); um1[3] = bf_hi(b.y); um1[4] = bf_lo(b.z); um1[5] = bf_hi(b.z); um1[6] = bf_lo(b.w); um1[7] = bf_hi(b.w);
        }
#pragma unroll 4
        for (int r = 0; r < 16; ++r) {
            const size_t off = (size_t)(t0 + r) * DM + c0;
            const u32x4 a = *(const u32x4*)(U + off), g = *(const u32x4*)(BG + off);
            const float uc[8] = {bf_lo(a.x), bf_hi(a.x), bf_lo(a.y), bf_hi(a.y), bf_lo(a.z), bf_hi(a.z), bf_lo(a.w), bf_hi(a.w)};
            const float gv[8] = {bf_lo(g.x), bf_hi(g.x), bf_lo(g.y), bf_hi(g.y), bf_lo(g.z), bf_hi(g.z), bf_lo(g.w), bf_hi(g.w)};
            float y[8];
#pragma unroll
            for (int j = 0; j < 8; ++j) { y[j] = gv[j] * (w0[j] * um2[j] + w1[j] * um1[j] + w2[j] * uc[j]); um2[j] = um1[j]; um1[j] = uc[j]; }
            u32x4 w; w.x = pk_bf16(y[0], y[1]); w.y = pk_bf16(y[2], y[3]); w.z = pk_bf16(y[4], y[5]); w.w = pk_bf16(y[6], y[7]);
            *(u32x4*)(Y + off) = w;
        }
    }
}
__device__ void conv4_phase(KA ka, const int wv) {
    unsigned char* const ws = P_WS;
    const bf16_t* R = (const bf16_t*)(ws + OFF_RECB); bf16_t* XS = (bf16_t*)(ws + OFF_XS);
    const float* cw = (const float*)P_IN(7); const float* cb = (const float*)P_IN(8);
    const int nitem = (T / 16) * 160;
    const int gstride = ogrid() * NTHREADS;
    for (int id = obid() * NTHREADS + otid(wv); id < nitem; id += gstride) {
        const int cgp = id % 160, rc = id / 160, c0 = cgp * 8, t0 = rc * 16;
        float w0[8], w1[8], w2[8], w3[8], bs[8], x3[8], x2[8], x1[8];
#pragma unroll
        for (int j = 0; j < 8; ++j) { w0[j] = cw[c0 + j]; w1[j] = cw[LW + c0 + j]; w2[j] = cw[2 * LW + c0 + j]; w3[j] = cw[3 * LW + c0 + j]; bs[j] = cb[c0 + j]; x3[j] = 0.f; x2[j] = 0.f; x1[j] = 0.f; }
        if ((t0 & (SEQ - 1)) != 0) {
            const u32x4 a = *(const u32x4*)(R + (size_t)(t0 - 3) * LW + c0), b = *(const u32x4*)(R + (size_t)(t0 - 2) * LW + c0), c = *(const u32x4*)(R + (size_t)(t0 - 1) * LW + c0);
            x3[0] = bf_lo(a.x); x3[1] = bf_hi(a.x); x3[2] = bf_lo(a.y); x3[3] = bf_hi(a.y); x3[4] = bf_lo(a.z); x3[5] = bf_hi(a.z); x3[6] = bf_lo(a.w); x3[7] = bf_hi(a.w);
            x2[0] = bf_lo(b.x); x2[1] = bf_hi(b.x); x2[2] = bf_lo(b.y); x2[3] = bf_hi(b.y); x2[4] = bf_lo(b.z); x2[5] = bf_hi(b.z); x2[6] = bf_lo(b.w); x2[7] = bf_hi(b.w);
            x1[0] = bf_lo(c.x); x1[1] = bf_hi(c.x); x1[2] = bf_lo(c.y); x1[3] = bf_hi(c.y); x1[4] = bf_lo(c.z); x1[5] = bf_hi(c.z); x1[6] = bf_lo(c.w); x1[7] = bf_hi(c.w);
        }
#pragma unroll 4
        for (int r = 0; r < 16; ++r) {
            const size_t off = (size_t)(t0 + r) * LW + c0;
            const u32x4 a = *(const u32x4*)(R + off);
            const float xc[8] = {bf_lo(a.x), bf_hi(a.x), bf_lo(a.y), bf_hi(a.y), bf_lo(a.z), bf_hi(a.z), bf_lo(a.w), bf_hi(a.w)};
            float y[8];
#pragma unroll
            for (int j = 0; j < 8; ++j) { y[j] = bs[j] + w0[j] * x3[j] + w1[j] * x2[j] + w2[j] * x1[j] + w3[j] * xc[j]; x3[j] = x2[j]; x2[j] = x1[j]; x1[j] = xc[j]; }
            u32x4 w; w.x = pk_bf16(y[0], y[1]); w.y = pk_bf16(y[2], y[3]); w.z = pk_bf16(y[4], y[5]); w.w = pk_bf16(y[6], y[7]);
            *(u32x4*)(XS + off) = w;
        }
    }
}
__device__ __forceinline__ void unpack8(const u32x4 w, float (&v)[8]) { v[0] = bf_lo(w.x); v[1] = bf_hi(w.x); v[2] = bf_lo(w.y); v[3] = bf_hi(w.y); v[4] = bf_lo(w.z); v[5] = bf_hi(w.z); v[6] = bf_lo(w.w); v[7] = bf_hi(w.w); }
__device__ void scan1_phase(KA ka, const int wv) {
    unsigned char* const ws = P_WS;
    const bf16_t* LA = (const bf16_t*)P_OUT; const bf16_t* BB = (const bf16_t*)(ws + OFF_RECB);
    float* CA = (float*)(ws + OFF_CARRY); float* CH = CA + NBATCH * 64 * LW;
    const int nitem = NBATCH * 64 * 160;
    const int gstride = ogrid() * NTHREADS;
    for (int id = obid() * NTHREADS + otid(wv); id < nitem; id += gstride) {
        const int c8 = id % 160, bj = id / 160;
        const size_t base = (size_t)bj * 64 * LW + c8 * 8;
        float s[8], h[8];
#pragma unroll
        for (int k = 0; k < 8; ++k) { s[k] = 0.f; h[k] = 0.f; }
#pragma unroll 8
        for (int t = 0; t < 64; ++t) {
            float l[8], b[8]; unpack8(*(const u32x4*)(LA + base + (size_t)t * LW), l); unpack8(*(const u32x4*)(BB + base + (size_t)t * LW), b);
#pragma unroll
            for (int k = 0; k < 8; ++k) { s[k] += l[k]; h[k] = __builtin_amdgcn_exp2f(l[k]) * h[k] + b[k]; }
        }
        float* ca = CA + (size_t)bj * LW + c8 * 8; float* ch = CH + (size_t)bj * LW + c8 * 8;
        *(f32x4*)ca = (f32x4){s[0], s[1], s[2], s[3]}; *(f32x4*)(ca + 4) = (f32x4){s[4], s[5], s[6], s[7]};
        *(f32x4*)ch = (f32x4){h[0], h[1], h[2], h[3]}; *(f32x4*)(ch + 4) = (f32x4){h[4], h[5], h[6], h[7]};
    }
}
__device__ void scan2_phase(KA ka, const int wv) {
    unsigned char* const ws = P_WS;
    const bf16_t* LA = (const bf16_t*)P_OUT; const bf16_t* BB = (const bf16_t*)(ws + OFF_RECB); bf16_t* GT = (bf16_t*)(ws + OFF_GATE);
    const float* CA = (const float*)(ws + OFF_CARRY); const float* CH = CA + NBATCH * 64 * LW;
    const int nitem = NBATCH * 64 * 160;
    const int gstride = ogrid() * NTHREADS;
    for (int id = obid() * NTHREADS + otid(wv); id < nitem; id += gstride) {
        const int c8 = id % 160, bj = id / 160, j = bj & 63, b0 = bj - j;
        float h[8];
#pragma unroll
        for (int k = 0; k < 8; ++k) h[k] = 0.f;
        const float* ca = CA + (size_t)b0 * LW + c8 * 8; const float* ch = CH + (size_t)b0 * LW + c8 * 8;
#pragma unroll 8
        for (int jj = 0; jj < j; ++jj) {
            const f32x4 a0 = *(const f32x4*)(ca + (size_t)jj * LW), a1 = *(const f32x4*)(ca + (size_t)jj * LW + 4);
            const f32x4 h0 = *(const f32x4*)(ch + (size_t)jj * LW), h1 = *(const f32x4*)(ch + (size_t)jj * LW + 4);
#pragma unroll
            for (int k = 0; k < 4; ++k) { h[k] = __builtin_amdgcn_exp2f(a0[k]) * h[k] + h0[k]; h[4 + k] = __builtin_amdgcn_exp2f(a1[k]) * h[4 + k] + h1[k]; }
        }
        const size_t base = (size_t)bj * 64 * LW + c8 * 8;
#pragma unroll 8
        for (int t = 0; t < 64; ++t) {
            const size_t o = base + (size_t)t * LW;
            float l[8], b[8], g[8]; unpack8(*(const u32x4*)(LA + o), l); unpack8(*(const u32x4*)(BB + o), b); unpack8(*(const u32x4*)(GT + o), g);
#pragma unroll
            for (int k = 0; k < 8; ++k) { h[k] = __builtin_amdgcn_exp2f(l[k]) * h[k] + b[k]; g[k] *= h[k]; }
            u32x4 w; w.x = pk_bf16(g[0], g[1]); w.y = pk_bf16(g[2], g[3]); w.z = pk_bf16(g[4], g[5]); w.w = pk_bf16(g[6], g[7]);
            *(u32x4*)(GT + o) = w;
        }
    }
}
__device__ __forceinline__ float sum8(float v) { v += __shfl_xor(v, 1); v += __shfl_xor(v, 2); v += __shfl_xor(v, 4); return v; }
__device__ void krope_phase(KA ka, const int wv) {
    unsigned char* const ws = P_WS;
    const int tid = otid(wv), lane = tid & 63, wid = tid >> 6, G = ogrid(), bx = obid();
    bf16_t* KR = (bf16_t*)(ws + OFF_KR); const bf16_t* CB = (const bf16_t*)(ws + OFF_CBUF);
    const int* pos = (const int*)P_IN(1); const float* kr = (const float*)P_IN(23);
    const int j = lane & 7;
    float krg[8], ifq[8];
#pragma unroll
    for (int e = 0; e < 8; ++e) { krg[e] = kr[8 * j + e]; ifq[e] = exp2f(-(float)(8 * (j & 3) + e) * (13.287712379549449f / 32.0f)); }
    for (int t = (bx * 8 + wid) * 8 + (lane >> 3); t < T; t += G * 64) {
        const u32x4 kc = *(const u32x4*)(CB + (size_t)t * 768 + 640 + 8 * j);
        const float fp = (float)pos[t];
        float xk[8]; unpack8(kc, xk);
        float skr = 0.f;
#pragma unroll
        for (int e = 0; e < 8; ++e) skr += xk[e] * xk[e];
        skr = sum8(skr);
        const float rkr = rsqrtf(skr * (1.0f / 64.0f) + EPS);
        float ok[8];
#pragma unroll
        for (int e = 0; e < 8; ++e) {
            const float ang = fp * ifq[e];
            const float nrev = rintf(ang * 0.15915494309189535f);
            float rr = fmaf(-nrev, 6.2831854820251465f, ang); rr = fmaf(-nrev, -1.7484556000744883e-07f, rr);
            const float sn = __sinf(rr), cs = __cosf(rr);
            const float b = xk[e] * rkr * krg[e], pb = __shfl_xor(b, 4);
            ok[e] = j < 4 ? b * cs - pb * sn : b * cs + pb * sn;
        }
        u32x4 w; w.x = pk_bf16(ok[0], ok[1]); w.y = pk_bf16(ok[2], ok[3]); w.z = pk_bf16(ok[4], ok[5]); w.w = pk_bf16(ok[6], ok[7]);
        *(u32x4*)(KR + (size_t)t * 64 + 8 * j) = w;
    }
}

constexpr int KP = 400, VP = 320, KBUF = 64 * KP, VBUF = 64 * VP;
constexpr float THR_DEFER = 6.0f;
__device__ __forceinline__ int crow(int r, int hi) { return (r & 3) + 8 * (r >> 2) + 4 * hi; }
__device__ __forceinline__ float vmax3_first(float a, float b, float c) { float r; asm volatile("s_nop 7\n\ts_nop 7\n\ts_nop 3\n\tv_max3_f32 %0, %1, %2, %3" : "=v"(r) : "v"(a), "v"(b), "v"(c)); return r; }
__device__ __forceinline__ float vmax3(float a, float b, float c) { float r; asm("v_max3_f32 %0, %1, %2, %3" : "=v"(r) : "v"(a), "v"(b), "v"(c)); return r; }
__device__ void attn_phase(KA ka, LAS unsigned char* lds, const int wv) {
    unsigned char* const ws = P_WS;
    const int tid = otid(wv), lane = tid & 63, w = __builtin_amdgcn_readfirstlane(tid >> 6), G = ogrid(), bx = obid();
    const bf16_t* QB = (const bf16_t*)(ws + OFF_QB); const bf16_t* KVB = (const bf16_t*)(ws + OFF_KVB); const bf16_t* KR = (const bf16_t*)(ws + OFF_KR); bf16_t* OB = (bf16_t*)(ws + OFF_OBUF);
    const int c = lane & 31, hi = lane >> 5;
    const int kn_key0 = tid >> 4, kn_ch = tid & 15;
    const int kr_key = tid >> 3, kr_ch = tid & 7;
    const unsigned kvoff = (unsigned)(kn_key0 * 4096 + kn_ch * 16), kroff = (unsigned)(kr_key * 128 + kr_ch * 16);
    const unsigned k_rd = (unsigned)(c * KP + hi * 16);
    const int g4 = lane >> 4, i16 = lane & 15, qq = i16 >> 2, pp = i16 & 3;
    const unsigned v_rd = (unsigned)((4 * hi + qq) * VP + (g4 & 1) * 32 + pp * 8);
    const int vcu = (G % 8 == 0) ? (bx % 8) * (G / 8) + bx / 8 : bx;
    for (int vw = vcu; vw < 256; vw += G) {
        const int bh = vw >> 2, sub = vw & 3, b = bh >> 3, h = bh & 7;
        for (int ui = 0; ui < 4; ++ui) {
            const int qb = ui == 0 ? 15 - sub : (ui == 1 ? 8 + sub : (ui == 2 ? 7 - sub : sub));
            const int q0 = qb * 256 + w * 32;
            const char* qbase = (const char*)(QB + ((size_t)b * SEQ + q0) * 1536 + h * 192);
            asm volatile("" : "+s"(qbase));
            const unsigned qoff = (unsigned)(c * 3072 + hi * 16);
            bf16x8 qf[12];
            {
                float ssn = 0.f, ssr = 0.f;
#pragma unroll
                for (int ks = 0; ks < 12; ++ks) {
                    const u32x4 w = *(const u32x4*)(qbase + qoff + ks * 32);
                    qf[ks] = __builtin_bit_cast(bf16x8, w);
                    float v[8]; unpack8(w, v);
                    float t = 0.f;
#pragma unroll
                    for (int j = 0; j < 8; ++j) t += v[j] * v[j];
                    if (ks < 8) ssn += t; else ssr += t;
                }
                ssn += __shfl_xor(ssn, 32); ssr += __shfl_xor(ssr, 32);
                const float QS = 0.07216878364870322f * 1.4426950408889634f;
                const float rn = __builtin_amdgcn_rsqf(ssn * (1.0f / 128.0f) + EPS) * QS, rr = __builtin_amdgcn_rsqf(ssr * (1.0f / 64.0f) + EPS) * QS;
                const float* qng = (const float*)P_IN(20) + hi * 8; const float* qrg = (const float*)P_IN(21) + hi * 8;
#pragma unroll
                for (int ks = 0; ks < 8; ++ks) {
                    float v[8]; unpack8(__builtin_bit_cast(u32x4, qf[ks]), v);
                    const f32x4 g0 = *(const f32x4*)(qng + ks * 16), g1 = *(const f32x4*)(qng + ks * 16 + 4);
                    u32x4 w; w.x = pk_bf16(v[0] * rn * g0[0], v[1] * rn * g0[1]); w.y = pk_bf16(v[2] * rn * g0[2], v[3] * rn * g0[3]);
                    w.z = pk_bf16(v[4] * rn * g1[0], v[5] * rn * g1[1]); w.w = pk_bf16(v[6] * rn * g1[2], v[7] * rn * g1[3]);
                    qf[ks] = __builtin_bit_cast(bf16x8, w);
                    asm volatile("" ::: "memory");
                }
                const float fpos = (float)((const int*)P_IN(1))[(size_t)b * SEQ + q0 + c];
                int hi2 = hi; asm volatile("" : "+v"(hi2));
#pragma unroll
                for (int kk = 0; kk < 2; ++kk) {
                    float a1[8], a2[8], o1[8], o2[8]; unpack8(__builtin_bit_cast(u32x4, qf[8 + kk]), a1); unpack8(__builtin_bit_cast(u32x4, qf[10 + kk]), a2);
#pragma unroll
                    for (int j = 0; j < 8; ++j) {
                        const int i = 16 * kk + 8 * hi2 + j;
                        const float ex = -(float)i * (13.287712379549449f / 32.0f);
                        const float ang = fpos * __builtin_amdgcn_exp2f(ex);
                        const float nrev = rintf(ang * 0.15915494309189535f);
                        float red = fmaf(-nrev, 6.2831854820251465f, ang); red = fmaf(-nrev, -1.7484556000744883e-07f, red);
                        const float sn = __sinf(red), cs = __cosf(red);
                        const float t1 = a1[j] * rr * qrg[16 * kk + j], t2 = a2[j] * rr * qrg[32 + 16 * kk + j];
                        o1[j] = t1 * cs - t2 * sn; o2[j] = t2 * cs + t1 * sn;
                    }
                    u32x4 w; w.x = pk_bf16(o1[0], o1[1]); w.y = pk_bf16(o1[2], o1[3]); w.z = pk_bf16(o1[4], o1[5]); w.w = pk_bf16(o1[6], o1[7]);
                    qf[8 + kk] = __builtin_bit_cast(bf16x8, w);
                    w.x = pk_bf16(o2[0], o2[1]); w.y = pk_bf16(o2[2], o2[3]); w.z = pk_bf16(o2[4], o2[5]); w.w = pk_bf16(o2[6], o2[7]);
                    qf[10 + kk] = __builtin_bit_cast(bf16x8, w);
                    asm volatile("" ::: "memory");
                }
            }
            f32x16 oacc[4];
#pragma unroll
            for (int i = 0; i < 4; ++i)
#pragma unroll
                for (int j = 0; j < 16; ++j) oacc[i][j] = 0.f;
            float mrun = 0.f, lrun = 0.f;
            const int ntile = 4 * qb + 4, wlast = 4 * qb + (w >> 1);
            const char* kvbase = (const char*)(KVB + (size_t)b * SEQ * 2048 + h * 256);
            const char* krbase = (const char*)(KR + (size_t)b * SEQ * 64);
            asm volatile("" : "+s"(kvbase), "+s"(krbase));
            u32x4 sk0, sk1, skr, sv0, sv1;
#define ATT_LOADK(kt) do { const char* tb_ = kvbase + (size_t)(kt) * (64 * 4096); const char* tr_ = krbase + (size_t)(kt) * (64 * 128); \
                sk0 = *(const u32x4*)(tb_ + kvoff); sk1 = *(const u32x4*)(tb_ + 32 * 4096 + kvoff); skr = *(const u32x4*)(tr_ + kroff); } while (0)
#define ATT_LOADV(kt) do { const char* tb_ = kvbase + (size_t)(kt) * (64 * 4096) + 256; \
                sv0 = *(const u32x4*)(tb_ + kvoff); sv1 = *(const u32x4*)(tb_ + 32 * 4096 + kvoff); } while (0)
#define ATT_WRITEK(buf) do { LAS unsigned char* kb_ = lds + (buf) * KBUF; \
                *(LAS u32x4*)(kb_ + kn_key0 * KP + kn_ch * 16) = sk0; *(LAS u32x4*)(kb_ + (kn_key0 + 32) * KP + kn_ch * 16) = sk1; \
                *(LAS u32x4*)(kb_ + kr_key * KP + 256 + kr_ch * 16) = skr; } while (0)
#define ATT_WRITEV(buf) do { LAS unsigned char* vb_ = lds + 2 * KBUF + (buf) * VBUF; \
                *(LAS u32x4*)(vb_ + kn_key0 * VP + kn_ch * 16) = sv0; *(LAS u32x4*)(vb_ + (kn_key0 + 32) * VP + kn_ch * 16) = sv1; } while (0)
            __syncthreads();
            ATT_LOADK(0); ATT_LOADV(0); ATT_WRITEK(0); ATT_WRITEV(0);
            __syncthreads();
            for (int kt = 0; kt < ntile; ++kt) {
                const int buf = kt & 1;
                const bool more = kt + 1 < ntile, active = kt <= wlast;
                if (more) ATT_LOADK(kt + 1);
                f32x16 sacc[2];
                if (active) {
                    const LAS unsigned char* kb = lds + buf * KBUF + k_rd;
#pragma unroll
                    for (int kb2 = 0; kb2 < 2; ++kb2)
#pragma unroll
                        for (int j = 0; j < 16; ++j) sacc[kb2][j] = -mrun;
                    bf16x8 kf[2][4];
#define ATT_LDK(dst, g) do { _Pragma("unroll") for (int q_ = 0; q_ < 4; ++q_) dst[q_] = *(const LAS bf16x8*)(kb + ((g) / 3) * 32 * KP + (((g) % 3) * 4 + q_) * 32); } while (0)
                    ATT_LDK(kf[0], 0);
#pragma unroll
                    for (int g = 0; g < 6; ++g) {
                        if (g < 5) ATT_LDK(kf[(g + 1) & 1], g + 1);
                        __builtin_amdgcn_sched_barrier(0);
#pragma unroll
                        for (int q_ = 0; q_ < 4; ++q_) sacc[g / 3] = __builtin_amdgcn_mfma_f32_32x32x16_bf16(kf[g & 1][q_], qf[(g % 3) * 4 + q_], sacc[g / 3], 0, 0, 0);
                        __builtin_amdgcn_sched_barrier(0);
                    }
#undef ATT_LDK
                }
                if (more) { ATT_WRITEK(buf ^ 1); ATT_LOADV(kt + 1); }
                if (active) {
                    const LAS unsigned char* vb = lds + 2 * KBUF + buf * VBUF + v_rd;
                    bf16x8 vf[2][4];
#define ATT_LDV(dst, gg) do { _Pragma("unroll") for (int i_ = 0; i_ < 4; ++i_) { \
                        const s16x4 lo_ = __builtin_amdgcn_ds_read_tr16_b64_v4i16((LAS s16x4*)(vb + ((gg) * 16) * VP + i_ * 64)); \
                        const s16x4 hv_ = __builtin_amdgcn_ds_read_tr16_b64_v4i16((LAS s16x4*)(vb + ((gg) * 16 + 8) * VP + i_ * 64)); \
                        dst[i_] = __builtin_shufflevector(lo_, hv_, 0, 1, 2, 3, 4, 5, 6, 7); } } while (0)
                    ATT_LDV(vf[0], 0);
                    if (kt == wlast) {
                        const int qi = q0 + c - kt * 64;
#pragma unroll
                        for (int kb2 = 0; kb2 < 2; ++kb2)
#pragma unroll
                            for (int j = 0; j < 16; ++j) if (kb2 * 32 + crow(j, hi) > qi) sacc[kb2][j] = -INFINITY;
                    }
                    float mx = vmax3_first(sacc[0][0], sacc[0][1], sacc[0][2]);
#pragma unroll
                    for (int j = 3; j < 15; j += 2) mx = vmax3(mx, sacc[0][j], sacc[0][j + 1]);
                    mx = vmax3(mx, sacc[0][15], sacc[1][0]);
#pragma unroll
                    for (int j = 1; j < 15; j += 2) mx = vmax3(mx, sacc[1][j], sacc[1][j + 1]);
                    {
                        const float m1 = fmaxf(mx, sacc[1][15]);
                        const auto sw = __builtin_amdgcn_permlane32_swap(__float_as_uint(m1), __float_as_uint(m1), false, false);
                        mx = fmaxf(__uint_as_float(sw[0]), __uint_as_float(sw[1]));
                    }
                    const bool first = (kt == 0);
                    const bool move = first || __builtin_amdgcn_ballot_w64(mx > THR_DEFER) != 0ull;
                    const float d = move ? (first ? mx : fmaxf(mx, 0.f)) : 0.f;
                    f32x2 ps2 = (f32x2){0.f, 0.f}; const f32x2 d2 = (f32x2){d, d};
#pragma unroll
                    for (int kb2 = 0; kb2 < 2; ++kb2)
#pragma unroll
                        for (int j = 0; j < 16; j += 2) {
                            const f32x2 t = (f32x2){sacc[kb2][j], sacc[kb2][j + 1]} - d2;
                            const f32x2 e = (f32x2){__builtin_amdgcn_exp2f(t.x), __builtin_amdgcn_exp2f(t.y)};
                            sacc[kb2][j] = e.x; sacc[kb2][j + 1] = e.y; ps2 += e;
                        }
                    const float ps = ps2.x + ps2.y;
                    if (move) {
                        const float alpha = first ? 0.f : __builtin_amdgcn_exp2f(-d);
                        mrun += d; lrun *= alpha;
#pragma unroll
                        for (int i = 0; i < 4; ++i)
#pragma unroll
                            for (int j = 0; j < 16; ++j) oacc[i][j] *= alpha;
                    }
                    lrun += ps;
                    bf16x8 pb[2][2];
#pragma unroll
                    for (int kb2 = 0; kb2 < 2; ++kb2)
#pragma unroll
                        for (int s2 = 0; s2 < 2; ++s2) {
                            u32x4 pw;
                            pw.x = pk_bf16(sacc[kb2][8 * s2 + 0], sacc[kb2][8 * s2 + 1]); pw.y = pk_bf16(sacc[kb2][8 * s2 + 2], sacc[kb2][8 * s2 + 3]);
                            pw.z = pk_bf16(sacc[kb2][8 * s2 + 4], sacc[kb2][8 * s2 + 5]); pw.w = pk_bf16(sacc[kb2][8 * s2 + 6], sacc[kb2][8 * s2 + 7]);
                            pb[kb2][s2] = __builtin_bit_cast(bf16x8, pw);
                        }
#pragma unroll
                    for (int gg = 0; gg < 4; ++gg) {
                        if (gg < 3) ATT_LDV(vf[(gg + 1) & 1], gg + 1);
                        __builtin_amdgcn_sched_barrier(0);
#pragma unroll
                        for (int i = 0; i < 4; ++i) oacc[i] = __builtin_amdgcn_mfma_f32_32x32x16_bf16(vf[gg & 1][i], pb[gg >> 1][gg & 1], oacc[i], 0, 0, 0);
                        __builtin_amdgcn_sched_barrier(0);
                    }
#undef ATT_LDV
                }
                if (more) ATT_WRITEV(buf ^ 1);
                __syncthreads();
            }
#undef ATT_LOADK
#undef ATT_LOADV
#undef ATT_WRITEK
#undef ATT_WRITEV
            const float ltot = lrun + __shfl_xor(lrun, 32), inv = 1.0f / ltot;
            char* obase = (char*)(OB + ((size_t)b * SEQ + q0) * DM + h * 128);
            asm volatile("" : "+s"(obase));
            const unsigned ooff = (unsigned)(c * 2048 + hi * 8);
#pragma unroll
            for (int i = 0; i < 4; ++i)
#pragma unroll
                for (int g = 0; g < 4; ++g) {
                    u32x2 wv; wv.x = pk_bf16(oacc[i][4 * g] * inv, oacc[i][4 * g + 1] * inv); wv.y = pk_bf16(oacc[i][4 * g + 2] * inv, oacc[i][4 * g + 3] * inv);
                    *(u32x2*)(obase + ooff + 64 * i + 16 * g) = wv;
                }
        }
    }
    __syncthreads();
}

#define XB_TMO      128
#define XB_XCNT(j)  (256  + 64 * (j))
#define XB_XSUB(j)  (1280 + 64 * (j))
#define XB_XGEN(j)  (2304 + 64 * (j))
#define XB_TOP      3328
#define XB_TOPGEN   3392
#define XCD_BAR_WORDS 3456
#define XB_SPIN_CAP (1u << 20)
__device__ __forceinline__ unsigned xb_ld(unsigned* p)              { return __hip_atomic_load(p, __ATOMIC_RELAXED, __HIP_MEMORY_SCOPE_AGENT); }
__device__ __forceinline__ unsigned xb_add(unsigned* p, unsigned v) { return __hip_atomic_fetch_add(p, v, __ATOMIC_RELAXED, __HIP_MEMORY_SCOPE_AGENT); }
__device__ __forceinline__ unsigned xb_xcc_id() { return (unsigned)__builtin_amdgcn_s_getreg((3 << 11) | 20) & 0xFu; }
#define XB_SPIN(cond, bar) do { unsigned _sp = 0; while (cond) { __builtin_amdgcn_s_sleep(1); \
    if ((++_sp & 255u) == 0u) { if (xb_ld(&(bar)[XB_TMO])) break; if (_sp > XB_SPIN_CAP) { atomicAdd(&(bar)[XB_TMO], 1u); break; } } } } while (0)
struct XcdBarrier { unsigned* bar; unsigned x; volatile LAS unsigned* st; };
__device__ __forceinline__ XcdBarrier xcd_barrier_post(unsigned* bar, volatile LAS unsigned* st, const int wv) {
    XcdBarrier b; b.bar = bar; b.x = xb_xcc_id(); b.st = st;
    if (otid(wv) == 0) (void)xb_add(&bar[XB_XCNT(b.x)], 1u);
    return b;
}
__device__ __forceinline__ void xcd_barrier_complete(unsigned* bar, unsigned x, unsigned& nloc, unsigned& nx) {
    const unsigned G = gridDim.x * gridDim.y * gridDim.z;
    unsigned sum, cnt, mine, sp = 0u;
    for (;;) {
        sum = 0u; cnt = 0u; mine = 0u;
#pragma unroll
        for (unsigned j = 0; j < 16; ++j) { const unsigned c = xb_ld(&bar[XB_XCNT(j)]); sum += c; cnt += (c > 0u) ? 1u : 0u; mine = (j == x) ? c : mine; }
        if (sum == G) break;
        __builtin_amdgcn_s_sleep(1);
        if ((++sp & 255u) == 0u) { if (xb_ld(&bar[XB_TMO])) break; if (sp > XB_SPIN_CAP) { atomicAdd(&bar[XB_TMO], 1u); break; } }
    }
    nloc = mine > 0u ? mine : 1u; nx = cnt > 0u ? cnt : 1u;
}
__device__ __forceinline__ void xcd_barrier(const XcdBarrier& b, const int wv) {
    asm volatile("s_waitcnt vmcnt(0)" ::: "memory");
    __syncthreads();
    if (otid(wv) == 0) {
        unsigned* bar = b.bar;
        __builtin_amdgcn_s_waitcnt(0);
        unsigned nloc = b.st[0], nx = b.st[1];
        if (nloc == 0u) { xcd_barrier_complete(bar, b.x, nloc, nx); b.st[0] = nloc; b.st[1] = nx; }
        const unsigned old = xb_add(&bar[XB_XSUB(b.x)], 1u);
        const unsigned gen = old / nloc;
        if (old + 1u == (gen + 1u) * nloc) {
            __builtin_amdgcn_fence(__ATOMIC_RELEASE, "agent");
            asm volatile("s_waitcnt vmcnt(0)" ::: "memory");
            const unsigned og = xb_add(&bar[XB_TOP], 1u);
            const unsigned tg = og / nx;
            if (og + 1u == (tg + 1u) * nx) xb_add(&bar[XB_TOPGEN], 1u);
            else XB_SPIN(xb_ld(&bar[XB_TOPGEN]) == tg, bar);
            __builtin_amdgcn_fence(__ATOMIC_ACQUIRE, "agent");
            xb_add(&bar[XB_XGEN(b.x)], 1u);
            asm volatile("s_waitcnt vmcnt(0)" ::: "memory");
        } else {
            XB_SPIN(xb_ld(&bar[XB_XGEN(b.x)]) == gen, bar);
            __builtin_amdgcn_fence(__ATOMIC_ACQUIRE, "agent");
            asm volatile("s_waitcnt vmcnt(0)" ::: "memory");
        }
    }
    __syncthreads();
}

enum { OP_CIN, OP_CONV3, OP_COUT, OP_GU, OP_DOWN, OP_LIN, OP_CONV4, OP_GATE, OP_SCAN1, OP_SCAN2, OP_LOUT, OP_MDOWN, OP_UQ, OP_UKV, OP_PREP, OP_ATTN, OP_WO };
enum { GT_NONE, GT_PAIR, GT_STORE, GT_RESID, GT_GATE };
__device__ const unsigned char g_prog[25][3] = {
    {OP_CIN, 0, 1}, {OP_CONV3, 0, 1}, {OP_COUT, 0, 1}, {OP_GU, 0, 1}, {OP_DOWN, 0, 1},
    {OP_LIN, 1, 1}, {OP_CONV4, 1, 1}, {OP_GATE, 1, 1}, {OP_SCAN1, 1, 1}, {OP_SCAN2, 1, 1}, {OP_LOUT, 1, 1}, {OP_GU, 1, 1}, {OP_DOWN, 1, 1},
    {OP_MDOWN, 2, 1}, {OP_UQ, 2, 0}, {OP_UKV, 2, 1}, {OP_ATTN, 2, 1}, {OP_WO, 2, 1}, {OP_GU, 2, 1}, {OP_DOWN, 2, 1},
    {OP_CIN, 3, 1}, {OP_CONV3, 3, 1}, {OP_COUT, 3, 1}, {OP_GU, 3, 1}, {OP_DOWN, 3, 1}};

__global__ void __launch_bounds__(NTHREADS) mega_fwd(Params p) {
    extern __shared__ __attribute__((aligned(16))) unsigned char lds_raw[];
    LAS unsigned char* lds = (LAS unsigned char*)lds_raw;
    cg::grid_group grid = cg::this_grid();
    KA ka = (KA)__builtin_amdgcn_kernarg_segment_ptr();
    (void)p;
    volatile LAS unsigned* xst = (volatile LAS unsigned*)(lds + pg8::STAGE_BYTES);
    const int wv = __builtin_amdgcn_readfirstlane((int)(threadIdx.x >> 6));
    { const int t0 = otid(wv); if (t0 < 4) xst[t0] = 0u; }
    __syncthreads();
    (void)xcd_barrier_post((unsigned*)(P_WS + OFF_BAR), xst, wv);
    if (P_OUT == nullptr) grid.sync();
#define GRID_BAR() do { XcdBarrier xb_; xb_.bar = (unsigned*)(P_WS + OFF_BAR); xb_.x = xb_xcc_id(); xb_.st = (volatile LAS unsigned*)(lds + pg8::STAGE_BYTES); xcd_barrier(xb_, wv); } while (0)
    for (int i = 0; i < PROBE_P0; ++i) { phase0(ka, lds, wv); GRID_BAR(); }
    phase0(ka, lds, wv);
    GRID_BAR();
    for (int i = 0; i < PROBE_SYNCS; ++i) GRID_BAR();
    for (int st = 0, rep = 0; st < 25; ++st) {
        asm volatile("" : "+s"(ka));
        unsigned char* const ws = P_WS;
        float* const ssq = (float*)(ws + OFF_SSQ);
        bf16_t* const hb = (bf16_t*)(ws + OFF_HB);
        const int op = g_prog[st][0], L = g_prog[st][1], sync_after = g_prog[st][2];
        const int j = L / 3;
        int gt = GT_NONE; pg8::Gemm g{}; EP e{};
        switch (op) {
        case OP_CIN:
            gt = GT_PAIR; g = pg8::Gemm{hb, (const bf16_t*)(ws + OFF_WCIN) + (size_t)j * 3072 * DM, T, 3072, DM, DM, 0};
            e.o0 = (bf16_t*)(ws + OFF_U); e.ld0 = DM; e.o1 = (bf16_t*)(ws + OFF_BG); e.ld1 = DM; e.split = 8; e.mode = 1; e.q2 = ssq + (size_t)(2 * L) * T; e.inv_dim = 1.0f / DM; break;
        case OP_CONV3: conv3_phase(ka, (const float*)P_IN(4) + (size_t)j * 3 * DM, wv); break;
        case OP_COUT:
            gt = GT_RESID; g = pg8::Gemm{(const bf16_t*)(ws + OFF_Y), (const bf16_t*)(ws + OFF_WCOUT) + (size_t)j * DM * DM, T, DM, DM, DM, 0};
            e.q2 = ws + OFF_B3; e.o0 = hb; e.q3 = ssq + (size_t)(2 * L + 1) * T; break;
        case OP_GU:
            gt = GT_PAIR; g = pg8::Gemm{hb, (const bf16_t*)(ws + OFF_WGU) + (size_t)L * 2 * DFF * DM, T, 2 * DFF, DM, DM, 0};
            e.o0 = (bf16_t*)(ws + OFF_ACT); e.ld0 = DFF; e.split = 1 << 20; e.mode = 0; e.q2 = ssq + (size_t)(2 * L + 1) * T; e.inv_dim = 1.0f / DM; break;
        case OP_DOWN:
            gt = GT_RESID; g = pg8::Gemm{(const bf16_t*)(ws + OFF_ACT), (const bf16_t*)(ws + OFF_WDN) + (size_t)L * DM * DFF, T, DM, DFF, DFF, 0};
            e.q2 = ws + OFF_B3; e.q4 = P_OUT; e.mode = (L == 3) ? 1 : 0; e.o0 = hb; e.q3 = ssq + (size_t)(L < 3 ? 2 * L + 2 : 10) * T; break;
        case OP_LIN:
            gt = GT_STORE; g = pg8::Gemm{hb, (const bf16_t*)(ws + OFF_WLIN), T, 2 * LW, DM, DM, 0};
            e.o0 = (bf16_t*)(ws + OFF_GATE); e.ld0 = LW; e.o1 = (bf16_t*)(ws + OFF_RECB); e.ld1 = LW; e.split = 5; e.mode = 1; e.q2 = ssq + (size_t)(2 * L) * T; e.inv_dim = 1.0f / DM; break;
        case OP_CONV4: conv4_phase(ka, wv); break;
        case OP_GATE:
            gt = GT_GATE; g = pg8::Gemm{(const bf16_t*)(ws + OFF_XS), (const bf16_t*)(ws + OFF_WLG), T, 2 * LW, 128, LW, 128};
            e.o0 = (bf16_t*)P_OUT; e.o1 = (bf16_t*)(ws + OFF_RECB); e.q2 = (const bf16_t*)(ws + OFF_XS);
            e.q3 = (void*)P_IN(10); e.q4 = (void*)P_IN(12); e.q5 = (const float*)(ws + OFF_CL); break;
        case OP_SCAN1: scan1_phase(ka, wv); break;
        case OP_SCAN2: scan2_phase(ka, wv); break;
        case OP_LOUT:
            gt = GT_RESID; g = pg8::Gemm{(const bf16_t*)(ws + OFF_GATE), (const bf16_t*)(ws + OFF_WLOUT), T, DM, LW, LW, 0};
            e.q2 = ws + OFF_B3; e.o0 = hb; e.q3 = ssq + (size_t)(2 * L + 1) * T; break;
        case OP_MDOWN:
            gt = GT_STORE; g = pg8::Gemm{hb, (const bf16_t*)(ws + OFF_WMD), T, 768, DM, DM, 0};
            e.o0 = (bf16_t*)(ws + OFF_CBUF); e.ld0 = 768; e.split = 1 << 20; e.mode = 2; e.q2 = ssq + (size_t)(2 * L) * T; e.inv_dim = 1.0f / DM;
            e.q3 = ssq + (size_t)8 * T; e.q4 = ssq + (size_t)9 * T; break;
        case OP_UQ:
            krope_phase(ka, wv);
            gt = GT_STORE; g = pg8::Gemm{(const bf16_t*)(ws + OFF_CBUF) + 256, (const bf16_t*)(ws + OFF_WUQ), T, 1536, 384, 768, 0};
            e.o0 = (bf16_t*)(ws + OFF_QB); e.ld0 = 1536; e.split = 1 << 20; e.mode = 0; e.q2 = ssq + (size_t)9 * T; e.inv_dim = 1.0f / 384.0f; break;
        case OP_UKV:
            gt = GT_STORE; g = pg8::Gemm{(const bf16_t*)(ws + OFF_CBUF), (const bf16_t*)(ws + OFF_WUKV), T, 2048, 256, 768, 0};
            e.o0 = (bf16_t*)(ws + OFF_KVB); e.ld0 = 2048; e.split = 1 << 20; e.mode = 3; e.q2 = ssq + (size_t)8 * T; e.inv_dim = 1.0f / 256.0f; e.q5 = P_IN(22); break;
        case OP_ATTN: attn_phase(ka, lds, wv); break;
        case OP_WO:
            gt = GT_RESID; g = pg8::Gemm{(const bf16_t*)(ws + OFF_OBUF), (const bf16_t*)(ws + OFF_WO), T, DM, DM, DM, 0};
            e.q2 = ws + OFF_B3; e.o0 = hb; e.q3 = ssq + (size_t)(2 * L + 1) * T; break;
        default: break;
        }
        if (gt == GT_PAIR && ((PROBE_MASK >> op) & 1u) && rep == 0) { e.mode = 99; g.akoff = -1; }
        if (gt == GT_RESID && ((PROBE_MASK >> op) & 1u) && rep == 0) {
            e.mode = 1; e.q4 = ws + OFF_R + 192 * MiB; }
        if (gt != GT_NONE) {
            pg8::StaticOrder S; S.init(g.M, g.N, ogrid(), obid());
            e.type = gt - 1;
#if PROBE_CLK
            unsigned long long c0_ = 0, r0_ = 0; const bool clk_ = (st == 11);
            if (clk_) { c0_ = clock64(); r0_ = wall_clock64(); }
#endif
            EpiAll E{e, (LAS const float*)(lds + pg8::STAGE_BYTES + 64)}; pg8::gemm_phase<EpiAll>(lds, g, S, E, wv);
#if PROBE_CLK
            if (clk_ && blockIdx.x == 0 && otid(wv) == 0) {
                const unsigned long long c1_ = clock64(), r1_ = wall_clock64();
                const unsigned long long mhz = (c1_ - c0_) * 100ull / (r1_ - r0_);
                while (wall_clock64() - r1_ < mhz * 100ull) __builtin_amdgcn_s_sleep(8);
            }
#endif
        }
        if (sync_after) GRID_BAR();
        if (((PROBE_MASK >> op) & 1u) && rep == 0) { if (!sync_after) GRID_BAR(); rep = 1; --st; } else rep = 0;
    }
}

constexpr int LDS_BYTES = pg8::STAGE_BYTES + 64 + 1024 + 4096;

extern "C" void kernel_launch(void* const* d_in, const int* in_sizes, int n_in, void* d_out, int out_size, void* d_ws, size_t ws_size, hipStream_t stream) {
    static int grid_blocks = 0;
    if (grid_blocks == 0) {
        if (n_in != 28 || ws_size < WS_NEED) { fprintf(stderr, "kernel_launch: unexpected inputs (n_in %d, ws %zu, need %zu)\n", n_in, ws_size, (size_t)WS_NEED); grid_blocks = -1; return; }
        int dev = 0, cus = 0, per_cu = 0;
        hipGetDevice(&dev);
        hipDeviceGetAttribute(&cus, hipDeviceAttributeMultiprocessorCount, dev);
        hipFuncSetAttribute((const void*)mega_fwd, hipFuncAttributeMaxDynamicSharedMemorySize, LDS_BYTES);
        hipOccupancyMaxActiveBlocksPerMultiprocessor(&per_cu, (const void*)mega_fwd, NTHREADS, LDS_BYTES);
        if (per_cu < 1) { fprintf(stderr, "kernel_launch: occupancy query returned %d\n", per_cu); per_cu = 1; }
        grid_blocks = cus;
        (void)hipGetLastError();
    }
    if (grid_blocks < 0) return;
    Params p{};
    for (int i = 0; i < 28; ++i) p.in[i] = d_in[i];
    p.out = (float*)d_out; p.ws = (unsigned char*)d_ws;
    (void)hipMemsetAsync((unsigned char*)d_ws + OFF_BAR, 0, XCD_BAR_WORDS * sizeof(unsigned), stream);
    void* args[] = {&p};
    hipError_t e = hipLaunchCooperativeKernel((const void*)mega_fwd, dim3(grid_blocks), dim3(NTHREADS), args, LDS_BYTES, stream);
    if (e != hipSuccess) fprintf(stderr, "cooperative launch failed: %s (grid %d)\n", hipGetErrorString(e), grid_blocks);
}
```
